# Optimizing an MI355X kernel written in HIP

```python
import math
import jax
import jax.numpy as jnp
from jax import lax
import numpy as np

D_MODEL = 1024
BATCH = 8
SEQ = 4096
DEPTH = 2

GRID_W = 64
CTX_LEN = 256
EPS = 1e-6
W_LRU = 256
LRU_BLOCKS = 4
LRU_BLK = W_LRU // LRU_BLOCKS
CONV_W = 4
LRU_C = 8.0
W_S5 = 256
S5_H = 16
S5_G = W_S5 // S5_H
S5_P = 64
DA_HEADS = 4
DA_DH = 64
DA_DV = 2 * DA_DH
W_DA = DA_HEADS * DA_DV
MIX_W = W_LRU + W_S5 + W_DA
SIDE_W = W_LRU + W_S5 + 2 * W_DA
IN_W = 2 * SIDE_W
SPLIT4 = (W_LRU, W_LRU + W_S5, W_LRU + W_S5 + W_DA)
Q_BLOCK = 128
ROPE_BASE = 10000.0
ROPE_F = DA_DH // 4

kernel_name = 'hybrid_lru_s5_diffattn_prefix'

F32 = jnp.float32


def rms_norm(x, g):
    xf = x.astype(F32)
    y = xf * lax.rsqrt(jnp.mean(xf * xf, axis=-1, keepdims=True) + EPS)
    return (y * g.astype(F32)).astype(x.dtype)


def centred_dwconv(u, w, b):
    left = CONV_W // 2
    y = lax.conv_general_dilated(u, w.astype(u.dtype)[:, None, :], window_strides=(1,),
                                 padding=[(left, CONV_W - 1 - left)],
                                 dimension_numbers=('NWC', 'WIO', 'NWC'),
                                 feature_group_count=u.shape[-1])
    return y + b.astype(u.dtype)


def real_linear_op(e1, e2):
    a1, b1 = e1
    a2, b2 = e2
    return a1 * a2, a2 * b1 + b2


def complex_linear_op(e1, e2):
    ar1, ai1, br1, bi1 = e1
    ar2, ai2, br2, bi2 = e2
    return (ar1 * ar2 - ai1 * ai2, ar1 * ai2 + ai1 * ar2,
            ar2 * br1 - ai2 * bi1 + br2, ar2 * bi1 + ai2 * br1 + bi2)


def real_scan(a, b, h0, reverse):
    if h0 is not None:
        idx = a.shape[1] - 1 if reverse else 0
        b = b.at[:, idx].add(a[:, idx] * h0)
    _, h = lax.associative_scan(real_linear_op, (a, b), reverse=reverse, axis=1)
    return h


def block_diag(xb, w):
    y = jnp.einsum('btnc,ncd->btnd', xb, w.astype(F32))
    return y.reshape(xb.shape[0], xb.shape[1], -1)


def rglru_scans(u, conv_w, conv_b, wa, ba, wx, bx, lam, h0):
    bsz, t, _ = u.shape
    xc = centred_dwconv(u, conv_w, conv_b).astype(F32)
    xb = xc.reshape(bsz, t, LRU_BLOCKS, LRU_BLK)
    hs = []
    for d in range(2):
        gate_r = jax.nn.sigmoid(block_diag(xb, wa[d]) + ba[d].astype(F32))
        gate_i = jax.nn.sigmoid(block_diag(xb, wx[d]) + bx[d].astype(F32))
        log_a = -LRU_C * gate_r * jax.nn.softplus(-lam[d].astype(F32))
        a = jnp.exp(log_a)
        b = jnp.sqrt(-jnp.expm1(2.0 * log_a)) * (gate_i * xc)
        hs.append(real_scan(a, b, None if h0 is None else h0[d], reverse=(d == 1)))
    return hs


def s5_discretise(lam_re, lam_im, log_dt, b_re, b_im):
    lam_re = lam_re.astype(F32)
    lam_im = lam_im.astype(F32)
    dt = jnp.exp(log_dt.astype(F32))[:, None]
    mag = jnp.exp(lam_re * dt)
    ang = lam_im * dt
    ab_re = mag * jnp.cos(ang)
    ab_im = mag * jnp.sin(ang)
    nr = ab_re - 1.0
    ni = ab_im
    den = lam_re * lam_re + lam_im * lam_im
    cf_re = ((nr * lam_re + ni * lam_im) / den)[..., None]
    cf_im = ((ni * lam_re - nr * lam_im) / den)[..., None]
    b_re = b_re.astype(F32)
    b_im = b_im.astype(F32)
    return ab_re, ab_im, cf_re * b_re - cf_im * b_im, cf_re * b_im + cf_im * b_re


def s5_scan(u, disc, h0, reverse):
    ab_re, ab_im, bb_re, bb_im = disc
    bsz, t, _ = u.shape
    ug = u.astype(F32).reshape(bsz, t, S5_G, S5_H)
    bu_re = jnp.einsum('btgh,gph->btgp', ug, bb_re)
    bu_im = jnp.einsum('btgh,gph->btgp', ug, bb_im)
    if h0 is not None:
        idx = t - 1 if reverse else 0
        h_re, h_im = h0
        bu_re = bu_re.at[:, idx].add(ab_re * h_re - ab_im * h_im)
        bu_im = bu_im.at[:, idx].add(ab_re * h_im + ab_im * h_re)
    a_re = jnp.broadcast_to(ab_re, bu_re.shape)
    a_im = jnp.broadcast_to(ab_im, bu_im.shape)
    _, _, s_re, s_im = lax.associative_scan(complex_linear_op, (a_re, a_im, bu_re, bu_im),
                                            reverse=reverse, axis=1)
    return s_re, s_im


def final_state(states, reverse):
    idx = 0 if reverse else -1
    return states[0][:, idx], states[1][:, idx]


def s5_output(u, states, c_re, c_im, d_skip, w_glu, b_glu):
    uf = u.astype(F32)
    bsz, t, _ = u.shape
    y = d_skip.astype(F32) * uf
    for d in range(2):
        s_re, s_im = states[d]
        r = (jnp.einsum('btgp,ghp->btgh', s_re, c_re[d].astype(F32))
             - jnp.einsum('btgp,ghp->btgh', s_im, c_im[d].astype(F32)))
        y = y + r.reshape(bsz, t, W_S5)
    z = jax.nn.gelu(y)
    return z * jax.nn.sigmoid(z @ w_glu.astype(F32) + b_glu.astype(F32))


def rot_half(x, ang):
    f = ang.shape[-1]
    cos = jnp.cos(ang).astype(x.dtype)[:, None, None, :]
    sin = jnp.sin(ang).astype(x.dtype)[:, None, None, :]
    x1, x2 = x[..., :f], x[..., f:]
    return jnp.concatenate([x1 * cos - x2 * sin, x2 * cos + x1 * sin], axis=-1)


def rope_axial(x, ang_row, ang_col):
    half = x.shape[-1] // 2
    return jnp.concatenate([rot_half(x[..., :half], ang_row), rot_half(x[..., half:], ang_col)], axis=-1)


def diff_softmax_attend(q, k, v, lam):
    s = jnp.einsum('bqhmd,bkhmd->bhmqk', q, k).astype(F32) * (DA_DH ** -0.5)
    p = jax.nn.softmax(s, axis=-1)
    w = p[:, :, 0] - lam * p[:, :, 1]
    return jnp.einsum('bhqk,bkhe->bqhe', w.astype(v.dtype), v)


def latent_diff_attention(q, k_all, v_all, lam):
    bsz, t = q.shape[:2]
    nb = t // Q_BLOCK
    qb = jnp.moveaxis(q.reshape(bsz, nb, Q_BLOCK, DA_HEADS, 2, DA_DH), 1, 0)
    ob = lax.map(lambda qq: diff_softmax_attend(qq, k_all, v_all, lam), qb)
    return jnp.moveaxis(ob, 0, 1).reshape(bsz, t, DA_HEADS, DA_DV)


def combine_branches(h_lru, s5_st, u_s5, o_att, g_lru, g_s5, g_att,
                     c_re, c_im, d_skip, w_glu, b_glu, da_g, lam_init, w_out):
    dtype = g_lru.dtype
    bsz, t, _ = g_lru.shape
    y_a = (h_lru[0] + h_lru[1]) * jax.nn.silu(g_lru.astype(F32))
    y_s = s5_output(u_s5, s5_st, c_re, c_im, d_skip, w_glu, b_glu) * jax.nn.silu(g_s5.astype(F32))
    o = rms_norm(o_att, da_g).astype(F32) * (1.0 - lam_init)
    y_d = o.reshape(bsz, t, W_DA) * jax.nn.silu(g_att.astype(F32))
    y = jnp.concatenate([y_a.astype(dtype), y_s.astype(dtype), y_d.astype(dtype)], axis=-1)
    return y @ w_out


def setup_inputs(seed: int = 0) -> dict:
    key = jax.random.key(seed)
    ks = iter(jax.random.split(key, 32))
    L, D = DEPTH, D_MODEL

    def nrm(shape, scale):
        return scale * jax.random.normal(next(ks), shape, F32)

    x = nrm((BATCH, SEQ, D), 1.0)
    c = nrm((BATCH, D), 1.0)
    ctx = nrm((BATCH, CTX_LEN, D), 1.0)
    c_ctx = nrm((D,), 1.0)
    norm_g = 1.0 + nrm((L, D), 0.02)
    w_mod = nrm((L, D, 3 * D), 0.5 * D ** -0.5)
    b_mod = nrm((L, 3 * D), 0.02)
    w_in = nrm((L, D, IN_W), D ** -0.5)
    w_out = nrm((L, MIX_W, D), MIX_W ** -0.5)
    lru_conv_w = nrm((L, CONV_W, W_LRU), CONV_W ** -0.5)
    lru_conv_b = nrm((L, W_LRU), 0.02)
    lru_wa = nrm((L, 2, LRU_BLOCKS, LRU_BLK, LRU_BLK), LRU_BLK ** -0.5)
    lru_ba = nrm((L, 2, W_LRU), 0.02)
    lru_wx = nrm((L, 2, LRU_BLOCKS, LRU_BLK, LRU_BLK), LRU_BLK ** -0.5)
    lru_bx = nrm((L, 2, W_LRU), 0.02)
    a_pow = jax.random.uniform(next(ks), (L, 2, W_LRU), F32, 0.9, 0.999)
    a0 = a_pow ** (1.0 / LRU_C)
    lru_lam = jnp.log(a0) - jnp.log1p(-a0)
    s5_lam_re = -0.5 + nrm((L, 2, S5_G, S5_P), 0.01)
    s5_lam_im = jnp.pi * jnp.arange(S5_P, dtype=F32) + nrm((L, 2, S5_G, S5_P), 0.01)
    s5_log_dt = jax.random.uniform(next(ks), (L, 2, S5_G), F32, math.log(1e-3), math.log(1e-1))
    s5_b_re = nrm((L, 2, S5_G, S5_P, S5_H), (2 * S5_H) ** -0.5)
    s5_b_im = nrm((L, 2, S5_G, S5_P, S5_H), (2 * S5_H) ** -0.5)
    s5_c_re = nrm((L, 2, S5_G, S5_H, S5_P), 0.5)
    s5_c_im = nrm((L, 2, S5_G, S5_H, S5_P), 0.5)
    s5_d = nrm((L, W_S5), 1.0)
    s5_w_glu = nrm((L, W_S5, W_S5), W_S5 ** -0.5)
    s5_b_glu = nrm((L, W_S5), 0.02)
    da_lam = nrm((L, 2, 2, DA_DH), 0.1)
    da_norm_g = 1.0 + nrm((L, DA_DV), 0.02)
    final_g = 1.0 + nrm((D,), 0.02)
    return {'x': x, 'c': c, 'ctx': ctx, 'c_ctx': c_ctx, 'norm_g': norm_g,
            'w_mod': w_mod, 'b_mod': b_mod, 'w_in': w_in, 'w_out': w_out,
            'lru_conv_w': lru_conv_w, 'lru_conv_b': lru_conv_b, 'lru_wa': lru_wa, 'lru_ba': lru_ba,
            'lru_wx': lru_wx, 'lru_bx': lru_bx, 'lru_lam': lru_lam,
            's5_lam_re': s5_lam_re, 's5_lam_im': s5_lam_im, 's5_log_dt': s5_log_dt,
            's5_b_re': s5_b_re, 's5_b_im': s5_b_im, 's5_c_re': s5_c_re, 's5_c_im': s5_c_im,
            's5_d': s5_d, 's5_w_glu': s5_w_glu, 's5_b_glu': s5_b_glu,
            'da_lam': da_lam, 'da_norm_g': da_norm_g, 'final_g': final_g}


def reference(x, c, ctx, c_ctx, norm_g, w_mod, b_mod, w_in, w_out,
              lru_conv_w, lru_conv_b, lru_wa, lru_ba, lru_wx, lru_bx, lru_lam,
              s5_lam_re, s5_lam_im, s5_log_dt, s5_b_re, s5_b_im, s5_c_re, s5_c_im,
              s5_d, s5_w_glu, s5_b_glu, da_lam, da_norm_g, final_g):
    bsz, t, _ = x.shape
    tc = ctx.shape[1]
    rows = t // GRID_W
    row_pos = jnp.broadcast_to(jnp.arange(rows, dtype=F32)[:, None], (rows, GRID_W)).reshape(t)
    col_pos = jnp.broadcast_to(jnp.arange(GRID_W, dtype=F32)[None, :], (rows, GRID_W)).reshape(t)
    inv_freq = jnp.exp(-math.log(ROPE_BASE) * jnp.arange(ROPE_F, dtype=F32) / ROPE_F)
    ang_row = row_pos[:, None] * inv_freq[None, :]
    ang_col = col_pos[:, None] * inv_freq[None, :]

    silu_c = jax.nn.silu(c)
    silu_cc = jax.nn.silu(c_ctx)
    h = x
    hc = ctx
    for l in range(DEPTH):
        last = l == DEPTH - 1
        shift, scale, gate = jnp.split(silu_c @ w_mod[l] + b_mod[l], 3, axis=-1)
        shift_c, scale_c, gate_c = jnp.split(silu_cc @ w_mod[l] + b_mod[l], 3, axis=-1)
        n_lat = rms_norm(h, norm_g[l]) * (1.0 + scale[:, None]) + shift[:, None]
        n_ctx = rms_norm(hc, norm_g[l]) * (1.0 + scale_c) + shift_c
        p_lat = n_lat @ w_in[l]
        p_ctx = n_ctx @ (w_in[l][:, :SIDE_W] if last else w_in[l])
        ua_l, us_l, k_l, v_l = jnp.split(p_lat[..., :SIDE_W], SPLIT4, axis=-1)
        ga_l, gs_l, q_l, gd_l = jnp.split(p_lat[..., SIDE_W:], SPLIT4, axis=-1)
        ua_c, us_c, k_c, v_c = jnp.split(p_ctx[..., :SIDE_W], SPLIT4, axis=-1)

        lru_p = (lru_conv_w[l], lru_conv_b[l], lru_wa[l], lru_ba[l], lru_wx[l], lru_bx[l], lru_lam[l])
        h_lru_c = rglru_scans(ua_c, *lru_p, None)
        h_lru_l = rglru_scans(ua_l, *lru_p, (h_lru_c[0][:, -1], h_lru_c[1][:, 0]))

        disc = [s5_discretise(s5_lam_re[l, d], s5_lam_im[l, d], s5_log_dt[l, d],
                              s5_b_re[l, d], s5_b_im[l, d]) for d in range(2)]
        st_c = [s5_scan(us_c, disc[d], None, d == 1) for d in range(2)]
        st_l = [s5_scan(us_l, disc[d], final_state(st_c[d], d == 1), d == 1) for d in range(2)]

        lam_init = 0.8 - 0.6 * math.exp(-0.3 * l)
        lam = (jnp.exp(jnp.sum(da_lam[l, 0, 0].astype(F32) * da_lam[l, 0, 1].astype(F32)))
               - jnp.exp(jnp.sum(da_lam[l, 1, 0].astype(F32) * da_lam[l, 1, 1].astype(F32))) + lam_init)
        q_l4 = rope_axial(q_l.reshape(bsz, t, DA_HEADS, 2, DA_DH), ang_row, ang_col)
        k_l4 = rope_axial(k_l.reshape(bsz, t, DA_HEADS, 2, DA_DH), ang_row, ang_col)
        k_c4 = k_c.reshape(bsz, tc, DA_HEADS, 2, DA_DH)
        v_c4 = v_c.reshape(bsz, tc, DA_HEADS, DA_DV)
        k_all = jnp.concatenate([k_c4, k_l4], axis=1)
        v_all = jnp.concatenate([v_c4, v_l.reshape(bsz, t, DA_HEADS, DA_DV)], axis=1)
        o_l = latent_diff_attention(q_l4, k_all, v_all, lam)

        s5p = (s5_c_re[l], s5_c_im[l], s5_d[l], s5_w_glu[l], s5_b_glu[l])
        y_l = combine_branches(h_lru_l, st_l, us_l, o_l, ga_l, gs_l, gd_l, *s5p,
                               da_norm_g[l], lam_init, w_out[l])
        h_next = h + gate[:, None] * y_l
        if not last:
            ga_c, gs_c, q_c, gd_c = jnp.split(p_ctx[..., SIDE_W:], SPLIT4, axis=-1)
            o_c = diff_softmax_attend(q_c.reshape(bsz, tc, DA_HEADS, 2, DA_DH), k_c4, v_c4, lam)
            y_c = combine_branches(h_lru_c, st_c, us_c, o_c, ga_c, gs_c, gd_c, *s5p,
                                   da_norm_g[l], lam_init, w_out[l])
            hc = hc + gate_c * y_c
        h = h_next
    return rms_norm(h, final_g)
```

```cpp
#include <hip/hip_runtime.h>
#include <hip/hip_bf16.h>
#include <hip/hip_cooperative_groups.h>
#include <cstdio>
#include <cstdint>
namespace cg = cooperative_groups;

#ifndef MULTI
#define MULTI 0
#endif
#ifndef PROBE_DUP
#define PROBE_DUP 0
#endif

#define DI __device__ __forceinline__
typedef unsigned short u16;
using bf16x8 = __attribute__((ext_vector_type(8))) short;
using s16x4  = __attribute__((ext_vector_type(4))) short;
using f32x4  = __attribute__((ext_vector_type(4))) float;
using f32x16 = __attribute__((ext_vector_type(16))) float;
using u32x4  = __attribute__((ext_vector_type(4))) unsigned;

constexpr int NB = 8, TL = 4096, DM = 1024, TC = 256, SEQ = TC + TL, ROWS = NB * SEQ;
constexpr int INW = 3072;
constexpr int C_UA = 0, C_US = 256, C_K = 512, C_V = 1024, C_GA = 1536, C_GS = 1792, C_Q = 2048, C_GD = 2560;
constexpr int NTHR = 512;
constexpr int LDS_BYTES = 131072;
constexpr float EPS = 1e-6f;

struct Params {
  const float *x, *c, *ctx, *c_ctx, *norm_g, *w_mod, *b_mod, *w_in, *w_out, *conv_w, *conv_b, *lru_wa, *lru_ba, *lru_wx, *lru_bx, *lru_lam,
      *s5_lam_re, *s5_lam_im, *s5_log_dt, *s5_b_re, *s5_b_im, *s5_c_re, *s5_c_im, *s5_d, *s5_w_glu, *s5_b_glu, *da_lam, *da_norm_g, *final_g;
  float* out;
  u16 *nbuf, *pbuf, *hl, *ys, *obuf, *winT, *woutT, *wgluT, *bbT, *cc, *lruWT;
  float *hc, *mod, *sa, *rope, *lamv;
  int* counters;
};

DI float bf2f(u16 u) { return __uint_as_float(((unsigned)u) << 16); }
DI u16 f2bf(float x) { unsigned u = __float_as_uint(x); u += 0x7fffu + ((u >> 16) & 1u); return (u16)(u >> 16); }
DI float sigmoid_f(float v) { return 1.f / (1.f + __expf(-v)); }
DI float silu_f(float v) { return v / (1.f + __expf(-v)); }
DI float gelu_tanh(float y) { float u = 0.7978845608028654f * (y + 0.044715f * y * y * y); float t = 1.f - 2.f / (__expf(2.f * u) + 1.f); return 0.5f * y * (1.f + t); }
DI int crow(int r, int hi) { return (r & 3) + 8 * (r >> 2) + 4 * hi; }
DI unsigned cvtpk(float lo, float hi) { unsigned r; asm volatile("v_cvt_pk_bf16_f32 %0, %1, %2" : "=v"(r) : "v"(lo), "v"(hi)); return r; }
DI float wave_sum(float v) { for (int o = 32; o > 0; o >>= 1) v += __shfl_xor(v, o); return v; }
DI int tid_opaque(int wid_s) { int t; asm volatile("v_mbcnt_lo_u32_b32 %0, -1, 0\n\tv_mbcnt_hi_u32_b32 %0, -1, %0" : "=v"(t)); return (wid_s << 6) + t; }
#define MFMA32(a, b, c) __builtin_amdgcn_mfma_f32_32x32x16_bf16((a), (b), (c), 0, 0, 0)

DI void transpose_job(const int tix, const float* __restrict__ src, u16* __restrict__ dst, int K, int N, int kt, int nt, float* lds) {
  const int tid = tix, c = tid & 63, r0 = tid >> 6;
  for (int i = 0; i < 8; ++i) { int r = r0 + 8 * i; lds[r * 65 + c] = src[(size_t)(kt * 64 + r) * N + nt * 64 + c]; }
  __syncthreads();
  for (int i = 0; i < 8; ++i) { int r = r0 + 8 * i; dst[(size_t)(nt * 64 + r) * K + kt * 64 + c] = f2bf(lds[c * 65 + r]); }
  __syncthreads();
}

DI void mod_job(const int tix, const Params& p, int job, float* lds) {
  const int tid = tix;
  const int l = job / 96, cb = (job % 96) * 32;
  for (int i = tid; i < 9 * 1024; i += NTHR) { float v = i < 8192 ? p.c[i] : p.c_ctx[i - 8192]; lds[i] = silu_f(v); }
  __syncthreads();
  const int col = tid & 31, kg = tid >> 5;
  float acc[9];
#pragma unroll
  for (int r = 0; r < 9; ++r) acc[r] = 0.f;
  for (int k = kg * 64; k < kg * 64 + 64; ++k) {
    float w = p.w_mod[((size_t)l * 1024 + k) * 3072 + cb + col];
#pragma unroll
    for (int r = 0; r < 9; ++r) acc[r] += lds[r * 1024 + k] * w;
  }
  float* red = lds + 9 * 1024;
#pragma unroll
  for (int r = 0; r < 9; ++r) red[(kg * 9 + r) * 32 + col] = acc[r];
  __syncthreads();
  if (tid < 288) {
    int r = tid >> 5, c2 = tid & 31; float s = p.b_mod[l * 3072 + cb + c2];
    for (int g = 0; g < 16; ++g) s += red[(g * 9 + r) * 32 + c2];
    p.mod[(l * 9 + r) * 3072 + cb + c2] = s;
  }
  __syncthreads();
}

DI void phase_prep(const int tix, const Params& p, char* smem) {
  float* lds = (float*)smem;
  constexpr int J_WIN = 2 * 16 * 48, J_WOUT = 2 * 16 * 16, J_GLU = 2 * 4 * 4, J_LRU = 32, J_MOD = 192;
  constexpr int JT = J_WIN + J_WOUT + J_GLU + J_LRU + J_MOD;
  for (int job = blockIdx.x; job < JT; job += gridDim.x) {
    int j = job;
    if (j < J_WIN) { int l = j / 768, r = j % 768; transpose_job(tix, p.w_in + (size_t)l * 1024 * 3072, p.winT + (size_t)l * 3072 * 1024, 1024, 3072, r / 48, r % 48, lds); continue; }
    j -= J_WIN;
    if (j < J_WOUT) { int l = j / 256, r = j % 256; transpose_job(tix, p.w_out + (size_t)l * 1024 * 1024, p.woutT + (size_t)l * 1024 * 1024, 1024, 1024, r / 16, r % 16, lds); continue; }
    j -= J_WOUT;
    if (j < J_GLU) { int l = j / 16, r = j % 16; transpose_job(tix, p.s5_w_glu + (size_t)l * 65536, p.wgluT + (size_t)l * 65536, 256, 256, r / 4, r % 4, lds); continue; }
    j -= J_GLU;
    if (j < J_LRU) { int m = j >> 1, gate = j & 1;
      transpose_job(tix, (gate ? p.lru_wx : p.lru_wa) + (size_t)m * 4096, p.lruWT + (size_t)(m * 2 + gate) * 4096, 64, 64, 0, 0, lds); continue; }
    j -= J_LRU;
    mod_job(tix, p, j, lds);
  }
  const int gtid = blockIdx.x * NTHR + tix, gsz = gridDim.x * NTHR;
  constexpr int N_S5 = 4096, N_CC = 131072, N_ROPE = 1024;
  for (int i = gtid; i < N_S5 + N_CC + N_ROPE + 4; i += gsz) {
    if (i < N_S5) {
      const int idx = i, ldg = idx >> 6, pp = idx & 63;
      float lr = p.s5_lam_re[idx], li = p.s5_lam_im[idx], dt = expf(p.s5_log_dt[ldg]);
      float mag = expf(lr * dt), ang = li * dt, sn = sinf(ang), cs = cosf(ang);
      float abr = mag * cs, abi = mag * sn, nr = abr - 1.f, ni = abi, den = lr * lr + li * li;
      float cfr = (nr * lr + ni * li) / den, cfi = (ni * lr - nr * li) / den;
      p.sa[idx * 2] = abr; p.sa[idx * 2 + 1] = abi;
      for (int h = 0; h < 16; ++h) {
        float br = p.s5_b_re[idx * 16 + h], bi = p.s5_b_im[idx * 16 + h];
        p.bbT[((size_t)(ldg * 2 + 0) * 64 + pp) * 16 + h] = f2bf(cfr * br - cfi * bi);
        p.bbT[((size_t)(ldg * 2 + 1) * 64 + pp) * 16 + h] = f2bf(cfr * bi + cfi * br);
      }
    } else if (i < N_S5 + N_CC) {
      const int e = i - N_S5, k = e & 127, lc = e >> 7;
      float v = k < 64 ? p.s5_c_re[lc * 64 + k] : -p.s5_c_im[lc * 64 + (k - 64)];
      p.cc[e] = f2bf(v);
    } else if (i < N_S5 + N_CC + N_ROPE) {
      const int e = i - N_S5 - N_CC, pos = e >> 4, f = e & 15;
      float inv = expf(-9.210340371976184f * (float)f / 16.f), ang = (float)pos * inv;
      p.rope[e] = cosf(ang); p.rope[1024 + e] = sinf(ang);
    } else {
      const int e = i - N_S5 - N_CC - N_ROPE;
      if (e < 2) {
        const int l = e; const float* dl = p.da_lam + l * 256;
        float s0 = 0.f, s1 = 0.f;
        for (int k = 0; k < 64; ++k) { s0 += dl[k] * dl[64 + k]; s1 += dl[128 + k] * dl[192 + k]; }
        float lam_init = 0.8f - 0.6f * expf(-0.3f * (float)l);
        p.lamv[l] = expf(s0) - expf(s1) + lam_init; p.lamv[2 + l] = lam_init;
      } else { for (int k = 0; k < 8; ++k) p.counters[(e - 2) * 8 + k] = 0; }
    }
  }
}

DI void phase_norm(const int tix, const Params& p, int l) {
  const int wid = tix >> 6, lane = tix & 63;
  const float* g = p.norm_g + l * 1024;
  for (int row = blockIdx.x * 8 + wid; row < ROWS; row += gridDim.x * 8) {
    const int b = row / SEQ, s = row % SEQ;
    const float* src; int mrow;
    if (s < TC) { src = (l == 0 ? p.ctx : p.hc) + ((size_t)b * TC + s) * 1024; mrow = 8; }
    else { src = (l == 0 ? p.x : p.out) + ((size_t)b * TL + (s - TC)) * 1024; mrow = b; }
    const float* md = p.mod + (l * 9 + mrow) * 3072;
    f32x4 v[4]; float ss = 0.f;
#pragma unroll
    for (int i = 0; i < 4; ++i) { v[i] = *(const f32x4*)(src + i * 256 + lane * 4); ss += v[i][0] * v[i][0] + v[i][1] * v[i][1] + v[i][2] * v[i][2] + v[i][3] * v[i][3]; }
    ss = wave_sum(ss);
    const float r = rsqrtf(ss * (1.f / 1024.f) + EPS);
#pragma unroll
    for (int i = 0; i < 4; ++i) {
      const int c0 = i * 256 + lane * 4;
      f32x4 gg = *(const f32x4*)(g + c0), sh = *(const f32x4*)(md + c0), sc = *(const f32x4*)(md + 1024 + c0);
      float o0 = v[i][0] * r * gg[0] * (1.f + sc[0]) + sh[0], o1 = v[i][1] * r * gg[1] * (1.f + sc[1]) + sh[1];
      float o2 = v[i][2] * r * gg[2] * (1.f + sc[2]) + sh[2], o3 = v[i][3] * r * gg[3] * (1.f + sc[3]) + sh[3];
      uint2 w; w.x = cvtpk(o0, o1); w.y = cvtpk(o2, o3);
      *(uint2*)(p.nbuf + (size_t)row * 1024 + c0) = w;
    }
  }
}

namespace gm {
constexpr int BM = 256, BK = 64, HALF = 128, NXCD = 8, WGM = 8, HT = HALF * BK, KD = 1024;
DI int lds_byte(int r, int c) { int st = (r >> 4) * 2 + (c >> 5), rr = r & 15, cc = c & 31, ob = rr * 64 + cc * 2; return st * 1024 + (ob ^ (((ob >> 9) & 1) << 5)); }
DI void stage_rc(int b, int& R, int& C) { int st = b / 1024, sb = b % 1024, swz = sb ^ (((sb >> 9) & 1) << 5); R = (st >> 1) * 16 + swz / 64; C = (st & 1) * 32 + (swz % 64) / 2; }

template <int MODE>
DI void gemm_tile(const int tix, const Params& p, int l, const u16* __restrict__ A, const u16* __restrict__ Bt, int brow, int bcol, u16* shm) {
  constexpr int K = KD;
#define SA(b, h) (shm + ((b) * 2 + (h)) * HT)
#define SB(b, h) (shm + (4 + (b) * 2 + (h)) * HT)
#define STAGE(P, BASE, br, kt) do { const u16* _gp = (BASE) + ((long)(br) * K + (long)(kt) * BK); \
      __builtin_amdgcn_global_load_lds((const unsigned*)(_gp + voff0), (__attribute__((address_space(3))) unsigned*)((char*)(P) + wbase), 16, 0, 0); \
      __builtin_amdgcn_global_load_lds((const unsigned*)(_gp + voff1), (__attribute__((address_space(3))) unsigned*)((char*)(P) + wbase + 8192), 16, 0, 0); } while (0)
#define LDA(dst, b, h) for (int m = 0; m < 4; ++m) for (int k = 0; k < 2; ++k) \
    dst[m][k] = *reinterpret_cast<const bf16x8*>((char*)SA(b, h) + lds_byte(wr * 64 + m * 16 + fr, k * 32 + fq * 8))
#define LDB(dst, b, h) for (int n = 0; n < 2; ++n) for (int k = 0; k < 2; ++k) \
    dst[n][k] = *reinterpret_cast<const bf16x8*>((char*)SB(b, h) + lds_byte(wc * 32 + n * 16 + fr, k * 32 + fq * 8))
#define MMA(ai, bj, At, Bt_) do { __builtin_amdgcn_s_setprio(1); \
    for (int m = 0; m < 4; ++m) for (int n = 0; n < 2; ++n) for (int k = 0; k < 2; ++k) \
      acc[ai][bj][m][n] = __builtin_amdgcn_mfma_f32_16x16x32_bf16(At[m][k], Bt_[n][k], acc[ai][bj][m][n], 0, 0, 0); \
    __builtin_amdgcn_s_setprio(0); } while (0)
#define WAIT_V(n) asm volatile("s_waitcnt vmcnt(" #n ")" ::: "memory")
#define WAIT_L(n) asm volatile("s_waitcnt lgkmcnt(" #n ")" ::: "memory")
#define BAR __builtin_amdgcn_s_barrier()
#define SCHED __builtin_amdgcn_sched_barrier(0)
  const int wid = __builtin_amdgcn_readfirstlane(tix >> 6), lane = tix & 63, wr = wid >> 2, wc = wid & 3, fr = lane & 15, fq = lane >> 4;
  const int wbase = wid * 1024;
  int voff0, voff1;
  { int _r, _c; stage_rc(tix * 16, _r, _c); voff0 = _r * K + _c; stage_rc(tix * 16 + 8192, _r, _c); voff1 = _r * K + _c; }
  f32x4 acc[2][2][4][2] = {};
  bf16x8 At[4][2], B0[2][2], B1[2][2];
  constexpr int nt = K / BK;
  STAGE(SB(0, 0), Bt, bcol, 0); STAGE(SA(0, 0), A, brow, 0);
  STAGE(SB(0, 1), Bt, bcol + HALF, 0); STAGE(SA(0, 1), A, brow + HALF, 0);
  if (wr == 1) BAR;
  WAIT_V(4); BAR;
  STAGE(SB(1, 0), Bt, bcol, 1); STAGE(SA(1, 0), A, brow, 1); STAGE(SB(1, 1), Bt, bcol + HALF, 1);
  WAIT_V(6); BAR;
  for (int t = 0; t < nt - 2; t += 2) {
    LDB(B0, 0, 0); SCHED; LDA(At, 0, 0); STAGE(SA(1, 1), A, brow + HALF, t + 1);
    WAIT_L(8); BAR; WAIT_L(0); MMA(0, 0, At, B0); BAR; SCHED;
    LDB(B1, 0, 1); STAGE(SB(0, 0), Bt, bcol, t + 2);
    BAR; WAIT_L(0); MMA(0, 1, At, B1); BAR;
    LDA(At, 0, 1); STAGE(SA(0, 0), A, brow, t + 2);
    BAR; WAIT_L(0); MMA(1, 0, At, B0); BAR; SCHED;
    STAGE(SB(0, 1), Bt, bcol + HALF, t + 2);
    WAIT_V(6); BAR; MMA(1, 1, At, B1); BAR;
    LDB(B0, 1, 0); SCHED; LDA(At, 1, 0); STAGE(SA(0, 1), A, brow + HALF, t + 2);
    WAIT_L(8); BAR; WAIT_L(0); MMA(0, 0, At, B0); BAR; SCHED;
    LDB(B1, 1, 1); STAGE(SB(1, 0), Bt, bcol, t + 3);
    BAR; WAIT_L(0); MMA(0, 1, At, B1); BAR;
    LDA(At, 1, 1); STAGE(SA(1, 0), A, brow, t + 3);
    BAR; WAIT_L(0); MMA(1, 0, At, B0); BAR; SCHED;
    STAGE(SB(1, 1), Bt, bcol + HALF, t + 3);
    WAIT_V(6); BAR; MMA(1, 1, At, B1); BAR;
  }
  { LDB(B0, 0, 0); LDA(At, 0, 0); STAGE(SA(1, 1), A, brow + HALF, nt - 1);
    BAR; WAIT_L(0); MMA(0, 0, At, B0); BAR;
    LDB(B1, 0, 1); BAR; WAIT_L(0); MMA(0, 1, At, B1); BAR;
    LDA(At, 0, 1); WAIT_V(4); BAR; WAIT_L(0); MMA(1, 0, At, B0); MMA(1, 1, At, B1); BAR; }
  { LDB(B0, 1, 0); LDA(At, 1, 0); WAIT_V(2); BAR; WAIT_L(0); MMA(0, 0, At, B0); BAR;
    LDB(B1, 1, 1); WAIT_V(0); BAR; WAIT_L(0); MMA(0, 1, At, B1); BAR;
    LDA(At, 1, 1); BAR; WAIT_L(0); MMA(1, 0, At, B0); MMA(1, 1, At, B1); BAR; }
  if (wr == 0) BAR;
  int fr_ = fr, fq_ = fq, wr_ = wr, wc_ = wc;
  asm volatile("" : "+v"(fr_), "+v"(fq_), "+s"(wr_), "+s"(wc_));
#define fr fr_
#define fq fq_
#define wr wr_
#define wc wc_
  const int b = brow / SEQ, s0 = brow % SEQ;
  if (MODE == 0) {
    const bool lat = s0 >= TC;
#pragma unroll
    for (int ai = 0; ai < 2; ++ai)
#pragma unroll
      for (int bj = 0; bj < 2; ++bj) {
        const int colbase = bcol + bj * HALF + wc * 32;
        const bool isrope = lat && ((colbase >= C_K && colbase < C_V) || (colbase >= C_Q && colbase < C_GD));
#pragma unroll
        for (int m = 0; m < 4; ++m)
#pragma unroll
          for (int j = 0; j < 4; ++j) {
            const int lr = ai * HALF + wr * 64 + m * 16 + fq * 4 + j;
            float x1 = acc[ai][bj][m][0][j], x2 = acc[ai][bj][m][1][j];
            if (isrope) {
              const int t = s0 + lr - TC; const int pos = (colbase & 32) ? (t & 63) : (t >> 6);
              const float cs = p.rope[pos * 16 + fr], sn = p.rope[1024 + pos * 16 + fr];
              const float o1 = x1 * cs - x2 * sn, o2 = x2 * cs + x1 * sn; x1 = o1; x2 = o2;
            }
            u16* dst = p.pbuf + (size_t)(brow + lr) * INW + colbase + fr;
            dst[0] = f2bf(x1); dst[16] = f2bf(x2);
          }
      }
  } else {
    const bool isctx = s0 < TC;
    const float* gate = p.mod + (l * 9 + (isctx ? 8 : b)) * 3072 + 2048;
    const float* srcb = isctx ? ((l == 0) ? p.ctx : p.hc) : ((l == 0) ? p.x : p.out);
    float* dstb = isctx ? p.hc : p.out;
    const size_t rbase = isctx ? (size_t)b * TC : ((size_t)b * TL - TC);
#pragma unroll
    for (int ai = 0; ai < 2; ++ai)
#pragma unroll
      for (int bj = 0; bj < 2; ++bj)
#pragma unroll
        for (int m = 0; m < 4; ++m)
#pragma unroll
          for (int n = 0; n < 2; ++n) {
            const int col = bcol + bj * HALF + wc * 32 + n * 16 + fr; const float gt = gate[col];
#pragma unroll
            for (int j = 0; j < 4; ++j) {
              const int lr = ai * HALF + wr * 64 + m * 16 + fq * 4 + j; const int s = s0 + lr;
              const size_t off = (rbase + s) * 1024 + col;
              dstb[off] = srcb[off] + gt * acc[ai][bj][m][n][j];
            }
          }
  }
  __syncthreads();
#undef fr
#undef fq
#undef wr
#undef wc
#undef SA
#undef SB
#undef STAGE
#undef LDA
#undef LDB
#undef MMA
}

template <int MODE>
DI void gemm_phase(const int tix, const Params& p, int l, const u16* A, const u16* Bt, int nN, char* smem) {
  constexpr int nM = ROWS / BM;
  const int nwg = nM * nN; const bool last = (l == 1);
  for (int T = blockIdx.x; T < nwg; T += gridDim.x) {
    int wgid = T;
    { int q = nwg / NXCD, r = nwg % NXCD, xcd = wgid % NXCD, off = wgid / NXCD; wgid = (xcd < r ? xcd * (q + 1) : r * (q + 1) + (xcd - r) * q) + off; }
    int nig = WGM * nN, gid = wgid / nig, fm = gid * WGM, gsz = min(nM - fm, WGM);
    int pm = fm + ((wgid % nig) % gsz), pn = (wgid % nig) / gsz;
    const bool isctx = (pm % 17) == 0;
    if (last && isctx && (MODE == 1 || pn >= 6)) continue;
    gemm_tile<MODE>(tix, p, l, A, Bt, pm * BM, pn * BM, (u16*)smem);
  }
}
}

namespace at {
constexpr int NW = 8, QBLK = 32, KVBLK = 64;
constexpr float SCALE = 0.125f, THR = 8.f;
constexpr int LDQ = INW, LDK = INW, LDO = 1024;
constexpr int SHM_V = KVBLK * 128 * 2, SHM_K = KVBLK * 64 * 2;
#define KSWZ(row, colB) ((row) * 128 + ((colB) ^ (((row) & 7) << 4)))
#define SBAR() __builtin_amdgcn_sched_barrier(0)

DI void partialSM(f32x16& p0, f32x16& p1, float& m_reg, float& mn, float& alpha) {
  constexpr float C = SCALE * 1.4426950408889634f;
  float pmax = p0[0];
  for (int r = 1; r < 16; ++r) pmax = fmaxf(pmax, p0[r]);
  for (int r = 0; r < 16; ++r) pmax = fmaxf(pmax, p1[r]);
  { auto rr = __builtin_amdgcn_permlane32_swap(__float_as_uint(pmax), __float_as_uint(pmax), false, false);
    pmax = fmaxf(__uint_as_float(rr[0]), __uint_as_float(rr[1])); }
  if (__builtin_expect(__all(pmax - m_reg <= THR / SCALE), 1)) { mn = m_reg; alpha = 1.f; }
  else { mn = fmaxf(m_reg, pmax); alpha = __builtin_amdgcn_exp2f((m_reg - mn) * C); m_reg = mn; }
  float mnC = -mn * C;
  for (int r = 0; r < 16; ++r) p0[r] = fmaf(p0[r], C, mnC);
  for (int r = 0; r < 16; ++r) p1[r] = fmaf(p1[r], C, mnC);
  for (int r = 0; r < 16; ++r) p0[r] = __builtin_amdgcn_exp2f(p0[r]);
}
DI void finishSM(f32x16& p0, f32x16& p1, float alpha, float& l_reg, bf16x8& pa0, bf16x8& pa1, bf16x8& pa2, bf16x8& pa3) {
  for (int r = 0; r < 16; ++r) p1[r] = __builtin_amdgcn_exp2f(p1[r]);
  float ps = 0;
  for (int r = 0; r < 16; ++r) ps += p0[r];
  for (int r = 0; r < 16; ++r) ps += p1[r];
  { auto rr = __builtin_amdgcn_permlane32_swap(__float_as_uint(ps), __float_as_uint(ps), false, false);
    ps = __uint_as_float(rr[0]) + __uint_as_float(rr[1]); }
  l_reg = l_reg * alpha + ps;
#define PK4(P, BASE, OUT) do { unsigned a0 = cvtpk(P[BASE + 0], P[BASE + 1]), a1 = cvtpk(P[BASE + 2], P[BASE + 3]);   \
    unsigned b0 = cvtpk(P[BASE + 4], P[BASE + 5]), b1 = cvtpk(P[BASE + 6], P[BASE + 7]);                              \
    auto r0 = __builtin_amdgcn_permlane32_swap(a0, b0, false, false); auto r1 = __builtin_amdgcn_permlane32_swap(a1, b1, false, false); \
    u32x4 w = {r0[0], r1[0], r0[1], r1[1]}; OUT = *reinterpret_cast<bf16x8*>(&w); } while (0)
  PK4(p0, 0, pa0); PK4(p0, 8, pa1); PK4(p1, 0, pa2); PK4(p1, 8, pa3);
#undef PK4
}
DI void qkt(f32x16& p0, f32x16& p1, const char* Ks, const bf16x8* qr, int r32, int hi) {
  p0 = f32x16{}; p1 = f32x16{};
#pragma unroll
  for (int d0 = 0; d0 < 4; ++d0) { int cb = (d0 * 16 + hi * 8) * 2;
    bf16x8 b0 = *reinterpret_cast<const bf16x8*>(Ks + KSWZ(r32, cb));
    bf16x8 b1 = *reinterpret_cast<const bf16x8*>(Ks + KSWZ(32 + r32, cb));
    p0 = MFMA32(b0, qr[d0], p0);
    p1 = MFMA32(b1, qr[d0], p1); }
}
DI int v_st(int k, int c) { const int kk = (k & ~0xC) | ((k & 4) << 1) | ((k & 8) >> 1); return ((kk >> 3) * 4 + (c >> 5)) * 512 + ((kk & 7) * 32 + (c & 31)) * 2; }
DI int v_rd_base(int lane) { return ((lane & 3) << 3) | (((lane >> 2) & 3) << 6) | (((lane >> 4) & 1) << 5) | (((lane >> 5) & 1) << 8); }
constexpr int v_rd_off(int d0, int ks, int half) { return d0 * 512 + ks * 4096 + half * 2048; }
template <int OFF> DI s16x4 tr_read(int vb) {
  s16x4 r; asm volatile("ds_read_b64_tr_b16 %0, %1 offset:%2" : "=&v"(r) : "v"(vb), "i"(OFF) : "memory"); return r;
}
template <int D0> DI void pv_one(f32x16& od, int vb, bf16x8 pa0, bf16x8 pa1, bf16x8 pa2, bf16x8 pa3) {
  const s16x4 l0 = tr_read<v_rd_off(D0, 0, 0)>(vb), h0 = tr_read<v_rd_off(D0, 0, 1)>(vb), l1 = tr_read<v_rd_off(D0, 1, 0)>(vb), h1 = tr_read<v_rd_off(D0, 1, 1)>(vb);
  const s16x4 l2 = tr_read<v_rd_off(D0, 2, 0)>(vb), h2 = tr_read<v_rd_off(D0, 2, 1)>(vb), l3 = tr_read<v_rd_off(D0, 3, 0)>(vb), h3 = tr_read<v_rd_off(D0, 3, 1)>(vb);
  asm volatile("s_waitcnt lgkmcnt(0)" ::: "memory"); SBAR();
#define PK(L, H) (bf16x8){L[0], L[1], L[2], L[3], H[0], H[1], H[2], H[3]}
  od = MFMA32(pa0, PK(l0, h0), od);
  od = MFMA32(pa1, PK(l1, h1), od);
  od = MFMA32(pa2, PK(l2, h2), od);
  od = MFMA32(pa3, PK(l3, h3), od);
#undef PK
}
DI void pv_d0(f32x16* o, int vb, bf16x8 pa0, bf16x8 pa1, bf16x8 pa2, bf16x8 pa3) {
  pv_one<0>(o[0], vb, pa0, pa1, pa2, pa3); pv_one<1>(o[1], vb, pa0, pa1, pa2, pa3); pv_one<2>(o[2], vb, pa0, pa1, pa2, pa3); pv_one<3>(o[3], vb, pa0, pa1, pa2, pa3);
}

DI void attn_body(const int tix, const u16* __restrict__ Qb, const u16* __restrict__ Kh, const u16* __restrict__ Vh, u16* __restrict__ Ob, int seq, char* lds) {
  const int tid = tix, wid = tid >> 6, lane = tid & 63, r32 = lane & 31, hi = lane >> 5;
  char* V_lds = lds; char* K_lds = lds + 2 * SHM_V;
  float* ws = (float*)(lds + 2 * SHM_V + 2 * SHM_K) + wid * 64; float* li_l = ws; float* al_l = ws + 32;
  float m_reg = -1e30f, l_reg = 0; f32x16 o[4] = {}; bf16x8 qr[4];
  const u16* Qw = Qb + (long)(wid * QBLK + r32) * LDQ + hi * 8;
#pragma unroll
  for (int d0 = 0; d0 < 4; ++d0) qr[d0] = *reinterpret_cast<const bf16x8*>(Qw + d0 * 16);
  const int sr = tid >> 4, sc = (tid & 15) * 8, vst0 = v_st(sr, sc), vst1 = v_st(32 + sr, sc);
  const int ksr = tid >> 3, ksc = (tid & 7) * 8, kst = KSWZ(ksr, ksc * 2);
  const int vb0 = (int)(uintptr_t)V_lds + v_rd_base(lane);
  struct { bf16x8 vs0, vs1, ks0; } sr_[2];
#define SLOAD(i, k0) do { sr_[i].vs0 = *reinterpret_cast<const bf16x8*>(&Vh[(long)((k0) + sr) * LDK + sc]); sr_[i].vs1 = *reinterpret_cast<const bf16x8*>(&Vh[(long)((k0) + 32 + sr) * LDK + sc]); \
    sr_[i].ks0 = *reinterpret_cast<const bf16x8*>(&Kh[(long)((k0) + ksr) * LDK + ksc]); } while (0)
#define SWRITE(b, i) do { *(bf16x8*)(V_lds + (b) * SHM_V + vst0) = sr_[i].vs0;          \
    *(bf16x8*)(V_lds + (b) * SHM_V + vst1) = sr_[i].vs1;               \
    *(bf16x8*)(K_lds + (b) * SHM_K + kst) = sr_[i].ks0; } while (0)
#define SWAIT() asm volatile("s_waitcnt vmcnt(3)" ::: "memory")
#define RESC(a) do { if (__any((a) < 1.f)) { if (hi == 0) al_l[r32] = (a); asm volatile("s_waitcnt lgkmcnt(0)" ::: "memory"); \
    for (int d = 0; d < 4; ++d) for (int r = 0; r < 16; ++r) o[d][r] *= al_l[crow(r, hi)]; } } while (0)
  f32x16 pA0, pA1, pB0, pB1; float mnA, mnB, alA, alB; bf16x8 pa0, pa1, pa2, pa3; const int NT = seq / KVBLK;
  constexpr int SE = 0, SO = 1;
  SLOAD(SE, 0); asm volatile("s_waitcnt vmcnt(0)" ::: "memory"); SWRITE(0, SE); __syncthreads();
  qkt(pA0, pA1, K_lds, qr, r32, hi); partialSM(pA0, pA1, m_reg, mnA, alA);
  SLOAD(SO, KVBLK); if (2 < NT) SLOAD(SE, 2 * KVBLK);
  SWAIT(); SWRITE(1, SO); __syncthreads();
  for (int j = 1; j + 1 < NT; j += 2) {
    SBAR(); qkt(pB0, pB1, K_lds + SHM_K, qr, r32, hi);
    finishSM(pA0, pA1, alA, l_reg, pa0, pa1, pa2, pa3); SBAR();
    SLOAD(SO, (j + 2) * KVBLK); SBAR();
    pv_d0(o, vb0, pa0, pa1, pa2, pa3); partialSM(pB0, pB1, m_reg, mnB, alB);
    __syncthreads(); SWAIT(); SWRITE(0, SE);
    RESC(alB); __syncthreads();
    SBAR(); qkt(pA0, pA1, K_lds, qr, r32, hi);
    finishSM(pB0, pB1, alB, l_reg, pa0, pa1, pa2, pa3); SBAR();
    if (j + 3 < NT) SLOAD(SE, (j + 3) * KVBLK); SBAR();
    pv_d0(o, vb0 + (int)SHM_V, pa0, pa1, pa2, pa3); partialSM(pA0, pA1, m_reg, mnA, alA);
    __syncthreads(); SWAIT(); SWRITE(1, SO);
    RESC(alA); __syncthreads();
  }
  SBAR(); qkt(pB0, pB1, K_lds + SHM_K, qr, r32, hi);
  finishSM(pA0, pA1, alA, l_reg, pa0, pa1, pa2, pa3); SBAR();
  pv_d0(o, vb0, pa0, pa1, pa2, pa3); partialSM(pB0, pB1, m_reg, mnB, alB);
  __syncthreads(); RESC(alB);
  finishSM(pB0, pB1, alB, l_reg, pa0, pa1, pa2, pa3); SBAR();
  pv_d0(o, vb0 + (int)SHM_V, pa0, pa1, pa2, pa3);
  if (hi == 0) li_l[r32] = l_reg; asm volatile("s_waitcnt lgkmcnt(0)" ::: "memory");
  float rli[16];
#pragma unroll
  for (int r = 0; r < 16; ++r) rli[r] = __builtin_amdgcn_rcpf(li_l[crow(r, hi)]);
  u16* Ow = Ob + (long)(wid * QBLK) * LDO;
#pragma unroll
  for (int r = 0; r < 16; ++r) { int orow = crow(r, hi);
#pragma unroll
    for (int d0 = 0; d0 < 4; ++d0) Ow[(long)orow * LDO + d0 * 32 + r32] = f2bf(o[d0][r] * rli[r]); }
  __syncthreads();
#undef SLOAD
#undef SWRITE
#undef SWAIT
#undef RESC
}
}

DI int smap(int sigma, int dir) { return dir == 0 ? sigma : (sigma < TC ? (TC - 1 - sigma) : (SEQ + TC - 1 - sigma)); }

DI float fsig(float v) { return __builtin_amdgcn_rcpf(1.f + __builtin_amdgcn_exp2f(-1.4426950408889634f * v)); }
DI u16 bfr(float x) { return (u16)(cvtpk(x, x) & 0xffffu); }
#define WAVE_SYNC() do { __builtin_amdgcn_fence(__ATOMIC_RELEASE, "wavefront"); __builtin_amdgcn_wave_barrier(); __builtin_amdgcn_fence(__ATOMIC_ACQUIRE, "wavefront"); } while (0)

DI void lru_wg_item(const int tix, const Params& p, int l, int item, char* smem) {
  const int wid = __builtin_amdgcn_readfirstlane(tix >> 6), lane = tix & 63, r = lane & 31, h = lane >> 5;
  const int b = item >> 4, dir = (item >> 3) & 1, n = (item >> 1) & 3, half = item & 1;
  char* wlds = smem + wid * 9216;
  u16* xcb = (u16*)wlds;
  float* xcf = (float*)(wlds + 32 * 144);
  float* exch = (float*)(smem + 8 * 9216);
  const int ld = l * 2 + dir;
  bf16x8 wa[4], wx[4];
  { const u16* wt = p.lruWT + (size_t)(((ld * 4 + n) * 2) * 4096) + (half * 32 + r) * 64 + 8 * h;
#pragma unroll
    for (int s = 0; s < 4; ++s) { wa[s] = *reinterpret_cast<const bf16x8*>(wt + 16 * s); wx[s] = *reinterpret_cast<const bf16x8*>(wt + 4096 + 16 * s); } }
  const int ch = n * 64 + half * 32 + r;
  const float ba = p.lru_ba[ld * 256 + ch], bx = p.lru_bx[ld * 256 + ch];
  const float sp8l = 8.f * 1.4426950408889634f * log1pf(expf(-p.lru_lam[ld * 256 + ch]));
  const int cch = n * 64 + lane;
  const float cw0 = p.conv_w[(l * 4 + 0) * 256 + cch], cw1 = p.conv_w[(l * 4 + 1) * 256 + cch], cw2 = p.conv_w[(l * 4 + 2) * 256 + cch], cw3 = p.conv_w[(l * 4 + 3) * 256 + cch];
  const float cbias = p.conv_b[l * 256 + cch];
  const u16* ubase = p.pbuf + (size_t)b * SEQ * INW + C_UA + cch;
  u16* hout = p.hl + ((size_t)dir * ROWS + (size_t)b * SEQ) * 256 + ch;
  float sc = 0.f;
  u16 un[35];
  { const int sg = wid * 32; const int smin0 = dir == 0 ? sg : smap(sg + 31, 1);
#pragma unroll
    for (int k = 0; k < 35; ++k) { int s = smin0 - 2 + k; s = s < 0 ? 0 : (s > SEQ - 1 ? SEQ - 1 : s); un[k] = ubase[(size_t)s * INW]; } }
  for (int st = 0; st < SEQ / 256; ++st) {
    const int sg0 = st * 256 + wid * 32;
    const int smin = dir == 0 ? sg0 : smap(sg0 + 31, 1);
    const int seg_lo = smin < TC ? 0 : TC, seg_hi = smin < TC ? TC : SEQ;
    float uw[35];
#pragma unroll
    for (int k = 0; k < 35; ++k) { const int s = smin - 2 + k; uw[k] = (s >= seg_lo && s < seg_hi) ? bf2f(un[k]) : 0.f; }
    if (st + 1 < SEQ / 256) {
      const int smin1 = dir == 0 ? sg0 + 256 : smap(sg0 + 256 + 31, 1);
#pragma unroll
      for (int k = 0; k < 35; ++k) { int s = smin1 - 2 + k; s = s < 0 ? 0 : (s > SEQ - 1 ? SEQ - 1 : s); un[k] = ubase[(size_t)s * INW]; }
    }
#pragma unroll
    for (int i = 0; i < 32; ++i) {
      const float xc = cbias + cw0 * uw[i] + cw1 * uw[i + 1] + cw2 * uw[i + 2] + cw3 * uw[i + 3];
      const int m = dir ? 31 - i : i;
      xcb[m * 72 + lane] = bfr(xc);
      if ((lane >> 5) == half) xcf[m * 33 + (lane & 31)] = xc;
    }
    WAVE_SYNC();
    f32x16 ga = {}, gx = {};
#pragma unroll
    for (int s = 0; s < 4; ++s) {
      const bf16x8 a = *reinterpret_cast<const bf16x8*>(xcb + r * 72 + 16 * s + 8 * h);
      ga = MFMA32(a, wa[s], ga); gx = MFMA32(a, wx[s], gx);
    }
    float av[16], hv[16], cum[16];
#pragma unroll
    for (int i = 0; i < 16; ++i) {
      const int m = crow(i, h);
      const float xv = xcf[m * 33 + r];
      const float rr = fsig(ga[i] + ba), ii = fsig(gx[i] + bx);
      const float a = __builtin_amdgcn_exp2f(-sp8l * rr);
      av[i] = a;
      hv[i] = __builtin_amdgcn_sqrtf(fmaxf(1.f - a * a, 0.f)) * (ii * xv);
    }
    float Ag[4], Bg[4];
#pragma unroll
    for (int g = 0; g < 4; ++g) {
      cum[4 * g] = av[4 * g];
#pragma unroll
      for (int j = 1; j < 4; ++j) { hv[4 * g + j] = av[4 * g + j] * hv[4 * g + j - 1] + hv[4 * g + j]; cum[4 * g + j] = cum[4 * g + j - 1] * av[4 * g + j]; }
      Ag[g] = cum[4 * g + 3]; Bg[g] = hv[4 * g + 3];
    }
    float cin0[4], pre[4];
    float cc = 0.f, pp = 1.f;
#pragma unroll
    for (int g = 0; g < 4; ++g) {
      const float oA = __shfl_xor(Ag[g], 32), oB = __shfl_xor(Bg[g], 32);
      const float A0 = h ? oA : Ag[g], B0 = h ? oB : Bg[g], A1 = h ? Ag[g] : oA, B1 = h ? Bg[g] : oB;
      const float c0 = cc, p0 = pp; cc = A0 * cc + B0; pp = A0 * pp;
      const float c1 = cc, p1 = pp; cc = A1 * cc + B1; pp = A1 * pp;
      cin0[g] = h ? c1 : c0; pre[g] = h ? p1 : p0;
    }
    if (h == 0) { exch[(wid * 32 + r) * 2] = pp; exch[(wid * 32 + r) * 2 + 1] = cc; }
    __syncthreads();
    float tc = sc, mycin = sc;
#pragma unroll
    for (int j = 0; j < 8; ++j) { const float Aj = exch[(j * 32 + r) * 2], Bj = exch[(j * 32 + r) * 2 + 1]; if (j == wid) mycin = tc; tc = Aj * tc + Bj; }
    sc = tc;
#pragma unroll
    for (int i = 0; i < 16; ++i) {
      const float hf = hv[i] + cum[i] * (cin0[i >> 2] + pre[i >> 2] * mycin);
      const int s = smap(sg0 + crow(i, h), dir);
      hout[(size_t)s * 256] = bfr(hf);
    }
    __syncthreads();
  }
}

DI void s5_wg_item(const int tix, const Params& p, int l, int item, char* smem) {
  const int wid = __builtin_amdgcn_readfirstlane(tix >> 6), lane = tix & 63, r = lane & 31, h = lane >> 5;
  const int b = item >> 5, dir = (item >> 4) & 1, g = item & 15;
  const int ldg = (l * 2 + dir) * 16 + g;
  u16* Sl = (u16*)(smem + wid * 9216);
  float* exch = (float*)(smem + 8 * 9216);
  bf16x8 bb[4], cf[4];
  const int c16 = lane & 15, kq = lane >> 4;
#pragma unroll
  for (int nt = 0; nt < 4; ++nt) bb[nt] = *reinterpret_cast<const bf16x8*>(p.bbT + ((size_t)(ldg * 2 + (nt >> 1)) * 64 + (nt & 1) * 32 + r) * 16 + 8 * h);
#pragma unroll
  for (int s = 0; s < 4; ++s) cf[s] = *reinterpret_cast<const bf16x8*>(p.cc + ((size_t)ldg * 16 + c16) * 128 + 32 * s + 8 * kq);
  float ar[2][4], ai[2][4];
  float a8r_[2], a8i_[2];
  float a32r[2], a32i[2];
#pragma unroll
  for (int st = 0; st < 2; ++st) {
    const float a_r = p.sa[((size_t)ldg * 64 + st * 32 + r) * 2], a_i = p.sa[((size_t)ldg * 64 + st * 32 + r) * 2 + 1];
    ar[st][0] = a_r; ai[st][0] = a_i;
#pragma unroll
    for (int k = 1; k < 4; ++k) { ar[st][k] = ar[st][k - 1] * a_r - ai[st][k - 1] * a_i; ai[st][k] = ar[st][k - 1] * a_i + ai[st][k - 1] * a_r; }
    const float a4r = ar[st][3], a4i = ai[st][3];
    const float a8r = a4r * a4r - a4i * a4i, a8i = 2.f * a4r * a4i;
    a8r_[st] = a8r; a8i_[st] = a8i;
    const float a16r = a8r * a8r - a8i * a8i, a16i = 2.f * a8r * a8i;
    a32r[st] = a16r * a16r - a16i * a16i; a32i[st] = 2.f * a16r * a16i;
  }
  float scr[2] = {0.f, 0.f}, sci[2] = {0.f, 0.f};
  const u16* ubase = p.pbuf + (size_t)b * SEQ * INW + C_US + g * 16 + 8 * h;
  u16* yout = p.ys + ((size_t)dir * ROWS + (size_t)b * SEQ) * 256 + g * 16 + c16;
  bf16x8 uan = *reinterpret_cast<const bf16x8*>(ubase + (size_t)smap(wid * 32 + r, dir) * INW);
  for (int st_ = 0; st_ < SEQ / 256; ++st_) {
    const int sg0 = st_ * 256 + wid * 32;
    const bf16x8 ua = uan;
    { const int sgn = (st_ + 1 < SEQ / 256) ? sg0 + 256 : sg0; uan = *reinterpret_cast<const bf16x8*>(ubase + (size_t)smap(sgn + r, dir) * INW); }
    f32x16 z16 = {};
    f32x16 sre[2], sim[2];
    sre[0] = MFMA32(ua, bb[0], z16); sre[1] = MFMA32(ua, bb[1], z16); sim[0] = MFMA32(ua, bb[2], z16); sim[1] = MFMA32(ua, bb[3], z16);
    float cinr[2][4], cini[2][4];
#pragma unroll
    for (int st = 0; st < 2; ++st) {
      const float a_r = ar[st][0], a_i = ai[st][0];
      float Er[4], Ei[4];
#pragma unroll
      for (int g4 = 0; g4 < 4; ++g4) {
#pragma unroll
        for (int j = 1; j < 4; ++j) {
          const float pr = sre[st][4 * g4 + j - 1], pi = sim[st][4 * g4 + j - 1];
          sre[st][4 * g4 + j] += a_r * pr - a_i * pi;
          sim[st][4 * g4 + j] += a_r * pi + a_i * pr;
        }
        Er[g4] = sre[st][4 * g4 + 3]; Ei[g4] = sim[st][4 * g4 + 3];
      }
      float c_r = 0.f, c_i = 0.f;
      const float a4r = ar[st][3], a4i = ai[st][3];
#pragma unroll
      for (int g4 = 0; g4 < 4; ++g4) {
        const float oEr = __shfl_xor(Er[g4], 32), oEi = __shfl_xor(Ei[g4], 32);
        const float E0r = h ? oEr : Er[g4], E0i = h ? oEi : Ei[g4], E1r = h ? Er[g4] : oEr, E1i = h ? Ei[g4] : oEi;
        const float c0r = c_r, c0i = c_i;
        float nr = a4r * c_r - a4i * c_i + E0r, ni = a4r * c_i + a4i * c_r + E0i; c_r = nr; c_i = ni;
        const float c1r = c_r, c1i = c_i;
        nr = a4r * c_r - a4i * c_i + E1r; ni = a4r * c_i + a4i * c_r + E1i; c_r = nr; c_i = ni;
        cinr[st][g4] = h ? c1r : c0r; cini[st][g4] = h ? c1i : c0i;
      }
      if (h == 0) { exch[(wid * 32 + r) * 4 + st * 2] = c_r; exch[(wid * 32 + r) * 4 + st * 2 + 1] = c_i; }
    }
    __syncthreads();
#pragma unroll
    for (int st = 0; st < 2; ++st) {
      float tr = scr[st], ti = sci[st], mr = tr, mi = ti;
#pragma unroll
      for (int j = 0; j < 8; ++j) {
        const float er = exch[(j * 32 + r) * 4 + st * 2], ei = exch[(j * 32 + r) * 4 + st * 2 + 1];
        if (j == wid) { mr = tr; mi = ti; }
        const float nr = a32r[st] * tr - a32i[st] * ti + er, ni = a32r[st] * ti + a32i[st] * tr + ei; tr = nr; ti = ni;
      }
      scr[st] = tr; sci[st] = ti;
      float qr = h ? (ar[st][3] * mr - ai[st][3] * mi) : mr, qi = h ? (ar[st][3] * mi + ai[st][3] * mr) : mi;
#pragma unroll
      for (int g4 = 0; g4 < 4; ++g4) {
        const float cr_ = cinr[st][g4] + qr, ci_ = cini[st][g4] + qi;
        { const float nq = a8r_[st] * qr - a8i_[st] * qi; qi = a8r_[st] * qi + a8i_[st] * qr; qr = nq; }
#pragma unroll
        for (int j = 0; j < 4; ++j) {
          const int i = 4 * g4 + j;
          const float vr = sre[st][i] + ar[st][j] * cr_ - ai[st][j] * ci_;
          const float vi = sim[st][i] + ar[st][j] * ci_ + ai[st][j] * cr_;
          const int m = crow(i, h);
          const unsigned w = cvtpk(vr, vi);
          Sl[m * 136 + st * 32 + r] = (u16)(w & 0xffffu);
          Sl[m * 136 + 64 + st * 32 + r] = (u16)(w >> 16);
        }
      }
    }
    WAVE_SYNC();
#pragma unroll
    for (int mt = 0; mt < 2; ++mt) {
      f32x4 y = {};
#pragma unroll
      for (int s = 0; s < 4; ++s) {
        const bf16x8 a = *reinterpret_cast<const bf16x8*>(Sl + (mt * 16 + c16) * 136 + 32 * s + 8 * kq);
        y = __builtin_amdgcn_mfma_f32_16x16x32_bf16(a, cf[s], y, 0, 0, 0);
      }
#pragma unroll
      for (int j = 0; j < 4; ++j) { const int s = smap(sg0 + mt * 16 + kq * 4 + j, dir); yout[(size_t)s * 256] = f2bf(y[j]); }
    }
    __syncthreads();
  }
}

DI void phase_mix(const int tix, const Params& p, int l, char* smem, int* s_item, int cbase = 0) {
  const int tid = tix, wid = __builtin_amdgcn_readfirstlane(tid >> 6);
#define NEXT_ITEM(cidx) if (tid == 0) *s_item = atomicAdd(&p.counters[l * 8 + cbase + (cidx)], 1); __syncthreads(); const int item = *s_item; __syncthreads();
  for (int rep = 0; rep < ((PROBE_DUP & 1) ? 2 : 1); ++rep)
  for (;;) { NEXT_ITEM(0 + 3 * rep); if (item >= 128) break; lru_wg_item(tix, p, l, item, smem); }
  for (int rep = 0; rep < ((PROBE_DUP & 2) ? 2 : 1); ++rep)
  for (;;) { NEXT_ITEM(1 + 3 * rep); if (item >= 256) break; s5_wg_item(tix, p, l, item, smem); }
  const int n_att = 1024 + (l == 0 ? 64 : 0);
  for (int rep = 0; rep < ((PROBE_DUP & 4) ? 2 : 1); ++rep)
  for (;;) {
    NEXT_ITEM(2 + 3 * rep); if (item >= n_att) break;
    int b, hm, q0, seq;
    if (item < 1024) { const int qb = item & 15; hm = (item >> 4) & 7; b = item >> 7; q0 = TC + qb * 256; seq = SEQ; }
    else { const int a = item - 1024; hm = a & 7; b = a >> 3; q0 = 0; seq = TC; }
    const u16* base = p.pbuf + (size_t)b * SEQ * INW;
    at::attn_body(tix, base + (size_t)q0 * INW + C_Q + hm * 64, base + C_K + hm * 64, base + C_V + (hm >> 1) * 128,
                  p.obuf + ((size_t)b * SEQ + q0) * 1024 + hm * 128, seq, smem);
  }
#undef NEXT_ITEM
}

DI void unpack8(const bf16x8 v, float* f) {
#pragma unroll
  for (int k = 0; k < 8; ++k) f[k] = bf2f((u16)v[k]);
}
DI bf16x8 pack8(const float* f) {
  u32x4 w = {cvtpk(f[0], f[1]), cvtpk(f[2], f[3]), cvtpk(f[4], f[5]), cvtpk(f[6], f[7])};
  return *reinterpret_cast<bf16x8*>(&w);
}
DI void phase_combine(const int tix, const Params& p, int l, char* smem) {
  const int tid = tix, wid = tid >> 6, lane = tid & 63, r = lane & 31, h = lane >> 5;
  float* zf = (float*)smem;
  u16* zb = (u16*)(smem + 32 * 260 * 4);
  const float lam = p.lamv[l], onem = 1.f - p.lamv[2 + l];
  bf16x8 wg[16];
  { const u16* wt = p.wgluT + (size_t)l * 65536 + (size_t)(wid * 32 + r) * 256 + 8 * h;
#pragma unroll
    for (int s = 0; s < 16; ++s) wg[s] = *reinterpret_cast<const bf16x8*>(wt + 16 * s); }
  const float bglu = p.s5_b_glu[l * 256 + wid * 32 + r];
  const size_t DSTRIDE = (size_t)ROWS * 256;
  for (int item = blockIdx.x; item < ROWS / 32; item += gridDim.x) {
    const int row0 = item * 32;
    if (l == 1 && (row0 % SEQ) < TC) continue;
#pragma unroll
    for (int i = 0; i < 2; ++i) {
      const int id = tid + NTHR * i, rr = id >> 5, c8 = (id & 31) * 8; const size_t row = row0 + rr;
      const u16* pr = p.pbuf + row * INW;
      float h0[8], h1[8], y0[8], y1[8], ga[8], us[8], o[8], z[8];
      unpack8(*reinterpret_cast<const bf16x8*>(p.hl + row * 256 + c8), h0);
      unpack8(*reinterpret_cast<const bf16x8*>(p.hl + DSTRIDE + row * 256 + c8), h1);
      unpack8(*reinterpret_cast<const bf16x8*>(p.ys + row * 256 + c8), y0);
      unpack8(*reinterpret_cast<const bf16x8*>(p.ys + DSTRIDE + row * 256 + c8), y1);
      unpack8(*reinterpret_cast<const bf16x8*>(pr + C_GA + c8), ga);
      unpack8(*reinterpret_cast<const bf16x8*>(pr + C_US + c8), us);
      const f32x4 d0 = *reinterpret_cast<const f32x4*>(p.s5_d + l * 256 + c8), d1 = *reinterpret_cast<const f32x4*>(p.s5_d + l * 256 + c8 + 4);
#pragma unroll
      for (int k = 0; k < 8; ++k) {
        o[k] = (h0[k] + h1[k]) * silu_f(ga[k]);
        z[k] = gelu_tanh((k < 4 ? d0[k] : d1[k - 4]) * us[k] + y0[k] + y1[k]);
      }
      *reinterpret_cast<bf16x8*>(p.nbuf + row * 1024 + c8) = pack8(o);
      *reinterpret_cast<f32x4*>(zf + rr * 260 + c8) = f32x4{z[0], z[1], z[2], z[3]};
      *reinterpret_cast<f32x4*>(zf + rr * 260 + c8 + 4) = f32x4{z[4], z[5], z[6], z[7]};
      *reinterpret_cast<bf16x8*>(zb + rr * 264 + c8) = pack8(z);
    }
    __syncthreads();
    f32x16 acc = {};
#pragma unroll
    for (int s = 0; s < 16; ++s) {
      const bf16x8 a = *reinterpret_cast<const bf16x8*>(zb + r * 264 + 16 * s + 8 * h);
      acc = MFMA32(a, wg[s], acc);
    }
#pragma unroll
    for (int i = 0; i < 16; ++i) {
      const int m = crow(i, h), col = wid * 32 + r;
      const float zz = zf[m * 260 + col];
      zf[m * 260 + col] = zz * sigmoid_f(acc[i] + bglu);
    }
    __syncthreads();
#pragma unroll
    for (int i = 0; i < 2; ++i) {
      const int id = tid + NTHR * i, rr = id >> 5, c8 = (id & 31) * 8; const size_t row = row0 + rr;
      float gs[8], o[8];
      unpack8(*reinterpret_cast<const bf16x8*>(p.pbuf + row * INW + C_GS + c8), gs);
      const f32x4 g0 = *reinterpret_cast<const f32x4*>(zf + rr * 260 + c8), g1 = *reinterpret_cast<const f32x4*>(zf + rr * 260 + c8 + 4);
#pragma unroll
      for (int k = 0; k < 8; ++k) o[k] = (k < 4 ? g0[k] : g1[k - 4]) * silu_f(gs[k]);
      *reinterpret_cast<bf16x8*>(p.nbuf + row * 1024 + 256 + c8) = pack8(o);
    }
#pragma unroll
    for (int it = 0; it < 4; ++it) {
      const int pair = (tid >> 4) + 32 * it, rr = pair >> 2, head = pair & 3, e8 = (tid & 15) * 8; const size_t row = row0 + rr;
      float o1[8], o2[8], gd[8], v[8], o[8];
      unpack8(*reinterpret_cast<const bf16x8*>(p.obuf + row * 1024 + head * 256 + e8), o1);
      unpack8(*reinterpret_cast<const bf16x8*>(p.obuf + row * 1024 + head * 256 + 128 + e8), o2);
      unpack8(*reinterpret_cast<const bf16x8*>(p.pbuf + row * INW + C_GD + head * 128 + e8), gd);
      const f32x4 n0 = *reinterpret_cast<const f32x4*>(p.da_norm_g + l * 128 + e8), n1 = *reinterpret_cast<const f32x4*>(p.da_norm_g + l * 128 + e8 + 4);
      float ss = 0.f;
#pragma unroll
      for (int k = 0; k < 8; ++k) { v[k] = o1[k] - lam * o2[k]; ss += v[k] * v[k]; }
      ss += __shfl_xor(ss, 1); ss += __shfl_xor(ss, 2); ss += __shfl_xor(ss, 4); ss += __shfl_xor(ss, 8);
      const float rinv = rsqrtf(ss * (1.f / 128.f) + EPS) * onem;
#pragma unroll
      for (int k = 0; k < 8; ++k) o[k] = v[k] * rinv * (k < 4 ? n0[k] : n1[k - 4]) * silu_f(gd[k]);
      *reinterpret_cast<bf16x8*>(p.nbuf + row * 1024 + 512 + head * 128 + e8) = pack8(o);
    }
    __syncthreads();
  }
}

DI void phase_final(const int tix, const Params& p) {
  const int wid = tix >> 6, lane = tix & 63;
  for (int row = blockIdx.x * 8 + wid; row < NB * TL; row += gridDim.x * 8) {
    float* src = p.out + (size_t)row * 1024;
    f32x4 v[4]; float ss = 0.f;
#pragma unroll
    for (int i = 0; i < 4; ++i) { v[i] = *(const f32x4*)(src + i * 256 + lane * 4); ss += v[i][0] * v[i][0] + v[i][1] * v[i][1] + v[i][2] * v[i][2] + v[i][3] * v[i][3]; }
    ss = wave_sum(ss);
    const float r = rsqrtf(ss * (1.f / 1024.f) + EPS);
#pragma unroll
    for (int i = 0; i < 4; ++i) {
      f32x4 gg = *(const f32x4*)(p.final_g + i * 256 + lane * 4);
      f32x4 o = {v[i][0] * r * gg[0], v[i][1] * r * gg[1], v[i][2] * r * gg[2], v[i][3] * r * gg[3]};
      *(f32x4*)(src + i * 256 + lane * 4) = o;
    }
  }
}

#if MULTI
template <int K> __global__ void __launch_bounds__(NTHR) phase_kernel(Params p, int ph) {
  extern __shared__ __attribute__((aligned(16))) char smem[];
  __shared__ int s_item;
  const int wid_s = __builtin_amdgcn_readfirstlane((int)__builtin_amdgcn_workitem_id_x() >> 6);
  const int l = (ph - 1) / 5;
  if (K == 0) phase_prep(tid_opaque(wid_s), p, smem);
  else if (K == 6) phase_final(tid_opaque(wid_s), p);
  else if (K == 1) phase_norm(tid_opaque(wid_s), p, l);
  else if (K == 2) gm::gemm_phase<0>(tid_opaque(wid_s), p, l, p.nbuf, p.winT + (size_t)l * 3072 * 1024, 12, smem);
  else if (K == 3) phase_mix(tid_opaque(wid_s), p, l, smem, &s_item);
  else if (K == 4) phase_combine(tid_opaque(wid_s), p, l, smem);
  else gm::gemm_phase<1>(tid_opaque(wid_s), p, l, p.nbuf, p.woutT + (size_t)l * 1024 * 1024, 4, smem);
}
template <int K> static void launch_phase(const Params& p, int ph, hipStream_t stream) {
  (void)hipFuncSetAttribute((const void*)phase_kernel<K>, hipFuncAttributeMaxDynamicSharedMemorySize, LDS_BYTES);
  hipLaunchKernelGGL(phase_kernel<K>, dim3(256), dim3(NTHR), LDS_BYTES, stream, p, ph);
}
#else
__global__ void __launch_bounds__(NTHR) mega_kernel(Params p) {
  extern __shared__ __attribute__((aligned(16))) char smem[];
  __shared__ int s_item;
  const int wid_s = __builtin_amdgcn_readfirstlane((int)__builtin_amdgcn_workitem_id_x() >> 6);
  cg::grid_group grid = cg::this_grid();
  for (int rep = 0; rep < ((PROBE_DUP & 64) ? 2 : 1); ++rep) { phase_prep(tid_opaque(wid_s), p, smem); grid.sync(); }
  for (int l = 0; l < 2; ++l) {
    for (int rep = 0; rep < ((PROBE_DUP & 8) ? 2 : 1); ++rep) { phase_norm(tid_opaque(wid_s), p, l); grid.sync(); }
    for (int rep = 0; rep < ((PROBE_DUP & 16) ? 2 : 1); ++rep) { gm::gemm_phase<0>(tid_opaque(wid_s), p, l, p.nbuf, p.winT + (size_t)l * 3072 * 1024, 12, smem); grid.sync(); }
    for (int rep = 0; rep < ((PROBE_DUP & 128) ? 2 : 1); ++rep) { phase_mix(tid_opaque(wid_s), p, l, smem, &s_item, rep * 3); grid.sync(); }
    for (int rep = 0; rep < ((PROBE_DUP & 32) ? 2 : 1); ++rep) { phase_combine(tid_opaque(wid_s), p, l, smem); grid.sync(); }
    for (int rep = 0; rep < (((PROBE_DUP & 256) && l == 0) ? 2 : 1); ++rep) { gm::gemm_phase<1>(tid_opaque(wid_s), p, l, p.nbuf, p.woutT + (size_t)l * 1024 * 1024, 4, smem); grid.sync(); }
  }
  phase_final(tid_opaque(wid_s), p);
}
#endif

extern "C" void kernel_launch(void* const* d_in, const int* in_sizes, int n_in, void* d_out, int out_size, void* d_ws, size_t ws_size, hipStream_t stream) {
  Params p{};
  const float** pf = (const float**)&p;
  for (int i = 0; i < 29; ++i) pf[i] = (const float*)d_in[i];
  p.out = (float*)d_out;
  char* w = (char*)d_ws; size_t off = 0;
  auto take = [&](size_t bytes) { char* r = w + off; off += (bytes + 255) & ~(size_t)255; return r; };
  p.nbuf = (u16*)take((size_t)ROWS * 1024 * 2);
  p.pbuf = (u16*)take((size_t)ROWS * INW * 2);
  p.hl = (u16*)take((size_t)2 * ROWS * 256 * 2);
  p.ys = (u16*)take((size_t)2 * ROWS * 256 * 2);
  p.obuf = (u16*)take((size_t)ROWS * 1024 * 2);
  p.winT = (u16*)take((size_t)2 * 3072 * 1024 * 2);
  p.woutT = (u16*)take((size_t)2 * 1024 * 1024 * 2);
  p.wgluT = (u16*)take((size_t)2 * 65536 * 2);
  p.bbT = (u16*)take((size_t)64 * 2 * 64 * 16 * 2);
  p.cc = (u16*)take((size_t)131072 * 2);
  p.lruWT = (u16*)take((size_t)32 * 4096 * 2);
  p.hc = (float*)take((size_t)NB * TC * 1024 * 4);
  p.mod = (float*)take((size_t)2 * 9 * 3072 * 4);
  p.sa = (float*)take((size_t)4096 * 2 * 4);
  p.rope = (float*)take((size_t)2048 * 4);
  p.lamv = (float*)take(256);
  p.counters = (int*)take(256);
  if (off > ws_size) { fprintf(stderr, "kernel_launch: workspace too small: need %zu have %zu\n", off, ws_size); return; }
#if MULTI
  launch_phase<0>(p, 0, stream);
  for (int l = 0; l < 2; ++l) {
    launch_phase<1>(p, 1 + 5 * l, stream); launch_phase<2>(p, 2 + 5 * l, stream); launch_phase<3>(p, 3 + 5 * l, stream);
    launch_phase<4>(p, 4 + 5 * l, stream); launch_phase<5>(p, 5 + 5 * l, stream);
  }
  launch_phase<6>(p, 11, stream);
#else
  static int grid_blocks = 0;
  if (!grid_blocks) {
    int dev = 0, cus = 0, per_cu = 0;
    hipGetDevice(&dev);
    hipDeviceGetAttribute(&cus, hipDeviceAttributeMultiprocessorCount, dev);
    hipFuncSetAttribute((const void*)mega_kernel, hipFuncAttributeMaxDynamicSharedMemorySize, LDS_BYTES);
    hipOccupancyMaxActiveBlocksPerMultiprocessor(&per_cu, (const void*)mega_kernel, NTHR, LDS_BYTES);
    if (per_cu < 1) per_cu = 1;
    grid_blocks = cus * per_cu;
  }
  void* args[] = {&p};
  hipError_t e = hipLaunchCooperativeKernel((const void*)mega_kernel, dim3(grid_blocks), dim3(NTHR), args, LDS_BYTES, stream);
  if (e != hipSuccess) fprintf(stderr, "cooperative launch failed: %s (grid %d)\n", hipGetErrorString(e), grid_blocks);
#endif
}
```

```cpp
#include <hip/hip_runtime.h>
#include <hip/hip_bf16.h>
#include <hip/hip_cooperative_groups.h>
#include <cstdio>
#include <cstdint>
namespace cg = cooperative_groups;

#ifndef MULTI
#define MULTI 0
#endif
#ifndef PROBE_DUP
#define PROBE_DUP 0
#endif

#define DI __device__ __forceinline__
typedef unsigned short u16;
using bf16x8 = __attribute__((ext_vector_type(8))) short;
using s16x4  = __attribute__((ext_vector_type(4))) short;
using f32x4  = __attribute__((ext_vector_type(4))) float;
using f32x16 = __attribute__((ext_vector_type(16))) float;
using u32x4  = __attribute__((ext_vector_type(4))) unsigned;

constexpr int NB = 8, TL = 4096, DM = 1024, TC = 256, SEQ = TC + TL, ROWS = NB * SEQ;
constexpr int INW = 3072;
constexpr int C_UA = 0, C_US = 256, C_K = 512, C_V = 1024, C_GA = 1536, C_GS = 1792, C_Q = 2048, C_GD = 2560;
constexpr int NTHR = 512;
constexpr int LDS_BYTES = 131072;
constexpr float EPS = 1e-6f;

struct Params {
  const float *x, *c, *ctx, *c_ctx, *norm_g, *w_mod, *b_mod, *w_in, *w_out, *conv_w, *conv_b, *lru_wa, *lru_ba, *lru_wx, *lru_bx, *lru_lam,
      *s5_lam_re, *s5_lam_im, *s5_log_dt, *s5_b_re, *s5_b_im, *s5_c_re, *s5_c_im, *s5_d, *s5_w_glu, *s5_b_glu, *da_lam, *da_norm_g, *final_g;
  float* out;
  u16 *nbuf, *pbuf, *hl, *ys, *obuf, *winT, *woutT, *wgluT, *bbT, *cc, *lruWT;
  float *hc, *mod, *sa, *rope, *lamv;
  int* counters;
};

DI float bf2f(u16 u) { return __uint_as_float(((unsigned)u) << 16); }
DI u16 f2bf(float x) { unsigned u = __float_as_uint(x); u += 0x7fffu + ((u >> 16) & 1u); return (u16)(u >> 16); }
DI float sigmoid_f(float v) { return 1.f / (1.f + __expf(-v)); }
DI float silu_f(float v) { return v / (1.f + __expf(-v)); }
DI float gelu_tanh(float y) { float u = 0.7978845608028654f * (y + 0.044715f * y * y * y); float t = 1.f - 2.f / (__expf(2.f * u) + 1.f); return 0.5f * y * (1.f + t); }
DI int crow(int r, int hi) { return (r & 3) + 8 * (r >> 2) + 4 * hi; }
DI unsigned cvtpk(float lo, float hi) { unsigned r; asm volatile("v_cvt_pk_bf16_f32 %0, %1, %2" : "=v"(r) : "v"(lo), "v"(hi)); return r; }
DI float wave_sum(float v) { for (int o = 32; o > 0; o >>= 1) v += __shfl_xor(v, o); return v; }
DI int tid_opaque(int wid_s) { int t; asm volatile("v_mbcnt_lo_u32_b32 %0, -1, 0\n\tv_mbcnt_hi_u32_b32 %0, -1, %0" : "=v"(t)); return (wid_s << 6) + t; }
#define MFMA32(a, b, c) __builtin_amdgcn_mfma_f32_32x32x16_bf16((a), (b), (c), 0, 0, 0)

DI void transpose_job(const int tix, const float* __restrict__ src, u16* __restrict__ dst, int K, int N, int kt, int nt, float* lds) {
  const int tid = tix, c = tid & 63, r0 = tid >> 6;
  for (int i = 0; i < 8; ++i) { int r = r0 + 8 * i; lds[r * 65 + c] = src[(size_t)(kt * 64 + r) * N + nt * 64 + c]; }
  __syncthreads();
  for (int i = 0; i < 8; ++i) { int r = r0 + 8 * i; dst[(size_t)(nt * 64 + r) * K + kt * 64 + c] = f2bf(lds[c * 65 + r]); }
  __syncthreads();
}

DI void mod_job(const int tix, const Params& p, int job, float* lds) {
  const int tid = tix;
  const int l = job / 96, cb = (job % 96) * 32;
  for (int i = tid; i < 9 * 1024; i += NTHR) { float v = i < 8192 ? p.c[i] : p.c_ctx[i - 8192]; lds[i] = silu_f(v); }
  __syncthreads();
  const int col = tid & 31, kg = tid >> 5;
  float acc[9];
#pragma unroll
  for (int r = 0; r < 9; ++r) acc[r] = 0.f;
  for (int k = kg * 64; k < kg * 64 + 64; ++k) {
    float w = p.w_mod[((size_t)l * 1024 + k) * 3072 + cb + col];
#pragma unroll
    for (int r = 0; r < 9; ++r) acc[r] += lds[r * 1024 + k] * w;
  }
  float* red = lds + 9 * 1024;
#pragma unroll
  for (int r = 0; r < 9; ++r) red[(kg * 9 + r) * 32 + col] = acc[r];
  __syncthreads();
  if (tid < 288) {
    int r = tid >> 5, c2 = tid & 31; float s = p.b_mod[l * 3072 + cb + c2];
    for (int g = 0; g < 16; ++g) s += red[(g * 9 + r) * 32 + c2];
    p.mod[(l * 9 + r) * 3072 + cb + c2] = s;
  }
  __syncthreads();
}

DI void phase_prep(const int tix, const Params& p, char* smem) {
  float* lds = (float*)smem;
  constexpr int J_WIN = 2 * 16 * 48, J_WOUT = 2 * 16 * 16, J_GLU = 2 * 4 * 4, J_LRU = 32, J_MOD = 192;
  constexpr int JT = J_WIN + J_WOUT + J_GLU + J_LRU + J_MOD;
  for (int job = blockIdx.x; job < JT; job += gridDim.x) {
    int j = job;
    if (j < J_WIN) { int l = j / 768, r = j % 768; transpose_job(tix, p.w_in + (size_t)l * 1024 * 3072, p.winT + (size_t)l * 3072 * 1024, 1024, 3072, r / 48, r % 48, lds); continue; }
    j -= J_WIN;
    if (j < J_WOUT) { int l = j / 256, r = j % 256; transpose_job(tix, p.w_out + (size_t)l * 1024 * 1024, p.woutT + (size_t)l * 1024 * 1024, 1024, 1024, r / 16, r % 16, lds); continue; }
    j -= J_WOUT;
    if (j < J_GLU) { int l = j / 16, r = j % 16; transpose_job(tix, p.s5_w_glu + (size_t)l * 65536, p.wgluT + (size_t)l * 65536, 256, 256, r / 4, r % 4, lds); continue; }
    j -= J_GLU;
    if (j < J_LRU) { int m = j >> 1, gate = j & 1;
      transpose_job(tix, (gate ? p.lru_wx : p.lru_wa) + (size_t)m * 4096, p.lruWT + (size_t)(m * 2 + gate) * 4096, 64, 64, 0, 0, lds); continue; }
    j -= J_LRU;
    mod_job(tix, p, j, lds);
  }
  const int gtid = blockIdx.x * NTHR + tix, gsz = gridDim.x * NTHR;
  constexpr int N_S5 = 4096, N_CC = 131072, N_ROPE = 1024;
  for (int i = gtid; i < N_S5 + N_CC + N_ROPE + 4; i += gsz) {
    if (i < N_S5) {
      const int idx = i, ldg = idx >> 6, pp = idx & 63;
      float lr = p.s5_lam_re[idx], li = p.s5_lam_im[idx], dt = expf(p.s5_log_dt[ldg]);
      float mag = expf(lr * dt), ang = li * dt, sn = sinf(ang), cs = cosf(ang);
      float abr = mag * cs, abi = mag * sn, nr = abr - 1.f, ni = abi, den = lr * lr + li * li;
      float cfr = (nr * lr + ni * li) / den, cfi = (ni * lr - nr * li) / den;
      p.sa[idx * 2] = abr; p.sa[idx * 2 + 1] = abi;
      for (int h = 0; h < 16; ++h) {
        float br = p.s5_b_re[idx * 16 + h], bi = p.s5_b_im[idx * 16 + h];
        p.bbT[((size_t)(ldg * 2 + 0) * 64 + pp) * 16 + h] = f2bf(cfr * br - cfi * bi);
        p.bbT[((size_t)(ldg * 2 + 1) * 64 + pp) * 16 + h] = f2bf(cfr * bi + cfi * br);
      }
    } else if (i < N_S5 + N_CC) {
      const int e = i - N_S5, k = e & 127, lc = e >> 7;
      float v = k < 64 ? p.s5_c_re[lc * 64 + k] : -p.s5_c_im[lc * 64 + (k - 64)];
      p.cc[e] = f2bf(v);
    } else if (i < N_S5 + N_CC + N_ROPE) {
      const int e = i - N_S5 - N_CC, pos = e >> 4, f = e & 15;
      float inv = expf(-9.210340371976184f * (float)f / 16.f), ang = (float)pos * inv;
      p.rope[e] = cosf(ang); p.rope[1024 + e] = sinf(ang);
    } else {
      const int e = i - N_S5 - N_CC - N_ROPE;
      if (e < 2) {
        const int l = e; const float* dl = p.da_lam + l * 256;
        float s0 = 0.f, s1 = 0.f;
        for (int k = 0; k < 64; ++k) { s0 += dl[k] * dl[64 + k]; s1 += dl[128 + k] * dl[192 + k]; }
        float lam_init = 0.8f - 0.6f * expf(-0.3f * (float)l);
        p.lamv[l] = expf(s0) - expf(s1) + lam_init; p.lamv[2 + l] = lam_init;
      } else { for (int k = 0; k < 8; ++k) p.counters[(e - 2) * 8 + k] = 0; }
    }
  }
}

DI void phase_norm(const int tix, const Params& p, int l) {
  const int wid = tix >> 6, lane = tix & 63;
  const float* g = p.norm_g + l * 1024;
  for (int row = blockIdx.x * 8 + wid; row < ROWS; row += gridDim.x * 8) {
    const int b = row / SEQ, s = row % SEQ;
    const float* src; int mrow;
    if (s < TC) { src = (l == 0 ? p.ctx : p.hc) + ((size_t)b * TC + s) * 1024; mrow = 8; }
    else { src = (l == 0 ? p.x : p.out) + ((size_t)b * TL + (s - TC)) * 1024; mrow = b; }
    const float* md = p.mod + (l * 9 + mrow) * 3072;
    f32x4 v[4]; float ss = 0.f;
#pragma unroll
    for (int i = 0; i < 4; ++i) { v[i] = *(const f32x4*)(src + i * 256 + lane * 4); ss += v[i][0] * v[i][0] + v[i][1] * v[i][1] + v[i][2] * v[i][2] + v[i][3] * v[i][3]; }
    ss = wave_sum(ss);
    const float r = rsqrtf(ss * (1.f / 1024.f) + EPS);
#pragma unroll
    for (int i = 0; i < 4; ++i) {
      const int c0 = i * 256 + lane * 4;
      f32x4 gg = *(const f32x4*)(g + c0), sh = *(const f32x4*)(md + c0), sc = *(const f32x4*)(md + 1024 + c0);
      float o0 = v[i][0] * r * gg[0] * (1.f + sc[0]) + sh[0], o1 = v[i][1] * r * gg[1] * (1.f + sc[1]) + sh[1];
      float o2 = v[i][2] * r * gg[2] * (1.f + sc[2]) + sh[2], o3 = v[i][3] * r * gg[3] * (1.f + sc[3]) + sh[3];
      uint2 w; w.x = cvtpk(o0, o1); w.y = cvtpk(o2, o3);
      *(uint2*)(p.nbuf + (size_t)row * 1024 + c0) = w;
    }
  }
}

namespace gm {
constexpr int BM = 256, BK = 64, HALF = 128, NXCD = 8, WGM = 8, HT = HALF * BK, KD = 1024;
DI int lds_byte(int r, int c) { int st = (r >> 4) * 2 + (c >> 5), rr = r & 15, cc = c & 31, ob = rr * 64 + cc * 2; return st * 1024 + (ob ^ (((ob >> 9) & 1) << 5)); }
DI void stage_rc(int b, int& R, int& C) { int st = b / 1024, sb = b % 1024, swz = sb ^ (((sb >> 9) & 1) << 5); R = (st >> 1) * 16 + swz / 64; C = (st & 1) * 32 + (swz % 64) / 2; }

template <int MODE>
DI void gemm_tile(const int tix, const Params& p, int l, const u16* __restrict__ A, const u16* __restrict__ Bt, int brow, int bcol, u16* shm) {
  constexpr int K = KD;
#define SA(b, h) (shm + ((b) * 2 + (h)) * HT)
#define SB(b, h) (shm + (4 + (b) * 2 + (h)) * HT)
#define STAGE(P, BASE, br, kt) do { const u16* _gp = (BASE) + ((long)(br) * K + (long)(kt) * BK); \
      __builtin_amdgcn_global_load_lds((const unsigned*)(_gp + voff0), (__attribute__((address_space(3))) unsigned*)((char*)(P) + wbase), 16, 0, 0); \
      __builtin_amdgcn_global_load_lds((const unsigned*)(_gp + voff1), (__attribute__((address_space(3))) unsigned*)((char*)(P) + wbase + 8192), 16, 0, 0); } while (0)
#define LDA(dst, b, h) for (int m = 0; m < 4; ++m) for (int k = 0; k < 2; ++k) \
    dst[m][k] = *reinterpret_cast<const bf16x8*>((char*)SA(b, h) + lds_byte(wr * 64 + m * 16 + fr, k * 32 + fq * 8))
#define LDB(dst, b, h) for (int n = 0; n < 2; ++n) for (int k = 0; k < 2; ++k) \
    dst[n][k] = *reinterpret_cast<const bf16x8*>((char*)SB(b, h) + lds_byte(wc * 32 + n * 16 + fr, k * 32 + fq * 8))
#define MMA(ai, bj, At, Bt_) do { __builtin_amdgcn_s_setprio(1); \
    for (int m = 0; m < 4; ++m) for (int n = 0; n < 2; ++n) for (int k = 0; k < 2; ++k) \
      acc[ai][bj][m][n] = __builtin_amdgcn_mfma_f32_16x16x32_bf16(Bt_[n][k], At[m][k], acc[ai][bj][m][n], 0, 0, 0); \
    __builtin_amdgcn_s_setprio(0); } while (0)
#define WAIT_V(n) asm volatile("s_waitcnt vmcnt(" #n ")" ::: "memory")
#define WAIT_L(n) asm volatile("s_waitcnt lgkmcnt(" #n ")" ::: "memory")
#define BAR __builtin_amdgcn_s_barrier()
#define SCHED __builtin_amdgcn_sched_barrier(0)
  const int wid = __builtin_amdgcn_readfirstlane(tix >> 6), lane = tix & 63, wr = wid >> 2, wc = wid & 3, fr = lane & 15, fq = lane >> 4;
  const int wbase = wid * 1024;
  int voff0, voff1;
  { int _r, _c; stage_rc(tix * 16, _r, _c); voff0 = _r * K + _c; stage_rc(tix * 16 + 8192, _r, _c); voff1 = _r * K + _c; }
  f32x4 acc[2][2][4][2] = {};
  bf16x8 At[4][2], B0[2][2], B1[2][2];
  constexpr int nt = K / BK;
  STAGE(SB(0, 0), Bt, bcol, 0); STAGE(SA(0, 0), A, brow, 0);
  STAGE(SB(0, 1), Bt, bcol + HALF, 0); STAGE(SA(0, 1), A, brow + HALF, 0);
  if (wr == 1) BAR;
  WAIT_V(4); BAR;
  STAGE(SB(1, 0), Bt, bcol, 1); STAGE(SA(1, 0), A, brow, 1); STAGE(SB(1, 1), Bt, bcol + HALF, 1);
  WAIT_V(6); BAR;
  for (int t = 0; t < nt - 2; t += 2) {
    LDB(B0, 0, 0); SCHED; LDA(At, 0, 0); STAGE(SA(1, 1), A, brow + HALF, t + 1);
    WAIT_L(8); BAR; WAIT_L(0); MMA(0, 0, At, B0); BAR; SCHED;
    LDB(B1, 0, 1); STAGE(SB(0, 0), Bt, bcol, t + 2);
    BAR; WAIT_L(0); MMA(0, 1, At, B1); BAR;
    LDA(At, 0, 1); STAGE(SA(0, 0), A, brow, t + 2);
    BAR; WAIT_L(0); MMA(1, 0, At, B0); BAR; SCHED;
    STAGE(SB(0, 1), Bt, bcol + HALF, t + 2);
    WAIT_V(6); BAR; MMA(1, 1, At, B1); BAR;
    LDB(B0, 1, 0); SCHED; LDA(At, 1, 0); STAGE(SA(0, 1), A, brow + HALF, t + 2);
    WAIT_L(8); BAR; WAIT_L(0); MMA(0, 0, At, B0); BAR; SCHED;
    LDB(B1, 1, 1); STAGE(SB(1, 0), Bt, bcol, t + 3);
    BAR; WAIT_L(0); MMA(0, 1, At, B1); BAR;
    LDA(At, 1, 1); STAGE(SA(1, 0), A, brow, t + 3);
    BAR; WAIT_L(0); MMA(1, 0, At, B0); BAR; SCHED;
    STAGE(SB(1, 1), Bt, bcol + HALF, t + 3);
    WAIT_V(6); BAR; MMA(1, 1, At, B1); BAR;
  }
  { LDB(B0, 0, 0); LDA(At, 0, 0); STAGE(SA(1, 1), A, brow + HALF, nt - 1);
    BAR; WAIT_L(0); MMA(0, 0, At, B0); BAR;
    LDB(B1, 0, 1); BAR; WAIT_L(0); MMA(0, 1, At, B1); BAR;
    LDA(At, 0, 1); WAIT_V(4); BAR; WAIT_L(0); MMA(1, 0, At, B0); MMA(1, 1, At, B1); BAR; }
  { LDB(B0, 1, 0); LDA(At, 1, 0); WAIT_V(2); BAR; WAIT_L(0); MMA(0, 0, At, B0); BAR;
    LDB(B1, 1, 1); WAIT_V(0); BAR; WAIT_L(0); MMA(0, 1, At, B1); BAR;
    LDA(At, 1, 1); BAR; WAIT_L(0); MMA(1, 0, At, B0); MMA(1, 1, At, B1); BAR; }
  if (wr == 0) BAR;
  int fr_ = fr, fq_ = fq, wr_ = wr, wc_ = wc;
  asm volatile("" : "+v"(fr_), "+v"(fq_), "+s"(wr_), "+s"(wc_));
#define fr fr_
#define fq fq_
#define wr wr_
#define wc wc_
  const int b = brow / SEQ, s0 = brow % SEQ;
  if (MODE == 0) {
    const bool lat = s0 >= TC;
#pragma unroll
    for (int ai = 0; ai < 2; ++ai)
#pragma unroll
      for (int bj = 0; bj < 2; ++bj) {
        const int colbase = bcol + bj * HALF + wc * 32;
        const bool isrope = lat && ((colbase >= C_K && colbase < C_V) || (colbase >= C_Q && colbase < C_GD));
#pragma unroll
        for (int m = 0; m < 4; ++m) {
          const int lr = ai * HALF + wr * 64 + m * 16 + fr;
          f32x4 x1 = acc[ai][bj][m][0], x2 = acc[ai][bj][m][1];
          if (isrope) {
            const int t = s0 + lr - TC; const int pos = (colbase & 32) ? (t & 63) : (t >> 6);
            const f32x4 cs = *reinterpret_cast<const f32x4*>(p.rope + pos * 16 + fq * 4), sn = *reinterpret_cast<const f32x4*>(p.rope + 1024 + pos * 16 + fq * 4);
            const f32x4 o1 = x1 * cs - x2 * sn, o2 = x2 * cs + x1 * sn; x1 = o1; x2 = o2;
          }
          u16* dst = p.pbuf + (size_t)(brow + lr) * INW + colbase + fq * 4;
          uint2 w1, w2; w1.x = cvtpk(x1[0] + 0.f, x1[1] + 0.f); w1.y = cvtpk(x1[2] + 0.f, x1[3] + 0.f); w2.x = cvtpk(x2[0] + 0.f, x2[1] + 0.f); w2.y = cvtpk(x2[2] + 0.f, x2[3] + 0.f);
          *reinterpret_cast<uint2*>(dst) = w1; *reinterpret_cast<uint2*>(dst + 16) = w2;
        }
      }
  } else {
    const bool isctx = s0 < TC;
    const float* gate = p.mod + (l * 9 + (isctx ? 8 : b)) * 3072 + 2048;
    const float* srcb = isctx ? ((l == 0) ? p.ctx : p.hc) : ((l == 0) ? p.x : p.out);
    float* dstb = isctx ? p.hc : p.out;
    const size_t rbase = isctx ? (size_t)b * TC : ((size_t)b * TL - TC);
#pragma unroll
    for (int ai = 0; ai < 2; ++ai)
#pragma unroll
      for (int bj = 0; bj < 2; ++bj)
#pragma unroll
        for (int n = 0; n < 2; ++n) {
          const int col = bcol + bj * HALF + wc * 32 + n * 16 + fq * 4;
          const f32x4 gt = *reinterpret_cast<const f32x4*>(gate + col);
#pragma unroll
          for (int m = 0; m < 4; ++m) {
            const int lr = ai * HALF + wr * 64 + m * 16 + fr; const int s = s0 + lr;
            const size_t off = (rbase + s) * 1024 + col;
            const f32x4 sv = *reinterpret_cast<const f32x4*>(srcb + off);
            *reinterpret_cast<f32x4*>(dstb + off) = sv + gt * acc[ai][bj][m][n];
          }
        }
  }
  __syncthreads();
#undef fr
#undef fq
#undef wr
#undef wc
#undef SA
#undef SB
#undef STAGE
#undef LDA
#undef LDB
#undef MMA
}

template <int MODE>
DI void gemm_phase(const int tix, const Params& p, int l, const u16* A, const u16* Bt, int nN, char* smem) {
  constexpr int nM = ROWS / BM;
  const int nwg = nM * nN; const bool last = (l == 1);
  for (int T = blockIdx.x; T < nwg; T += gridDim.x) {
    int wgid = T;
    { int q = nwg / NXCD, r = nwg % NXCD, xcd = wgid % NXCD, off = wgid / NXCD; wgid = (xcd < r ? xcd * (q + 1) : r * (q + 1) + (xcd - r) * q) + off; }
    int nig = WGM * nN, gid = wgid / nig, fm = gid * WGM, gsz = min(nM - fm, WGM);
    int pm = fm + ((wgid % nig) % gsz), pn = (wgid % nig) / gsz;
    const bool isctx = (pm % 17) == 0;
    if (last && isctx && (MODE == 1 || pn >= 6)) continue;
    gemm_tile<MODE>(tix, p, l, A, Bt, pm * BM, pn * BM, (u16*)smem);
  }
}
}

namespace at {
constexpr int NW = 8, QBLK = 32, KVBLK = 64;
constexpr float SCALE = 0.125f, THR = 8.f;
constexpr int LDQ = INW, LDK = INW, LDO = 1024;
constexpr int SHM_V = KVBLK * 128 * 2, SHM_K = KVBLK * 64 * 2;
#define KSWZ(row, colB) ((row) * 128 + ((colB) ^ (((row) & 7) << 4)))
#define SBAR() __builtin_amdgcn_sched_barrier(0)

DI void partialSM(f32x16& p0, f32x16& p1, float& m_reg, float& mn, float& alpha) {
  constexpr float C = SCALE * 1.4426950408889634f;
  float pmax = p0[0];
  for (int r = 1; r < 16; ++r) pmax = fmaxf(pmax, p0[r]);
  for (int r = 0; r < 16; ++r) pmax = fmaxf(pmax, p1[r]);
  { auto rr = __builtin_amdgcn_permlane32_swap(__float_as_uint(pmax), __float_as_uint(pmax), false, false);
    pmax = fmaxf(__uint_as_float(rr[0]), __uint_as_float(rr[1])); }
  if (__builtin_expect(__all(pmax - m_reg <= THR / SCALE), 1)) { mn = m_reg; alpha = 1.f; }
  else { mn = fmaxf(m_reg, pmax); alpha = __builtin_amdgcn_exp2f((m_reg - mn) * C); m_reg = mn; }
  float mnC = -mn * C;
  for (int r = 0; r < 16; ++r) p0[r] = fmaf(p0[r], C, mnC);
  for (int r = 0; r < 16; ++r) p1[r] = fmaf(p1[r], C, mnC);
  for (int r = 0; r < 16; ++r) p0[r] = __builtin_amdgcn_exp2f(p0[r]);
}
DI void finishSM(f32x16& p0, f32x16& p1, float alpha, float& l_reg, bf16x8& pa0, bf16x8& pa1, bf16x8& pa2, bf16x8& pa3) {
  for (int r = 0; r < 16; ++r) p1[r] = __builtin_amdgcn_exp2f(p1[r]);
  float ps = 0;
  for (int r = 0; r < 16; ++r) ps += p0[r];
  for (int r = 0; r < 16; ++r) ps += p1[r];
  { auto rr = __builtin_amdgcn_permlane32_swap(__float_as_uint(ps), __float_as_uint(ps), false, false);
    ps = __uint_as_float(rr[0]) + __uint_as_float(rr[1]); }
  l_reg = l_reg * alpha + ps;
#define PK4(P, BASE, OUT) do { unsigned a0 = cvtpk(P[BASE + 0], P[BASE + 1]), a1 = cvtpk(P[BASE + 2], P[BASE + 3]);   \
    unsigned b0 = cvtpk(P[BASE + 4], P[BASE + 5]), b1 = cvtpk(P[BASE + 6], P[BASE + 7]);                              \
    auto r0 = __builtin_amdgcn_permlane32_swap(a0, b0, false, false); auto r1 = __builtin_amdgcn_permlane32_swap(a1, b1, false, false); \
    u32x4 w = {r0[0], r1[0], r0[1], r1[1]}; OUT = *reinterpret_cast<bf16x8*>(&w); } while (0)
  PK4(p0, 0, pa0); PK4(p0, 8, pa1); PK4(p1, 0, pa2); PK4(p1, 8, pa3);
#undef PK4
}
DI void qkt(f32x16& p0, f32x16& p1, const char* Ks, const bf16x8* qr, int r32, int hi) {
  p0 = f32x16{}; p1 = f32x16{};
#pragma unroll
  for (int d0 = 0; d0 < 4; ++d0) { int cb = (d0 * 16 + hi * 8) * 2;
    bf16x8 b0 = *reinterpret_cast<const bf16x8*>(Ks + KSWZ(r32, cb));
    bf16x8 b1 = *reinterpret_cast<const bf16x8*>(Ks + KSWZ(32 + r32, cb));
    p0 = MFMA32(b0, qr[d0], p0);
    p1 = MFMA32(b1, qr[d0], p1); }
}
DI int v_st(int k, int c) { const int kk = (k & ~0xC) | ((k & 4) << 1) | ((k & 8) >> 1); return ((kk >> 3) * 4 + (c >> 5)) * 512 + ((kk & 7) * 32 + (c & 31)) * 2; }
DI int v_rd_base(int lane) { return ((lane & 3) << 3) | (((lane >> 2) & 3) << 6) | (((lane >> 4) & 1) << 5) | (((lane >> 5) & 1) << 8); }
constexpr int v_rd_off(int d0, int ks, int half) { return d0 * 512 + ks * 4096 + half * 2048; }
template <int OFF> DI s16x4 tr_read(int vb) {
  s16x4 r; asm volatile("ds_read_b64_tr_b16 %0, %1 offset:%2" : "=&v"(r) : "v"(vb), "i"(OFF) : "memory"); return r;
}
template <int D0> DI void pv_one(f32x16& od, int vb, bf16x8 pa0, bf16x8 pa1, bf16x8 pa2, bf16x8 pa3) {
  const s16x4 l0 = tr_read<v_rd_off(D0, 0, 0)>(vb), h0 = tr_read<v_rd_off(D0, 0, 1)>(vb), l1 = tr_read<v_rd_off(D0, 1, 0)>(vb), h1 = tr_read<v_rd_off(D0, 1, 1)>(vb);
  const s16x4 l2 = tr_read<v_rd_off(D0, 2, 0)>(vb), h2 = tr_read<v_rd_off(D0, 2, 1)>(vb), l3 = tr_read<v_rd_off(D0, 3, 0)>(vb), h3 = tr_read<v_rd_off(D0, 3, 1)>(vb);
  asm volatile("s_waitcnt lgkmcnt(0)" ::: "memory"); SBAR();
#define PK(L, H) (bf16x8){L[0], L[1], L[2], L[3], H[0], H[1], H[2], H[3]}
  od = MFMA32(pa0, PK(l0, h0), od);
  od = MFMA32(pa1, PK(l1, h1), od);
  od = MFMA32(pa2, PK(l2, h2), od);
  od = MFMA32(pa3, PK(l3, h3), od);
#undef PK
}
DI void pv_d0(f32x16* o, int vb, bf16x8 pa0, bf16x8 pa1, bf16x8 pa2, bf16x8 pa3) {
  pv_one<0>(o[0], vb, pa0, pa1, pa2, pa3); pv_one<1>(o[1], vb, pa0, pa1, pa2, pa3); pv_one<2>(o[2], vb, pa0, pa1, pa2, pa3); pv_one<3>(o[3], vb, pa0, pa1, pa2, pa3);
}

DI void attn_body(const int tix, const u16* __restrict__ Qb, const u16* __restrict__ Kh, const u16* __restrict__ Vh, u16* __restrict__ Ob, int seq, char* lds) {
  const int tid = tix, wid = tid >> 6, lane = tid & 63, r32 = lane & 31, hi = lane >> 5;
  char* V_lds = lds; char* K_lds = lds + 2 * SHM_V;
  float* ws = (float*)(lds + 2 * SHM_V + 2 * SHM_K) + wid * 64; float* li_l = ws; float* al_l = ws + 32;
  float m_reg = -1e30f, l_reg = 0; f32x16 o[4] = {}; bf16x8 qr[4];
  const u16* Qw = Qb + (long)(wid * QBLK + r32) * LDQ + hi * 8;
#pragma unroll
  for (int d0 = 0; d0 < 4; ++d0) qr[d0] = *reinterpret_cast<const bf16x8*>(Qw + d0 * 16);
  const int sr = tid >> 4, sc = (tid & 15) * 8, vst0 = v_st(sr, sc), vst1 = v_st(32 + sr, sc);
  const int ksr = tid >> 3, ksc = (tid & 7) * 8, kst = KSWZ(ksr, ksc * 2);
  const int vb0 = (int)(uintptr_t)V_lds + v_rd_base(lane);
  struct { bf16x8 vs0, vs1, ks0; } sr_[2];
#define SLOAD(i, k0) do { sr_[i].vs0 = *reinterpret_cast<const bf16x8*>(&Vh[(long)((k0) + sr) * LDK + sc]); sr_[i].vs1 = *reinterpret_cast<const bf16x8*>(&Vh[(long)((k0) + 32 + sr) * LDK + sc]); \
    sr_[i].ks0 = *reinterpret_cast<const bf16x8*>(&Kh[(long)((k0) + ksr) * LDK + ksc]); } while (0)
#define SWRITE(b, i) do { *(bf16x8*)(V_lds + (b) * SHM_V + vst0) = sr_[i].vs0;          \
    *(bf16x8*)(V_lds + (b) * SHM_V + vst1) = sr_[i].vs1;               \
    *(bf16x8*)(K_lds + (b) * SHM_K + kst) = sr_[i].ks0; } while (0)
#define SWAIT() asm volatile("s_waitcnt vmcnt(3)" ::: "memory")
#define RESC(a) do { if (__any((a) < 1.f)) { if (hi == 0) al_l[r32] = (a); asm volatile("s_waitcnt lgkmcnt(0)" ::: "memory"); \
    for (int d = 0; d < 4; ++d) for (int r = 0; r < 16; ++r) o[d][r] *= al_l[crow(r, hi)]; } } while (0)
  f32x16 pA0, pA1, pB0, pB1; float mnA, mnB, alA, alB; bf16x8 pa0, pa1, pa2, pa3; const int NT = seq / KVBLK;
  constexpr int SE = 0, SO = 1;
  SLOAD(SE, 0); asm volatile("s_waitcnt vmcnt(0)" ::: "memory"); SWRITE(0, SE); __syncthreads();
  qkt(pA0, pA1, K_lds, qr, r32, hi); partialSM(pA0, pA1, m_reg, mnA, alA);
  SLOAD(SO, KVBLK); if (2 < NT) SLOAD(SE, 2 * KVBLK);
  SWAIT(); SWRITE(1, SO); __syncthreads();
  for (int j = 1; j + 1 < NT; j += 2) {
    SBAR(); qkt(pB0, pB1, K_lds + SHM_K, qr, r32, hi);
    finishSM(pA0, pA1, alA, l_reg, pa0, pa1, pa2, pa3); SBAR();
    SLOAD(SO, (j + 2) * KVBLK); SBAR();
    pv_d0(o, vb0, pa0, pa1, pa2, pa3); partialSM(pB0, pB1, m_reg, mnB, alB);
    __syncthreads(); SWAIT(); SWRITE(0, SE);
    RESC(alB); __syncthreads();
    SBAR(); qkt(pA0, pA1, K_lds, qr, r32, hi);
    finishSM(pB0, pB1, alB, l_reg, pa0, pa1, pa2, pa3); SBAR();
    if (j + 3 < NT) SLOAD(SE, (j + 3) * KVBLK); SBAR();
    pv_d0(o, vb0 + (int)SHM_V, pa0, pa1, pa2, pa3); partialSM(pA0, pA1, m_reg, mnA, alA);
    __syncthreads(); SWAIT(); SWRITE(1, SO);
    RESC(alA); __syncthreads();
  }
  SBAR(); qkt(pB0, pB1, K_lds + SHM_K, qr, r32, hi);
  finishSM(pA0, pA1, alA, l_reg, pa0, pa1, pa2, pa3); SBAR();
  pv_d0(o, vb0, pa0, pa1, pa2, pa3); partialSM(pB0, pB1, m_reg, mnB, alB);
  __syncthreads(); RESC(alB);
  finishSM(pB0, pB1, alB, l_reg, pa0, pa1, pa2, pa3); SBAR();
  pv_d0(o, vb0 + (int)SHM_V, pa0, pa1, pa2, pa3);
  if (hi == 0) li_l[r32] = l_reg; asm volatile("s_waitcnt lgkmcnt(0)" ::: "memory");
  float rli[16];
#pragma unroll
  for (int r = 0; r < 16; ++r) rli[r] = __builtin_amdgcn_rcpf(li_l[crow(r, hi)]);
  u16* Ow = Ob + (long)(wid * QBLK) * LDO;
#pragma unroll
  for (int r = 0; r < 16; ++r) { int orow = crow(r, hi);
#pragma unroll
    for (int d0 = 0; d0 < 4; ++d0) Ow[(long)orow * LDO + d0 * 32 + r32] = f2bf(o[d0][r] * rli[r]); }
  __syncthreads();
#undef SLOAD
#undef SWRITE
#undef SWAIT
#undef RESC
}
}

DI int smap(int sigma, int dir) { return dir == 0 ? sigma : (sigma < TC ? (TC - 1 - sigma) : (SEQ + TC - 1 - sigma)); }

DI float fsig(float v) { return __builtin_amdgcn_rcpf(1.f + __builtin_amdgcn_exp2f(-1.4426950408889634f * v)); }
DI u16 bfr(float x) { return (u16)(cvtpk(x, x) & 0xffffu); }
#define WAVE_SYNC() do { __builtin_amdgcn_fence(__ATOMIC_RELEASE, "wavefront"); __builtin_amdgcn_wave_barrier(); __builtin_amdgcn_fence(__ATOMIC_ACQUIRE, "wavefront"); } while (0)

DI void lru_wg_item(const int tix, const Params& p, int l, int item, char* smem) {
  const int wid = __builtin_amdgcn_readfirstlane(tix >> 6), lane = tix & 63, r = lane & 31, h = lane >> 5;
  const int b = item >> 4, dir = (item >> 3) & 1, n = (item >> 1) & 3, half = item & 1;
  char* wlds = smem + wid * 9216;
  u16* xcb = (u16*)wlds;
  float* xcf = (float*)(wlds + 32 * 144);
  float* exch = (float*)(smem + 8 * 9216);
  const int ld = l * 2 + dir;
  bf16x8 wa[4], wx[4];
  { const u16* wt = p.lruWT + (size_t)(((ld * 4 + n) * 2) * 4096) + (half * 32 + r) * 64 + 8 * h;
#pragma unroll
    for (int s = 0; s < 4; ++s) { wa[s] = *reinterpret_cast<const bf16x8*>(wt + 16 * s); wx[s] = *reinterpret_cast<const bf16x8*>(wt + 4096 + 16 * s); } }
  const int ch = n * 64 + half * 32 + r;
  const float ba = p.lru_ba[ld * 256 + ch], bx = p.lru_bx[ld * 256 + ch];
  const float sp8l = 8.f * 1.4426950408889634f * log1pf(expf(-p.lru_lam[ld * 256 + ch]));
  const int cch = n * 64 + lane;
  const float cw0 = p.conv_w[(l * 4 + 0) * 256 + cch], cw1 = p.conv_w[(l * 4 + 1) * 256 + cch], cw2 = p.conv_w[(l * 4 + 2) * 256 + cch], cw3 = p.conv_w[(l * 4 + 3) * 256 + cch];
  const float cbias = p.conv_b[l * 256 + cch];
  const u16* ubase = p.pbuf + (size_t)b * SEQ * INW + C_UA + cch;
  u16* hout = p.hl + ((size_t)dir * ROWS + (size_t)b * SEQ) * 256 + ch;
  float sc = 0.f;
  u16 un[35];
  { const int sg = wid * 32; const int smin0 = dir == 0 ? sg : smap(sg + 31, 1);
#pragma unroll
    for (int k = 0; k < 35; ++k) { int s = smin0 - 2 + k; s = s < 0 ? 0 : (s > SEQ - 1 ? SEQ - 1 : s); un[k] = ubase[(size_t)s * INW]; } }
  for (int st = 0; st < SEQ / 256; ++st) {
    const int sg0 = st * 256 + wid * 32;
    const int smin = dir == 0 ? sg0 : smap(sg0 + 31, 1);
    const int seg_lo = smin < TC ? 0 : TC, seg_hi = smin < TC ? TC : SEQ;
    float uw[35];
#pragma unroll
    for (int k = 0; k < 35; ++k) { const int s = smin - 2 + k; uw[k] = (s >= seg_lo && s < seg_hi) ? bf2f(un[k]) : 0.f; }
    if (st + 1 < SEQ / 256) {
      const int smin1 = dir == 0 ? sg0 + 256 : smap(sg0 + 256 + 31, 1);
#pragma unroll
      for (int k = 0; k < 35; ++k) { int s = smin1 - 2 + k; s = s < 0 ? 0 : (s > SEQ - 1 ? SEQ - 1 : s); un[k] = ubase[(size_t)s * INW]; }
    }
#pragma unroll
    for (int i = 0; i < 32; ++i) {
      const float xc = cbias + cw0 * uw[i] + cw1 * uw[i + 1] + cw2 * uw[i + 2] + cw3 * uw[i + 3];
      const int m = dir ? 31 - i : i;
      xcb[m * 72 + lane] = bfr(xc);
      if ((lane >> 5) == half) xcf[m * 33 + (lane & 31)] = xc;
    }
    WAVE_SYNC();
    f32x16 ga = {}, gx = {};
#pragma unroll
    for (int s = 0; s < 4; ++s) {
      const bf16x8 a = *reinterpret_cast<const bf16x8*>(xcb + r * 72 + 16 * s + 8 * h);
      ga = MFMA32(a, wa[s], ga); gx = MFMA32(a, wx[s], gx);
    }
    float av[16], hv[16], cum[16];
#pragma unroll
    for (int i = 0; i < 16; ++i) {
      const int m = crow(i, h);
      const float xv = xcf[m * 33 + r];
      const float rr = fsig(ga[i] + ba), ii = fsig(gx[i] + bx);
      const float a = __builtin_amdgcn_exp2f(-sp8l * rr);
      av[i] = a;
      hv[i] = __builtin_amdgcn_sqrtf(fmaxf(1.f - a * a, 0.f)) * (ii * xv);
    }
    float Ag[4], Bg[4];
#pragma unroll
    for (int g = 0; g < 4; ++g) {
      cum[4 * g] = av[4 * g];
#pragma unroll
      for (int j = 1; j < 4; ++j) { hv[4 * g + j] = av[4 * g + j] * hv[4 * g + j - 1] + hv[4 * g + j]; cum[4 * g + j] = cum[4 * g + j - 1] * av[4 * g + j]; }
      Ag[g] = cum[4 * g + 3]; Bg[g] = hv[4 * g + 3];
    }
    float cin0[4], pre[4];
    float cc = 0.f, pp = 1.f;
#pragma unroll
    for (int g = 0; g < 4; ++g) {
      const float oA = __shfl_xor(Ag[g], 32), oB = __shfl_xor(Bg[g], 32);
      const float A0 = h ? oA : Ag[g], B0 = h ? oB : Bg[g], A1 = h ? Ag[g] : oA, B1 = h ? Bg[g] : oB;
      const float c0 = cc, p0 = pp; cc = A0 * cc + B0; pp = A0 * pp;
      const float c1 = cc, p1 = pp; cc = A1 * cc + B1; pp = A1 * pp;
      cin0[g] = h ? c1 : c0; pre[g] = h ? p1 : p0;
    }
    if (h == 0) { exch[(wid * 32 + r) * 2] = pp; exch[(wid * 32 + r) * 2 + 1] = cc; }
    __syncthreads();
    float tc = sc, mycin = sc;
#pragma unroll
    for (int j = 0; j < 8; ++j) { const float Aj = exch[(j * 32 + r) * 2], Bj = exch[(j * 32 + r) * 2 + 1]; if (j == wid) mycin = tc; tc = Aj * tc + Bj; }
    sc = tc;
#pragma unroll
    for (int i = 0; i < 16; ++i) {
      const float hf = hv[i] + cum[i] * (cin0[i >> 2] + pre[i >> 2] * mycin);
      const int s = smap(sg0 + crow(i, h), dir);
      hout[(size_t)s * 256] = bfr(hf);
    }
    __syncthreads();
  }
}

DI void s5_wg_item(const int tix, const Params& p, int l, int item, char* smem) {
  const int wid = __builtin_amdgcn_readfirstlane(tix >> 6), lane = tix & 63, r = lane & 31, h = lane >> 5;
  const int b = item >> 5, dir = (item >> 4) & 1, g = item & 15;
  const int ldg = (l * 2 + dir) * 16 + g;
  u16* Sl = (u16*)(smem + wid * 9216);
  float* exch = (float*)(smem + 8 * 9216);
  bf16x8 bb[4], cf[4];
  const int c16 = lane & 15, kq = lane >> 4;
#pragma unroll
  for (int nt = 0; nt < 4; ++nt) bb[nt] = *reinterpret_cast<const bf16x8*>(p.bbT + ((size_t)(ldg * 2 + (nt >> 1)) * 64 + (nt & 1) * 32 + r) * 16 + 8 * h);
#pragma unroll
  for (int s = 0; s < 4; ++s) cf[s] = *reinterpret_cast<const bf16x8*>(p.cc + ((size_t)ldg * 16 + c16) * 128 + 32 * s + 8 * kq);
  float ar[2][4], ai[2][4];
  float a8r_[2], a8i_[2];
  float a32r[2], a32i[2];
#pragma unroll
  for (int st = 0; st < 2; ++st) {
    const float a_r = p.sa[((size_t)ldg * 64 + st * 32 + r) * 2], a_i = p.sa[((size_t)ldg * 64 + st * 32 + r) * 2 + 1];
    ar[st][0] = a_r; ai[st][0] = a_i;
#pragma unroll
    for (int k = 1; k < 4; ++k) { ar[st][k] = ar[st][k - 1] * a_r - ai[st][k - 1] * a_i; ai[st][k] = ar[st][k - 1] * a_i + ai[st][k - 1] * a_r; }
    const float a4r = ar[st][3], a4i = ai[st][3];
    const float a8r = a4r * a4r - a4i * a4i, a8i = 2.f * a4r * a4i;
    a8r_[st] = a8r; a8i_[st] = a8i;
    const float a16r = a8r * a8r - a8i * a8i, a16i = 2.f * a8r * a8i;
    a32r[st] = a16r * a16r - a16i * a16i; a32i[st] = 2.f * a16r * a16i;
  }
  float scr[2] = {0.f, 0.f}, sci[2] = {0.f, 0.f};
  const u16* ubase = p.pbuf + (size_t)b * SEQ * INW + C_US + g * 16 + 8 * h;
  u16* yout = p.ys + ((size_t)dir * ROWS + (size_t)b * SEQ) * 256 + g * 16 + c16;
  bf16x8 uan = *reinterpret_cast<const bf16x8*>(ubase + (size_t)smap(wid * 32 + r, dir) * INW);
  for (int st_ = 0; st_ < SEQ / 256; ++st_) {
    const int sg0 = st_ * 256 + wid * 32;
    const bf16x8 ua = uan;
    { const int sgn = (st_ + 1 < SEQ / 256) ? sg0 + 256 : sg0; uan = *reinterpret_cast<const bf16x8*>(ubase + (size_t)smap(sgn + r, dir) * INW); }
    f32x16 z16 = {};
    f32x16 sre[2], sim[2];
    sre[0] = MFMA32(ua, bb[0], z16); sre[1] = MFMA32(ua, bb[1], z16); sim[0] = MFMA32(ua, bb[2], z16); sim[1] = MFMA32(ua, bb[3], z16);
    float cinr[2][4], cini[2][4];
#pragma unroll
    for (int st = 0; st < 2; ++st) {
      const float a_r = ar[st][0], a_i = ai[st][0];
      float Er[4], Ei[4];
#pragma unroll
      for (int g4 = 0; g4 < 4; ++g4) {
#pragma unroll
        for (int j = 1; j < 4; ++j) {
          const float pr = sre[st][4 * g4 + j - 1], pi = sim[st][4 * g4 + j - 1];
          sre[st][4 * g4 + j] += a_r * pr - a_i * pi;
          sim[st][4 * g4 + j] += a_r * pi + a_i * pr;
        }
        Er[g4] = sre[st][4 * g4 + 3]; Ei[g4] = sim[st][4 * g4 + 3];
      }
      float c_r = 0.f, c_i = 0.f;
      const float a4r = ar[st][3], a4i = ai[st][3];
#pragma unroll
      for (int g4 = 0; g4 < 4; ++g4) {
        const float oEr = __shfl_xor(Er[g4], 32), oEi = __shfl_xor(Ei[g4], 32);
        const float E0r = h ? oEr : Er[g4], E0i = h ? oEi : Ei[g4], E1r = h ? Er[g4] : oEr, E1i = h ? Ei[g4] : oEi;
        const float c0r = c_r, c0i = c_i;
        float nr = a4r * c_r - a4i * c_i + E0r, ni = a4r * c_i + a4i * c_r + E0i; c_r = nr; c_i = ni;
        const float c1r = c_r, c1i = c_i;
        nr = a4r * c_r - a4i * c_i + E1r; ni = a4r * c_i + a4i * c_r + E1i; c_r = nr; c_i = ni;
        cinr[st][g4] = h ? c1r : c0r; cini[st][g4] = h ? c1i : c0i;
      }
      if (h == 0) { exch[(wid * 32 + r) * 4 + st * 2] = c_r; exch[(wid * 32 + r) * 4 + st * 2 + 1] = c_i; }
    }
    __syncthreads();
#pragma unroll
    for (int st = 0; st < 2; ++st) {
      float tr = scr[st], ti = sci[st], mr = tr, mi = ti;
#pragma unroll
      for (int j = 0; j < 8; ++j) {
        const float er = exch[(j * 32 + r) * 4 + st * 2], ei = exch[(j * 32 + r) * 4 + st * 2 + 1];
        if (j == wid) { mr = tr; mi = ti; }
        const float nr = a32r[st] * tr - a32i[st] * ti + er, ni = a32r[st] * ti + a32i[st] * tr + ei; tr = nr; ti = ni;
      }
      scr[st] = tr; sci[st] = ti;
      float qr = h ? (ar[st][3] * mr - ai[st][3] * mi) : mr, qi = h ? (ar[st][3] * mi + ai[st][3] * mr) : mi;
#pragma unroll
      for (int g4 = 0; g4 < 4; ++g4) {
        const float cr_ = cinr[st][g4] + qr, ci_ = cini[st][g4] + qi;
        { const float nq = a8r_[st] * qr - a8i_[st] * qi; qi = a8r_[st] * qi + a8i_[st] * qr; qr = nq; }
#pragma unroll
        for (int j = 0; j < 4; ++j) {
          const int i = 4 * g4 + j;
          const float vr = sre[st][i] + ar[st][j] * cr_ - ai[st][j] * ci_;
          const float vi = sim[st][i] + ar[st][j] * ci_ + ai[st][j] * cr_;
          const int m = crow(i, h);
          const unsigned w = cvtpk(vr, vi);
          Sl[m * 136 + st * 32 + r] = (u16)(w & 0xffffu);
          Sl[m * 136 + 64 + st * 32 + r] = (u16)(w >> 16);
        }
      }
    }
    WAVE_SYNC();
#pragma unroll
    for (int mt = 0; mt < 2; ++mt) {
      f32x4 y = {};
#pragma unroll
      for (int s = 0; s < 4; ++s) {
        const bf16x8 a = *reinterpret_cast<const bf16x8*>(Sl + (mt * 16 + c16) * 136 + 32 * s + 8 * kq);
        y = __builtin_amdgcn_mfma_f32_16x16x32_bf16(a, cf[s], y, 0, 0, 0);
      }
#pragma unroll
      for (int j = 0; j < 4; ++j) { const int s = smap(sg0 + mt * 16 + kq * 4 + j, dir); yout[(size_t)s * 256] = f2bf(y[j]); }
    }
    __syncthreads();
  }
}

DI void phase_mix(const int tix, const Params& p, int l, char* smem, int* s_item, int cbase = 0) {
  const int tid = tix, wid = __builtin_amdgcn_readfirstlane(tid >> 6);
#define NEXT_ITEM(cidx) if (tid == 0) *s_item = atomicAdd(&p.counters[l * 8 + cbase + (cidx)], 1); __syncthreads(); const int item = *s_item; __syncthreads();
  for (int rep = 0; rep < ((PROBE_DUP & 1) ? 2 : 1); ++rep)
  for (;;) { NEXT_ITEM(0 + 3 * rep); if (item >= 128) break; lru_wg_item(tix, p, l, item, smem); }
  for (int rep = 0; rep < ((PROBE_DUP & 2) ? 2 : 1); ++rep)
  for (;;) { NEXT_ITEM(1 + 3 * rep); if (item >= 256) break; s5_wg_item(tix, p, l, item, smem); }
  const int n_att = 1024 + (l == 0 ? 64 : 0);
  for (int rep = 0; rep < ((PROBE_DUP & 4) ? 2 : 1); ++rep)
  for (;;) {
    NEXT_ITEM(2 + 3 * rep); if (item >= n_att) break;
    int b, hm, q0, seq;
    if (item < 1024) { const int qb = item & 15; hm = (item >> 4) & 7; b = item >> 7; q0 = TC + qb * 256; seq = SEQ; }
    else { const int a = item - 1024; hm = a & 7; b = a >> 3; q0 = 0; seq = TC; }
    const u16* base = p.pbuf + (size_t)b * SEQ * INW;
    at::attn_body(tix, base + (size_t)q0 * INW + C_Q + hm * 64, base + C_K + hm * 64, base + C_V + (hm >> 1) * 128,
                  p.obuf + ((size_t)b * SEQ + q0) * 1024 + hm * 128, seq, smem);
  }
#undef NEXT_ITEM
}

DI void unpack8(const bf16x8 v, float* f) {
#pragma unroll
  for (int k = 0; k < 8; ++k) f[k] = bf2f((u16)v[k]);
}
DI bf16x8 pack8(const float* f) {
  u32x4 w = {cvtpk(f[0], f[1]), cvtpk(f[2], f[3]), cvtpk(f[4], f[5]), cvtpk(f[6], f[7])};
  return *reinterpret_cast<bf16x8*>(&w);
}
DI void phase_combine(const int tix, const Params& p, int l, char* smem) {
  const int tid = tix, wid = tid >> 6, lane = tid & 63, r = lane & 31, h = lane >> 5;
  float* zf = (float*)smem;
  u16* zb = (u16*)(smem + 32 * 260 * 4);
  const float lam = p.lamv[l], onem = 1.f - p.lamv[2 + l];
  bf16x8 wg[16];
  { const u16* wt = p.wgluT + (size_t)l * 65536 + (size_t)(wid * 32 + r) * 256 + 8 * h;
#pragma unroll
    for (int s = 0; s < 16; ++s) wg[s] = *reinterpret_cast<const bf16x8*>(wt + 16 * s); }
  const float bglu = p.s5_b_glu[l * 256 + wid * 32 + r];
  const size_t DSTRIDE = (size_t)ROWS * 256;
  for (int item = blockIdx.x; item < ROWS / 32; item += gridDim.x) {
    const int row0 = item * 32;
    if (l == 1 && (row0 % SEQ) < TC) continue;
#pragma unroll
    for (int i = 0; i < 2; ++i) {
      const int id = tid + NTHR * i, rr = id >> 5, c8 = (id & 31) * 8; const size_t row = row0 + rr;
      const u16* pr = p.pbuf + row * INW;
      float h0[8], h1[8], y0[8], y1[8], ga[8], us[8], o[8], z[8];
      unpack8(*reinterpret_cast<const bf16x8*>(p.hl + row * 256 + c8), h0);
      unpack8(*reinterpret_cast<const bf16x8*>(p.hl + DSTRIDE + row * 256 + c8), h1);
      unpack8(*reinterpret_cast<const bf16x8*>(p.ys + row * 256 + c8), y0);
      unpack8(*reinterpret_cast<const bf16x8*>(p.ys + DSTRIDE + row * 256 + c8), y1);
      unpack8(*reinterpret_cast<const bf16x8*>(pr + C_GA + c8), ga);
      unpack8(*reinterpret_cast<const bf16x8*>(pr + C_US + c8), us);
      const f32x4 d0 = *reinterpret_cast<const f32x4*>(p.s5_d + l * 256 + c8), d1 = *reinterpret_cast<const f32x4*>(p.s5_d + l * 256 + c8 + 4);
#pragma unroll
      for (int k = 0; k < 8; ++k) {
        o[k] = (h0[k] + h1[k]) * silu_f(ga[k]);
        z[k] = gelu_tanh((k < 4 ? d0[k] : d1[k - 4]) * us[k] + y0[k] + y1[k]);
      }
      *reinterpret_cast<bf16x8*>(p.nbuf + row * 1024 + c8) = pack8(o);
      *reinterpret_cast<f32x4*>(zf + rr * 260 + c8) = f32x4{z[0], z[1], z[2], z[3]};
      *reinterpret_cast<f32x4*>(zf + rr * 260 + c8 + 4) = f32x4{z[4], z[5], z[6], z[7]};
      *reinterpret_cast<bf16x8*>(zb + rr * 264 + c8) = pack8(z);
    }
    __syncthreads();
    f32x16 acc = {};
#pragma unroll
    for (int s = 0; s < 16; ++s) {
      const bf16x8 a = *reinterpret_cast<const bf16x8*>(zb + r * 264 + 16 * s + 8 * h);
      acc = MFMA32(a, wg[s], acc);
    }
#pragma unroll
    for (int i = 0; i < 16; ++i) {
      const int m = crow(i, h), col = wid * 32 + r;
      const float zz = zf[m * 260 + col];
      zf[m * 260 + col] = zz * sigmoid_f(acc[i] + bglu);
    }
    __syncthreads();
#pragma unroll
    for (int i = 0; i < 2; ++i) {
      const int id = tid + NTHR * i, rr = id >> 5, c8 = (id & 31) * 8; const size_t row = row0 + rr;
      float gs[8], o[8];
      unpack8(*reinterpret_cast<const bf16x8*>(p.pbuf + row * INW + C_GS + c8), gs);
      const f32x4 g0 = *reinterpret_cast<const f32x4*>(zf + rr * 260 + c8), g1 = *reinterpret_cast<const f32x4*>(zf + rr * 260 + c8 + 4);
#pragma unroll
      for (int k = 0; k < 8; ++k) o[k] = (k < 4 ? g0[k] : g1[k - 4]) * silu_f(gs[k]);
      *reinterpret_cast<bf16x8*>(p.nbuf + row * 1024 + 256 + c8) = pack8(o);
    }
#pragma unroll
    for (int it = 0; it < 4; ++it) {
      const int pair = (tid >> 4) + 32 * it, rr = pair >> 2, head = pair & 3, e8 = (tid & 15) * 8; const size_t row = row0 + rr;
      float o1[8], o2[8], gd[8], v[8], o[8];
      unpack8(*reinterpret_cast<const bf16x8*>(p.obuf + row * 1024 + head * 256 + e8), o1);
      unpack8(*reinterpret_cast<const bf16x8*>(p.obuf + row * 1024 + head * 256 + 128 + e8), o2);
      unpack8(*reinterpret_cast<const bf16x8*>(p.pbuf + row * INW + C_GD + head * 128 + e8), gd);
      const f32x4 n0 = *reinterpret_cast<const f32x4*>(p.da_norm_g + l * 128 + e8), n1 = *reinterpret_cast<const f32x4*>(p.da_norm_g + l * 128 + e8 + 4);
      float ss = 0.f;
#pragma unroll
      for (int k = 0; k < 8; ++k) { v[k] = o1[k] - lam * o2[k]; ss += v[k] * v[k]; }
      ss += __shfl_xor(ss, 1); ss += __shfl_xor(ss, 2); ss += __shfl_xor(ss, 4); ss += __shfl_xor(ss, 8);
      const float rinv = rsqrtf(ss * (1.f / 128.f) + EPS) * onem;
#pragma unroll
      for (int k = 0; k < 8; ++k) o[k] = v[k] * rinv * (k < 4 ? n0[k] : n1[k - 4]) * silu_f(gd[k]);
      *reinterpret_cast<bf16x8*>(p.nbuf + row * 1024 + 512 + head * 128 + e8) = pack8(o);
    }
    __syncthreads();
  }
}

DI void phase_final(const int tix, const Params& p) {
  const int wid = tix >> 6, lane = tix & 63;
  for (int row = blockIdx.x * 8 + wid; row < NB * TL; row += gridDim.x * 8) {
    float* src = p.out + (size_t)row * 1024;
    f32x4 v[4]; float ss = 0.f;
#pragma unroll
    for (int i = 0; i < 4; ++i) { v[i] = *(const f32x4*)(src + i * 256 + lane * 4); ss += v[i][0] * v[i][0] + v[i][1] * v[i][1] + v[i][2] * v[i][2] + v[i][3] * v[i][3]; }
    ss = wave_sum(ss);
    const float r = rsqrtf(ss * (1.f / 1024.f) + EPS);
#pragma unroll
    for (int i = 0; i < 4; ++i) {
      f32x4 gg = *(const f32x4*)(p.final_g + i * 256 + lane * 4);
      f32x4 o = {v[i][0] * r * gg[0], v[i][1] * r * gg[1], v[i][2] * r * gg[2], v[i][3] * r * gg[3]};
      *(f32x4*)(src + i * 256 + lane * 4) = o;
    }
  }
}

#if MULTI
template <int K> __global__ void __launch_bounds__(NTHR) phase_kernel(Params p, int ph) {
  extern __shared__ __attribute__((aligned(16))) char smem[];
  __shared__ int s_item;
  const int wid_s = __builtin_amdgcn_readfirstlane((int)__builtin_amdgcn_workitem_id_x() >> 6);
  const int l = (ph - 1) / 5;
  if (K == 0) phase_prep(tid_opaque(wid_s), p, smem);
  else if (K == 6) phase_final(tid_opaque(wid_s), p);
  else if (K == 1) phase_norm(tid_opaque(wid_s), p, l);
  else if (K == 2) gm::gemm_phase<0>(tid_opaque(wid_s), p, l, p.nbuf, p.winT + (size_t)l * 3072 * 1024, 12, smem);
  else if (K == 3) phase_mix(tid_opaque(wid_s), p, l, smem, &s_item);
  else if (K == 4) phase_combine(tid_opaque(wid_s), p, l, smem);
  else gm::gemm_phase<1>(tid_opaque(wid_s), p, l, p.nbuf, p.woutT + (size_t)l * 1024 * 1024, 4, smem);
}
template <int K> static void launch_phase(const Params& p, int ph, hipStream_t stream) {
  (void)hipFuncSetAttribute((const void*)phase_kernel<K>, hipFuncAttributeMaxDynamicSharedMemorySize, LDS_BYTES);
  hipLaunchKernelGGL(phase_kernel<K>, dim3(256), dim3(NTHR), LDS_BYTES, stream, p, ph);
}
#else
__global__ void __launch_bounds__(NTHR) mega_kernel(Params p) {
  extern __shared__ __attribute__((aligned(16))) char smem[];
  __shared__ int s_item;
  const int wid_s = __builtin_amdgcn_readfirstlane((int)__builtin_amdgcn_workitem_id_x() >> 6);
  cg::grid_group grid = cg::this_grid();
  for (int rep = 0; rep < ((PROBE_DUP & 64) ? 2 : 1); ++rep) { phase_prep(tid_opaque(wid_s), p, smem); grid.sync(); }
  for (int l = 0; l < 2; ++l) {
    for (int rep = 0; rep < ((PROBE_DUP & 8) ? 2 : 1); ++rep) { phase_norm(tid_opaque(wid_s), p, l); grid.sync(); }
    for (int rep = 0; rep < ((PROBE_DUP & 16) ? 2 : 1); ++rep) { gm::gemm_phase<0>(tid_opaque(wid_s), p, l, p.nbuf, p.winT + (size_t)l * 3072 * 1024, 12, smem); grid.sync(); }
    for (int rep = 0; rep < ((PROBE_DUP & 128) ? 2 : 1); ++rep) { phase_mix(tid_opaque(wid_s), p, l, smem, &s_item, rep * 3); grid.sync(); }
    for (int rep = 0; rep < ((PROBE_DUP & 32) ? 2 : 1); ++rep) { phase_combine(tid_opaque(wid_s), p, l, smem); grid.sync(); }
    for (int rep = 0; rep < (((PROBE_DUP & 256) && l == 0) ? 2 : 1); ++rep) { gm::gemm_phase<1>(tid_opaque(wid_s), p, l, p.nbuf, p.woutT + (size_t)l * 1024 * 1024, 4, smem); grid.sync(); }
  }
  phase_final(tid_opaque(wid_s), p);
}
#endif

extern "C" void kernel_launch(void* const* d_in, const int* in_sizes, int n_in, void* d_out, int out_size, void* d_ws, size_t ws_size, hipStream_t stream) {
  Params p{};
  const float** pf = (const float**)&p;
  for (int i = 0; i < 29; ++i) pf[i] = (const float*)d_in[i];
  p.out = (float*)d_out;
  char* w = (char*)d_ws; size_t off = 0;
  auto take = [&](size_t bytes) { char* r = w + off; off += (bytes + 255) & ~(size_t)255; return r; };
  p.nbuf = (u16*)take((size_t)ROWS * 1024 * 2);
  p.pbuf = (u16*)take((size_t)ROWS * INW * 2);
  p.hl = (u16*)take((size_t)2 * ROWS * 256 * 2);
  p.ys = (u16*)take((size_t)2 * ROWS * 256 * 2);
  p.obuf = (u16*)take((size_t)ROWS * 1024 * 2);
  p.winT = (u16*)take((size_t)2 * 3072 * 1024 * 2);
  p.woutT = (u16*)take((size_t)2 * 1024 * 1024 * 2);
  p.wgluT = (u16*)take((size_t)2 * 65536 * 2);
  p.bbT = (u16*)take((size_t)64 * 2 * 64 * 16 * 2);
  p.cc = (u16*)take((size_t)131072 * 2);
  p.lruWT = (u16*)take((size_t)32 * 4096 * 2);
  p.hc = (float*)take((size_t)NB * TC * 1024 * 4);
  p.mod = (float*)take((size_t)2 * 9 * 3072 * 4);
  p.sa = (float*)take((size_t)4096 * 2 * 4);
  p.rope = (float*)take((size_t)2048 * 4);
  p.lamv = (float*)take(256);
  p.counters = (int*)take(256);
  if (off > ws_size) { fprintf(stderr, "kernel_launch: workspace too small: need %zu have %zu\n", off, ws_size); return; }
#if MULTI
  launch_phase<0>(p, 0, stream);
  for (int l = 0; l < 2; ++l) {
    launch_phase<1>(p, 1 + 5 * l, stream); launch_phase<2>(p, 2 + 5 * l, stream); launch_phase<3>(p, 3 + 5 * l, stream);
    launch_phase<4>(p, 4 + 5 * l, stream); launch_phase<5>(p, 5 + 5 * l, stream);
  }
  launch_phase<6>(p, 11, stream);
#else
  static int grid_blocks = 0;
  if (!grid_blocks) {
    int dev = 0, cus = 0, per_cu = 0;
    hipGetDevice(&dev);
    hipDeviceGetAttribute(&cus, hipDeviceAttributeMultiprocessorCount, dev);
    hipFuncSetAttribute((const void*)mega_kernel, hipFuncAttributeMaxDynamicSharedMemorySize, LDS_BYTES);
    hipOccupancyMaxActiveBlocksPerMultiprocessor(&per_cu, (const void*)mega_kernel, NTHR, LDS_BYTES);
    if (per_cu < 1) per_cu = 1;
    grid_blocks = cus * per_cu;
  }
  void* args[] = {&p};
  hipError_t e = hipLaunchCooperativeKernel((const void*)mega_kernel, dim3(grid_blocks), dim3(NTHR), args, LDS_BYTES, stream);
  if (e != hipSuccess) fprintf(stderr, "cooperative launch failed: %s (grid %d)\n", hipGetErrorString(e), grid_blocks);
#endif
}
```

```cpp
#include <hip/hip_runtime.h>
#include <hip/hip_bf16.h>
#include <hip/hip_cooperative_groups.h>
#include <cstdio>
#include <cstdint>
namespace cg = cooperative_groups;

#ifndef MULTI
#define MULTI 0
#endif
#ifndef PROBE_DUP
#define PROBE_DUP 0
#endif

#define DI __device__ __forceinline__
typedef unsigned short u16;
using bf16x8 = __attribute__((ext_vector_type(8))) short;
using s16x4  = __attribute__((ext_vector_type(4))) short;
using f32x4  = __attribute__((ext_vector_type(4))) float;
using f32x16 = __attribute__((ext_vector_type(16))) float;
using u32x4  = __attribute__((ext_vector_type(4))) unsigned;

constexpr int NB = 8, TL = 4096, DM = 1024, TC = 256, SEQ = TC + TL, ROWS = NB * SEQ;
constexpr int INW = 3072;
constexpr int C_UA = 0, C_US = 256, C_K = 512, C_V = 1024, C_GA = 1536, C_GS = 1792, C_Q = 2048, C_GD = 2560;
constexpr int NTHR = 512;
constexpr int LDS_BYTES = 131072;
constexpr float EPS = 1e-6f;

struct Params {
  const float *x, *c, *ctx, *c_ctx, *norm_g, *w_mod, *b_mod, *w_in, *w_out, *conv_w, *conv_b, *lru_wa, *lru_ba, *lru_wx, *lru_bx, *lru_lam,
      *s5_lam_re, *s5_lam_im, *s5_log_dt, *s5_b_re, *s5_b_im, *s5_c_re, *s5_c_im, *s5_d, *s5_w_glu, *s5_b_glu, *da_lam, *da_norm_g, *final_g;
  float* out;
  u16 *nbuf, *pbuf, *hl, *ys, *obuf, *winT, *woutT, *wgluT, *bbT, *cc, *lruWT;
  float *hc, *mod, *sa, *rope, *lamv;
  int* counters;
  unsigned* xbar;
};

DI float bf2f(u16 u) { return __uint_as_float(((unsigned)u) << 16); }
DI u16 f2bf(float x) { unsigned u = __float_as_uint(x); u += 0x7fffu + ((u >> 16) & 1u); return (u16)(u >> 16); }
DI float sigmoid_f(float v) { return 1.f / (1.f + __expf(-v)); }
DI float silu_f(float v) { return v / (1.f + __expf(-v)); }
DI float gelu_tanh(float y) { float u = 0.7978845608028654f * (y + 0.044715f * y * y * y); float t = 1.f - 2.f / (__expf(2.f * u) + 1.f); return 0.5f * y * (1.f + t); }
DI int crow(int r, int hi) { return (r & 3) + 8 * (r >> 2) + 4 * hi; }
DI unsigned cvtpk(float lo, float hi) { unsigned r; asm volatile("v_cvt_pk_bf16_f32 %0, %1, %2" : "=v"(r) : "v"(lo), "v"(hi)); return r; }
DI float wave_sum(float v) { for (int o = 32; o > 0; o >>= 1) v += __shfl_xor(v, o); return v; }
DI int tid_opaque(int wid_s) { int t; asm volatile("v_mbcnt_lo_u32_b32 %0, -1, 0\n\tv_mbcnt_hi_u32_b32 %0, -1, %0" : "=v"(t)); return (wid_s << 6) + t; }
#define MFMA32(a, b, c) __builtin_amdgcn_mfma_f32_32x32x16_bf16((a), (b), (c), 0, 0, 0)

DI void transpose_job(const int tix, const float* __restrict__ src, u16* __restrict__ dst, int K, int N, int kt, int nt, float* lds) {
  const int tid = tix, c = tid & 63, r0 = tid >> 6;
  for (int i = 0; i < 8; ++i) { int r = r0 + 8 * i; lds[r * 65 + c] = src[(size_t)(kt * 64 + r) * N + nt * 64 + c]; }
  __syncthreads();
  for (int i = 0; i < 8; ++i) { int r = r0 + 8 * i; dst[(size_t)(nt * 64 + r) * K + kt * 64 + c] = f2bf(lds[c * 65 + r]); }
  __syncthreads();
}

DI void mod_job(const int tix, const Params& p, int job, float* lds) {
  const int tid = tix;
  const int l = job / 96, cb = (job % 96) * 32;
  for (int i = tid; i < 9 * 1024; i += NTHR) { float v = i < 8192 ? p.c[i] : p.c_ctx[i - 8192]; lds[i] = silu_f(v); }
  __syncthreads();
  const int col = tid & 31, kg = tid >> 5;
  float acc[9];
#pragma unroll
  for (int r = 0; r < 9; ++r) acc[r] = 0.f;
  for (int k = kg * 64; k < kg * 64 + 64; ++k) {
    float w = p.w_mod[((size_t)l * 1024 + k) * 3072 + cb + col];
#pragma unroll
    for (int r = 0; r < 9; ++r) acc[r] += lds[r * 1024 + k] * w;
  }
  float* red = lds + 9 * 1024;
#pragma unroll
  for (int r = 0; r < 9; ++r) red[(kg * 9 + r) * 32 + col] = acc[r];
  __syncthreads();
  if (tid < 288) {
    int r = tid >> 5, c2 = tid & 31; float s = p.b_mod[l * 3072 + cb + c2];
    for (int g = 0; g < 16; ++g) s += red[(g * 9 + r) * 32 + c2];
    p.mod[(l * 9 + r) * 3072 + cb + c2] = s;
  }
  __syncthreads();
}

DI void phase_prep(const int tix, const Params& p, char* smem) {
  float* lds = (float*)smem;
  constexpr int J_WIN = 2 * 16 * 48, J_WOUT = 2 * 16 * 16, J_GLU = 2 * 4 * 4, J_LRU = 32, J_MOD = 192;
  constexpr int JT = J_WIN + J_WOUT + J_GLU + J_LRU + J_MOD;
  for (int job = blockIdx.x; job < JT; job += gridDim.x) {
    int j = job;
    if (j < J_WIN) { int l = j / 768, r = j % 768; transpose_job(tix, p.w_in + (size_t)l * 1024 * 3072, p.winT + (size_t)l * 3072 * 1024, 1024, 3072, r / 48, r % 48, lds); continue; }
    j -= J_WIN;
    if (j < J_WOUT) { int l = j / 256, r = j % 256; transpose_job(tix, p.w_out + (size_t)l * 1024 * 1024, p.woutT + (size_t)l * 1024 * 1024, 1024, 1024, r / 16, r % 16, lds); continue; }
    j -= J_WOUT;
    if (j < J_GLU) { int l = j / 16, r = j % 16; transpose_job(tix, p.s5_w_glu + (size_t)l * 65536, p.wgluT + (size_t)l * 65536, 256, 256, r / 4, r % 4, lds); continue; }
    j -= J_GLU;
    if (j < J_LRU) { int m = j >> 1, gate = j & 1;
      transpose_job(tix, (gate ? p.lru_wx : p.lru_wa) + (size_t)m * 4096, p.lruWT + (size_t)(m * 2 + gate) * 4096, 64, 64, 0, 0, lds); continue; }
    j -= J_LRU;
    mod_job(tix, p, j, lds);
  }
  const int gtid = blockIdx.x * NTHR + tix, gsz = gridDim.x * NTHR;
  constexpr int N_S5 = 4096, N_CC = 131072, N_ROPE = 1024;
  for (int i = gtid; i < N_S5 + N_CC + N_ROPE + 4; i += gsz) {
    if (i < N_S5) {
      const int idx = i, ldg = idx >> 6, pp = idx & 63;
      float lr = p.s5_lam_re[idx], li = p.s5_lam_im[idx], dt = expf(p.s5_log_dt[ldg]);
      float mag = expf(lr * dt), ang = li * dt, sn = sinf(ang), cs = cosf(ang);
      float abr = mag * cs, abi = mag * sn, nr = abr - 1.f, ni = abi, den = lr * lr + li * li;
      float cfr = (nr * lr + ni * li) / den, cfi = (ni * lr - nr * li) / den;
      p.sa[idx * 2] = abr; p.sa[idx * 2 + 1] = abi;
      for (int h = 0; h < 16; ++h) {
        float br = p.s5_b_re[idx * 16 + h], bi = p.s5_b_im[idx * 16 + h];
        p.bbT[((size_t)(ldg * 2 + 0) * 64 + pp) * 16 + h] = f2bf(cfr * br - cfi * bi);
        p.bbT[((size_t)(ldg * 2 + 1) * 64 + pp) * 16 + h] = f2bf(cfr * bi + cfi * br);
      }
    } else if (i < N_S5 + N_CC) {
      const int e = i - N_S5, k = e & 127, lc = e >> 7;
      float v = k < 64 ? p.s5_c_re[lc * 64 + k] : -p.s5_c_im[lc * 64 + (k - 64)];
      p.cc[e] = f2bf(v);
    } else if (i < N_S5 + N_CC + N_ROPE) {
      const int e = i - N_S5 - N_CC, pos = e >> 4, f = e & 15;
      float inv = expf(-9.210340371976184f * (float)f / 16.f), ang = (float)pos * inv;
      p.rope[e] = cosf(ang); p.rope[1024 + e] = sinf(ang);
    } else {
      const int e = i - N_S5 - N_CC - N_ROPE;
      if (e < 2) {
        const int l = e; const float* dl = p.da_lam + l * 256;
        float s0 = 0.f, s1 = 0.f;
        for (int k = 0; k < 64; ++k) { s0 += dl[k] * dl[64 + k]; s1 += dl[128 + k] * dl[192 + k]; }
        float lam_init = 0.8f - 0.6f * expf(-0.3f * (float)l);
        p.lamv[l] = expf(s0) - expf(s1) + lam_init; p.lamv[2 + l] = lam_init;
      } else { for (int k = 0; k < 8; ++k) p.counters[(e - 2) * 8 + k] = 0; }
    }
  }
}

DI void phase_norm(const int tix, const Params& p, int l) {
  const int wid = tix >> 6, lane = tix & 63;
  const float* g = p.norm_g + l * 1024;
  for (int row = blockIdx.x * 8 + wid; row < ROWS; row += gridDim.x * 8) {
    const int b = row / SEQ, s = row % SEQ;
    const float* src; int mrow;
    if (s < TC) { src = (l == 0 ? p.ctx : p.hc) + ((size_t)b * TC + s) * 1024; mrow = 8; }
    else { src = (l == 0 ? p.x : p.out) + ((size_t)b * TL + (s - TC)) * 1024; mrow = b; }
    const float* md = p.mod + (l * 9 + mrow) * 3072;
    f32x4 v[4]; float ss = 0.f;
#pragma unroll
    for (int i = 0; i < 4; ++i) { v[i] = *(const f32x4*)(src + i * 256 + lane * 4); ss += v[i][0] * v[i][0] + v[i][1] * v[i][1] + v[i][2] * v[i][2] + v[i][3] * v[i][3]; }
    ss = wave_sum(ss);
    const float r = rsqrtf(ss * (1.f / 1024.f) + EPS);
#pragma unroll
    for (int i = 0; i < 4; ++i) {
      const int c0 = i * 256 + lane * 4;
      f32x4 gg = *(const f32x4*)(g + c0), sh = *(const f32x4*)(md + c0), sc = *(const f32x4*)(md + 1024 + c0);
      float o0 = v[i][0] * r * gg[0] * (1.f + sc[0]) + sh[0], o1 = v[i][1] * r * gg[1] * (1.f + sc[1]) + sh[1];
      float o2 = v[i][2] * r * gg[2] * (1.f + sc[2]) + sh[2], o3 = v[i][3] * r * gg[3] * (1.f + sc[3]) + sh[3];
      uint2 w; w.x = cvtpk(o0, o1); w.y = cvtpk(o2, o3);
      *(uint2*)(p.nbuf + (size_t)row * 1024 + c0) = w;
    }
  }
}

namespace gm {
constexpr int BM = 256, BK = 64, HALF = 128, NXCD = 8, WGM = 8, HT = HALF * BK, KD = 1024;
DI int lds_byte(int r, int c) { int st = (r >> 4) * 2 + (c >> 5), rr = r & 15, cc = c & 31, ob = rr * 64 + cc * 2; return st * 1024 + (ob ^ (((ob >> 9) & 1) << 5)); }
DI void stage_rc(int b, int& R, int& C) { int st = b / 1024, sb = b % 1024, swz = sb ^ (((sb >> 9) & 1) << 5); R = (st >> 1) * 16 + swz / 64; C = (st & 1) * 32 + (swz % 64) / 2; }

template <int MODE>
DI void gemm_tile(const int tix, const Params& p, int l, const u16* __restrict__ A, const u16* __restrict__ Bt, int brow, int bcol, u16* shm) {
  constexpr int K = KD;
#define SA(b, h) (shm + ((b) * 2 + (h)) * HT)
#define SB(b, h) (shm + (4 + (b) * 2 + (h)) * HT)
#define STAGE(P, BASE, br, kt) do { const u16* _gp = (BASE) + ((long)(br) * K + (long)(kt) * BK); \
      __builtin_amdgcn_global_load_lds((const unsigned*)(_gp + voff0), (__attribute__((address_space(3))) unsigned*)((char*)(P) + wbase), 16, 0, 0); \
      __builtin_amdgcn_global_load_lds((const unsigned*)(_gp + voff1), (__attribute__((address_space(3))) unsigned*)((char*)(P) + wbase + 8192), 16, 0, 0); } while (0)
#define LDA(dst, b, h) for (int m = 0; m < 4; ++m) for (int k = 0; k < 2; ++k) \
    dst[m][k] = *reinterpret_cast<const bf16x8*>((char*)SA(b, h) + lds_byte(wr * 64 + m * 16 + fr, k * 32 + fq * 8))
#define LDB(dst, b, h) for (int n = 0; n < 2; ++n) for (int k = 0; k < 2; ++k) \
    dst[n][k] = *reinterpret_cast<const bf16x8*>((char*)SB(b, h) + lds_byte(wc * 32 + n * 16 + fr, k * 32 + fq * 8))
#define MMA(ai, bj, At, Bt_) do { __builtin_amdgcn_s_setprio(1); \
    for (int m = 0; m < 4; ++m) for (int n = 0; n < 2; ++n) for (int k = 0; k < 2; ++k) \
      acc[ai][bj][m][n] = __builtin_amdgcn_mfma_f32_16x16x32_bf16(Bt_[n][k], At[m][k], acc[ai][bj][m][n], 0, 0, 0); \
    __builtin_amdgcn_s_setprio(0); } while (0)
#define WAIT_V(n) asm volatile("s_waitcnt vmcnt(" #n ")" ::: "memory")
#define WAIT_L(n) asm volatile("s_waitcnt lgkmcnt(" #n ")" ::: "memory")
#define BAR __builtin_amdgcn_s_barrier()
#define SCHED __builtin_amdgcn_sched_barrier(0)
  const int wid = __builtin_amdgcn_readfirstlane(tix >> 6), lane = tix & 63, wr = wid >> 2, wc = wid & 3, fr = lane & 15, fq = lane >> 4;
  const int wbase = wid * 1024;
  int voff0, voff1;
  { int _r, _c; stage_rc(tix * 16, _r, _c); voff0 = _r * K + _c; stage_rc(tix * 16 + 8192, _r, _c); voff1 = _r * K + _c; }
  f32x4 acc[2][2][4][2] = {};
  bf16x8 At[4][2], B0[2][2], B1[2][2];
  constexpr int nt = K / BK;
  STAGE(SB(0, 0), Bt, bcol, 0); STAGE(SA(0, 0), A, brow, 0);
  STAGE(SB(0, 1), Bt, bcol + HALF, 0); STAGE(SA(0, 1), A, brow + HALF, 0);
  if (wr == 1) BAR;
  WAIT_V(4); BAR;
  STAGE(SB(1, 0), Bt, bcol, 1); STAGE(SA(1, 0), A, brow, 1); STAGE(SB(1, 1), Bt, bcol + HALF, 1);
  WAIT_V(6); BAR;
  for (int t = 0; t < nt - 2; t += 2) {
    LDB(B0, 0, 0); SCHED; LDA(At, 0, 0); STAGE(SA(1, 1), A, brow + HALF, t + 1);
    WAIT_L(8); BAR; WAIT_L(0); MMA(0, 0, At, B0); BAR; SCHED;
    LDB(B1, 0, 1); STAGE(SB(0, 0), Bt, bcol, t + 2);
    BAR; WAIT_L(0); MMA(0, 1, At, B1); BAR;
    LDA(At, 0, 1); STAGE(SA(0, 0), A, brow, t + 2);
    BAR; WAIT_L(0); MMA(1, 0, At, B0); BAR; SCHED;
    STAGE(SB(0, 1), Bt, bcol + HALF, t + 2);
    WAIT_V(6); BAR; MMA(1, 1, At, B1); BAR;
    LDB(B0, 1, 0); SCHED; LDA(At, 1, 0); STAGE(SA(0, 1), A, brow + HALF, t + 2);
    WAIT_L(8); BAR; WAIT_L(0); MMA(0, 0, At, B0); BAR; SCHED;
    LDB(B1, 1, 1); STAGE(SB(1, 0), Bt, bcol, t + 3);
    BAR; WAIT_L(0); MMA(0, 1, At, B1); BAR;
    LDA(At, 1, 1); STAGE(SA(1, 0), A, brow, t + 3);
    BAR; WAIT_L(0); MMA(1, 0, At, B0); BAR; SCHED;
    STAGE(SB(1, 1), Bt, bcol + HALF, t + 3);
    WAIT_V(6); BAR; MMA(1, 1, At, B1); BAR;
  }
  { LDB(B0, 0, 0); LDA(At, 0, 0); STAGE(SA(1, 1), A, brow + HALF, nt - 1);
    BAR; WAIT_L(0); MMA(0, 0, At, B0); BAR;
    LDB(B1, 0, 1); BAR; WAIT_L(0); MMA(0, 1, At, B1); BAR;
    LDA(At, 0, 1); WAIT_V(4); BAR; WAIT_L(0); MMA(1, 0, At, B0); MMA(1, 1, At, B1); BAR; }
  { LDB(B0, 1, 0); LDA(At, 1, 0); WAIT_V(2); BAR; WAIT_L(0); MMA(0, 0, At, B0); BAR;
    LDB(B1, 1, 1); WAIT_V(0); BAR; WAIT_L(0); MMA(0, 1, At, B1); BAR;
    LDA(At, 1, 1); BAR; WAIT_L(0); MMA(1, 0, At, B0); MMA(1, 1, At, B1); BAR; }
  if (wr == 0) BAR;
  int fr_ = fr, fq_ = fq, wr_ = wr, wc_ = wc;
  asm volatile("" : "+v"(fr_), "+v"(fq_), "+s"(wr_), "+s"(wc_));
#define fr fr_
#define fq fq_
#define wr wr_
#define wc wc_
  const int b = brow / SEQ, s0 = brow % SEQ;
  if (MODE == 0) {
    const bool lat = s0 >= TC;
#pragma unroll
    for (int ai = 0; ai < 2; ++ai)
#pragma unroll
      for (int bj = 0; bj < 2; ++bj) {
        const int colbase = bcol + bj * HALF + wc * 32;
        const bool isrope = lat && ((colbase >= C_K && colbase < C_V) || (colbase >= C_Q && colbase < C_GD));
#pragma unroll
        for (int m = 0; m < 4; ++m) {
          const int lr = ai * HALF + wr * 64 + m * 16 + fr;
          f32x4 x1 = acc[ai][bj][m][0], x2 = acc[ai][bj][m][1];
          if (isrope) {
            const int t = s0 + lr - TC; const int pos = (colbase & 32) ? (t & 63) : (t >> 6);
            const f32x4 cs = *reinterpret_cast<const f32x4*>(p.rope + pos * 16 + fq * 4), sn = *reinterpret_cast<const f32x4*>(p.rope + 1024 + pos * 16 + fq * 4);
            const f32x4 o1 = x1 * cs - x2 * sn, o2 = x2 * cs + x1 * sn; x1 = o1; x2 = o2;
          }
          u16* dst = p.pbuf + (size_t)(brow + lr) * INW + colbase + fq * 4;
          uint2 w1, w2; w1.x = cvtpk(x1[0] + 0.f, x1[1] + 0.f); w1.y = cvtpk(x1[2] + 0.f, x1[3] + 0.f); w2.x = cvtpk(x2[0] + 0.f, x2[1] + 0.f); w2.y = cvtpk(x2[2] + 0.f, x2[3] + 0.f);
          *reinterpret_cast<uint2*>(dst) = w1; *reinterpret_cast<uint2*>(dst + 16) = w2;
        }
      }
  } else {
    const bool isctx = s0 < TC;
    const float* gate = p.mod + (l * 9 + (isctx ? 8 : b)) * 3072 + 2048;
    const float* srcb = isctx ? ((l == 0) ? p.ctx : p.hc) : ((l == 0) ? p.x : p.out);
    float* dstb = isctx ? p.hc : p.out;
    const size_t rbase = isctx ? (size_t)b * TC : ((size_t)b * TL - TC);
#pragma unroll
    for (int ai = 0; ai < 2; ++ai)
#pragma unroll
      for (int bj = 0; bj < 2; ++bj)
#pragma unroll
        for (int n = 0; n < 2; ++n) {
          const int col = bcol + bj * HALF + wc * 32 + n * 16 + fq * 4;
          const f32x4 gt = *reinterpret_cast<const f32x4*>(gate + col);
#pragma unroll
          for (int m = 0; m < 4; ++m) {
            const int lr = ai * HALF + wr * 64 + m * 16 + fr; const int s = s0 + lr;
            const size_t off = (rbase + s) * 1024 + col;
            const f32x4 sv = *reinterpret_cast<const f32x4*>(srcb + off);
            *reinterpret_cast<f32x4*>(dstb + off) = sv + gt * acc[ai][bj][m][n];
          }
        }
  }
  __syncthreads();
#undef fr
#undef fq
#undef wr
#undef wc
#undef SA
#undef SB
#undef STAGE
#undef LDA
#undef LDB
#undef MMA
}

template <int MODE>
DI void gemm_phase(const int tix, const Params& p, int l, const u16* A, const u16* Bt, int nN, char* smem) {
  constexpr int nM = ROWS / BM;
  const int nwg = nM * nN; const bool last = (l == 1);
  for (int T = blockIdx.x; T < nwg; T += gridDim.x) {
    int wgid = T;
    { int q = nwg / NXCD, r = nwg % NXCD, xcd = wgid % NXCD, off = wgid / NXCD; wgid = (xcd < r ? xcd * (q + 1) : r * (q + 1) + (xcd - r) * q) + off; }
    int nig = WGM * nN, gid = wgid / nig, fm = gid * WGM, gsz = min(nM - fm, WGM);
    int pm = fm + ((wgid % nig) % gsz), pn = (wgid % nig) / gsz;
    const bool isctx = (pm % 17) == 0;
    if (last && isctx && (MODE == 1 || pn >= 6)) continue;
    gemm_tile<MODE>(tix, p, l, A, Bt, pm * BM, pn * BM, (u16*)smem);
  }
}
}

namespace at {
constexpr int NW = 8, QBLK = 32, KVBLK = 64;
constexpr float SCALE = 0.125f, THR = 8.f;
constexpr int LDQ = INW, LDK = INW, LDO = 1024;
constexpr int SHM_V = KVBLK * 128 * 2, SHM_K = KVBLK * 64 * 2;
#define KSWZ(row, colB) ((row) * 128 + ((colB) ^ (((row) & 7) << 4)))
#define SBAR() __builtin_amdgcn_sched_barrier(0)

DI void partialSM(f32x16& p0, f32x16& p1, float& m_reg, float& mn, float& alpha) {
  constexpr float C = SCALE * 1.4426950408889634f;
  float pmax = p0[0];
  for (int r = 1; r < 16; ++r) pmax = fmaxf(pmax, p0[r]);
  for (int r = 0; r < 16; ++r) pmax = fmaxf(pmax, p1[r]);
  { auto rr = __builtin_amdgcn_permlane32_swap(__float_as_uint(pmax), __float_as_uint(pmax), false, false);
    pmax = fmaxf(__uint_as_float(rr[0]), __uint_as_float(rr[1])); }
  if (__builtin_expect(__all(pmax - m_reg <= THR / SCALE), 1)) { mn = m_reg; alpha = 1.f; }
  else { mn = fmaxf(m_reg, pmax); alpha = __builtin_amdgcn_exp2f((m_reg - mn) * C); m_reg = mn; }
  float mnC = -mn * C;
  for (int r = 0; r < 16; ++r) p0[r] = fmaf(p0[r], C, mnC);
  for (int r = 0; r < 16; ++r) p1[r] = fmaf(p1[r], C, mnC);
  for (int r = 0; r < 16; ++r) p0[r] = __builtin_amdgcn_exp2f(p0[r]);
}
DI void finishSM(f32x16& p0, f32x16& p1, float alpha, float& l_reg, bf16x8& pa0, bf16x8& pa1, bf16x8& pa2, bf16x8& pa3) {
  for (int r = 0; r < 16; ++r) p1[r] = __builtin_amdgcn_exp2f(p1[r]);
  float ps = 0;
  for (int r = 0; r < 16; ++r) ps += p0[r];
  for (int r = 0; r < 16; ++r) ps += p1[r];
  { auto rr = __builtin_amdgcn_permlane32_swap(__float_as_uint(ps), __float_as_uint(ps), false, false);
    ps = __uint_as_float(rr[0]) + __uint_as_float(rr[1]); }
  l_reg = l_reg * alpha + ps;
#define PK4(P, BASE, OUT) do { unsigned a0 = cvtpk(P[BASE + 0], P[BASE + 1]), a1 = cvtpk(P[BASE + 2], P[BASE + 3]);   \
    unsigned b0 = cvtpk(P[BASE + 4], P[BASE + 5]), b1 = cvtpk(P[BASE + 6], P[BASE + 7]);                              \
    auto r0 = __builtin_amdgcn_permlane32_swap(a0, b0, false, false); auto r1 = __builtin_amdgcn_permlane32_swap(a1, b1, false, false); \
    u32x4 w = {r0[0], r1[0], r0[1], r1[1]}; OUT = *reinterpret_cast<bf16x8*>(&w); } while (0)
  PK4(p0, 0, pa0); PK4(p0, 8, pa1); PK4(p1, 0, pa2); PK4(p1, 8, pa3);
#undef PK4
}
DI void qkt(f32x16& p0, f32x16& p1, const char* Ks, const bf16x8* qr, int r32, int hi) {
  p0 = f32x16{}; p1 = f32x16{};
#pragma unroll
  for (int d0 = 0; d0 < 4; ++d0) { int cb = (d0 * 16 + hi * 8) * 2;
    bf16x8 b0 = *reinterpret_cast<const bf16x8*>(Ks + KSWZ(r32, cb));
    bf16x8 b1 = *reinterpret_cast<const bf16x8*>(Ks + KSWZ(32 + r32, cb));
    p0 = MFMA32(b0, qr[d0], p0);
    p1 = MFMA32(b1, qr[d0], p1); }
}
DI int v_st(int k, int c) { const int kk = (k & ~0xC) | ((k & 4) << 1) | ((k & 8) >> 1); return ((kk >> 3) * 4 + (c >> 5)) * 512 + ((kk & 7) * 32 + (c & 31)) * 2; }
DI int v_rd_base(int lane) { return ((lane & 3) << 3) | (((lane >> 2) & 3) << 6) | (((lane >> 4) & 1) << 5) | (((lane >> 5) & 1) << 8); }
constexpr int v_rd_off(int d0, int ks, int half) { return d0 * 512 + ks * 4096 + half * 2048; }
template <int OFF> DI s16x4 tr_read(int vb) {
  s16x4 r; asm volatile("ds_read_b64_tr_b16 %0, %1 offset:%2" : "=&v"(r) : "v"(vb), "i"(OFF) : "memory"); return r;
}
template <int D0> DI void pv_one(f32x16& od, int vb, bf16x8 pa0, bf16x8 pa1, bf16x8 pa2, bf16x8 pa3) {
  const s16x4 l0 = tr_read<v_rd_off(D0, 0, 0)>(vb), h0 = tr_read<v_rd_off(D0, 0, 1)>(vb), l1 = tr_read<v_rd_off(D0, 1, 0)>(vb), h1 = tr_read<v_rd_off(D0, 1, 1)>(vb);
  const s16x4 l2 = tr_read<v_rd_off(D0, 2, 0)>(vb), h2 = tr_read<v_rd_off(D0, 2, 1)>(vb), l3 = tr_read<v_rd_off(D0, 3, 0)>(vb), h3 = tr_read<v_rd_off(D0, 3, 1)>(vb);
  asm volatile("s_waitcnt lgkmcnt(0)" ::: "memory"); SBAR();
#define PK(L, H) (bf16x8){L[0], L[1], L[2], L[3], H[0], H[1], H[2], H[3]}
  od = MFMA32(pa0, PK(l0, h0), od);
  od = MFMA32(pa1, PK(l1, h1), od);
  od = MFMA32(pa2, PK(l2, h2), od);
  od = MFMA32(pa3, PK(l3, h3), od);
#undef PK
}
DI void pv_d0(f32x16* o, int vb, bf16x8 pa0, bf16x8 pa1, bf16x8 pa2, bf16x8 pa3) {
  pv_one<0>(o[0], vb, pa0, pa1, pa2, pa3); pv_one<1>(o[1], vb, pa0, pa1, pa2, pa3); pv_one<2>(o[2], vb, pa0, pa1, pa2, pa3); pv_one<3>(o[3], vb, pa0, pa1, pa2, pa3);
}

DI void attn_body(const int tix, const u16* __restrict__ Qb, const u16* __restrict__ Kh, const u16* __restrict__ Vh, u16* __restrict__ Ob, int seq, char* lds) {
  const int tid = tix, wid = tid >> 6, lane = tid & 63, r32 = lane & 31, hi = lane >> 5;
  char* V_lds = lds; char* K_lds = lds + 2 * SHM_V;
  float* ws = (float*)(lds + 2 * SHM_V + 2 * SHM_K) + wid * 64; float* li_l = ws; float* al_l = ws + 32;
  float m_reg = -1e30f, l_reg = 0; f32x16 o[4] = {}; bf16x8 qr[4];
  const u16* Qw = Qb + (long)(wid * QBLK + r32) * LDQ + hi * 8;
#pragma unroll
  for (int d0 = 0; d0 < 4; ++d0) qr[d0] = *reinterpret_cast<const bf16x8*>(Qw + d0 * 16);
  const int sr = tid >> 4, sc = (tid & 15) * 8, vst0 = v_st(sr, sc), vst1 = v_st(32 + sr, sc);
  const int ksr = tid >> 3, ksc = (tid & 7) * 8, kst = KSWZ(ksr, ksc * 2);
  const int vb0 = (int)(uintptr_t)V_lds + v_rd_base(lane);
  struct { bf16x8 vs0, vs1, ks0; } sr_[2];
#define SLOAD(i, k0) do { sr_[i].vs0 = *reinterpret_cast<const bf16x8*>(&Vh[(long)((k0) + sr) * LDK + sc]); sr_[i].vs1 = *reinterpret_cast<const bf16x8*>(&Vh[(long)((k0) + 32 + sr) * LDK + sc]); \
    sr_[i].ks0 = *reinterpret_cast<const bf16x8*>(&Kh[(long)((k0) + ksr) * LDK + ksc]); } while (0)
#define SWRITE(b, i) do { *(bf16x8*)(V_lds + (b) * SHM_V + vst0) = sr_[i].vs0;          \
    *(bf16x8*)(V_lds + (b) * SHM_V + vst1) = sr_[i].vs1;               \
    *(bf16x8*)(K_lds + (b) * SHM_K + kst) = sr_[i].ks0; } while (0)
#define SWAIT() asm volatile("s_waitcnt vmcnt(3)" ::: "memory")
#define RESC(a) do { if (__any((a) < 1.f)) { if (hi == 0) al_l[r32] = (a); asm volatile("s_waitcnt lgkmcnt(0)" ::: "memory"); \
    for (int d = 0; d < 4; ++d) for (int r = 0; r < 16; ++r) o[d][r] *= al_l[crow(r, hi)]; } } while (0)
  f32x16 pA0, pA1, pB0, pB1; float mnA, mnB, alA, alB; bf16x8 pa0, pa1, pa2, pa3; const int NT = seq / KVBLK;
  constexpr int SE = 0, SO = 1;
  SLOAD(SE, 0); asm volatile("s_waitcnt vmcnt(0)" ::: "memory"); SWRITE(0, SE); __syncthreads();
  qkt(pA0, pA1, K_lds, qr, r32, hi); partialSM(pA0, pA1, m_reg, mnA, alA);
  SLOAD(SO, KVBLK); if (2 < NT) SLOAD(SE, 2 * KVBLK);
  SWAIT(); SWRITE(1, SO); __syncthreads();
  for (int j = 1; j + 1 < NT; j += 2) {
    SBAR(); qkt(pB0, pB1, K_lds + SHM_K, qr, r32, hi);
    finishSM(pA0, pA1, alA, l_reg, pa0, pa1, pa2, pa3); SBAR();
    SLOAD(SO, (j + 2) * KVBLK); SBAR();
    pv_d0(o, vb0, pa0, pa1, pa2, pa3); partialSM(pB0, pB1, m_reg, mnB, alB);
    __syncthreads(); SWAIT(); SWRITE(0, SE);
    RESC(alB); __syncthreads();
    SBAR(); qkt(pA0, pA1, K_lds, qr, r32, hi);
    finishSM(pB0, pB1, alB, l_reg, pa0, pa1, pa2, pa3); SBAR();
    if (j + 3 < NT) SLOAD(SE, (j + 3) * KVBLK); SBAR();
    pv_d0(o, vb0 + (int)SHM_V, pa0, pa1, pa2, pa3); partialSM(pA0, pA1, m_reg, mnA, alA);
    __syncthreads(); SWAIT(); SWRITE(1, SO);
    RESC(alA); __syncthreads();
  }
  SBAR(); qkt(pB0, pB1, K_lds + SHM_K, qr, r32, hi);
  finishSM(pA0, pA1, alA, l_reg, pa0, pa1, pa2, pa3); SBAR();
  pv_d0(o, vb0, pa0, pa1, pa2, pa3); partialSM(pB0, pB1, m_reg, mnB, alB);
  __syncthreads(); RESC(alB);
  finishSM(pB0, pB1, alB, l_reg, pa0, pa1, pa2, pa3); SBAR();
  pv_d0(o, vb0 + (int)SHM_V, pa0, pa1, pa2, pa3);
  if (hi == 0) li_l[r32] = l_reg; asm volatile("s_waitcnt lgkmcnt(0)" ::: "memory");
  float rli[16];
#pragma unroll
  for (int r = 0; r < 16; ++r) rli[r] = __builtin_amdgcn_rcpf(li_l[crow(r, hi)]);
  u16* Ow = Ob + (long)(wid * QBLK) * LDO;
#pragma unroll
  for (int r = 0; r < 16; ++r) { int orow = crow(r, hi);
#pragma unroll
    for (int d0 = 0; d0 < 4; ++d0) Ow[(long)orow * LDO + d0 * 32 + r32] = f2bf(o[d0][r] * rli[r]); }
  __syncthreads();
#undef SLOAD
#undef SWRITE
#undef SWAIT
#undef RESC
}
}

DI int smap(int sigma, int dir) { return dir == 0 ? sigma : (sigma < TC ? (TC - 1 - sigma) : (SEQ + TC - 1 - sigma)); }

DI float fsig(float v) { return __builtin_amdgcn_rcpf(1.f + __builtin_amdgcn_exp2f(-1.4426950408889634f * v)); }
DI u16 bfr(float x) { return (u16)(cvtpk(x, x) & 0xffffu); }
#define WAVE_SYNC() do { __builtin_amdgcn_fence(__ATOMIC_RELEASE, "wavefront"); __builtin_amdgcn_wave_barrier(); __builtin_amdgcn_fence(__ATOMIC_ACQUIRE, "wavefront"); } while (0)

DI void lru_wg_item(const int tix, const Params& p, int l, int item, char* smem) {
  const int wid = __builtin_amdgcn_readfirstlane(tix >> 6), lane = tix & 63, r = lane & 31, h = lane >> 5;
  const int b = item >> 4, dir = (item >> 3) & 1, n = (item >> 1) & 3, half = item & 1;
  char* wlds = smem + wid * 9216;
  u16* xcb = (u16*)wlds;
  float* xcf = (float*)(wlds + 32 * 144);
  float* exch = (float*)(smem + 8 * 9216);
  const int ld = l * 2 + dir;
  bf16x8 wa[4], wx[4];
  { const u16* wt = p.lruWT + (size_t)(((ld * 4 + n) * 2) * 4096) + (half * 32 + r) * 64 + 8 * h;
#pragma unroll
    for (int s = 0; s < 4; ++s) { wa[s] = *reinterpret_cast<const bf16x8*>(wt + 16 * s); wx[s] = *reinterpret_cast<const bf16x8*>(wt + 4096 + 16 * s); } }
  const int ch = n * 64 + half * 32 + r;
  const float ba = p.lru_ba[ld * 256 + ch], bx = p.lru_bx[ld * 256 + ch];
  const float sp8l = 8.f * 1.4426950408889634f * log1pf(expf(-p.lru_lam[ld * 256 + ch]));
  const int cch = n * 64 + lane;
  const float cw0 = p.conv_w[(l * 4 + 0) * 256 + cch], cw1 = p.conv_w[(l * 4 + 1) * 256 + cch], cw2 = p.conv_w[(l * 4 + 2) * 256 + cch], cw3 = p.conv_w[(l * 4 + 3) * 256 + cch];
  const float cbias = p.conv_b[l * 256 + cch];
  const u16* ubase = p.pbuf + (size_t)b * SEQ * INW + C_UA + cch;
  u16* hout = p.hl + ((size_t)dir * ROWS + (size_t)b * SEQ) * 256 + ch;
  float sc = 0.f;
  u16 un[35];
  { const int sg = wid * 32; const int smin0 = dir == 0 ? sg : smap(sg + 31, 1);
#pragma unroll
    for (int k = 0; k < 35; ++k) { int s = smin0 - 2 + k; s = s < 0 ? 0 : (s > SEQ - 1 ? SEQ - 1 : s); un[k] = ubase[(size_t)s * INW]; } }
  for (int st = 0; st < SEQ / 256; ++st) {
    const int sg0 = st * 256 + wid * 32;
    const int smin = dir == 0 ? sg0 : smap(sg0 + 31, 1);
    const int seg_lo = smin < TC ? 0 : TC, seg_hi = smin < TC ? TC : SEQ;
    float uw[35];
#pragma unroll
    for (int k = 0; k < 35; ++k) { const int s = smin - 2 + k; uw[k] = (s >= seg_lo && s < seg_hi) ? bf2f(un[k]) : 0.f; }
    if (st + 1 < SEQ / 256) {
      const int smin1 = dir == 0 ? sg0 + 256 : smap(sg0 + 256 + 31, 1);
#pragma unroll
      for (int k = 0; k < 35; ++k) { int s = smin1 - 2 + k; s = s < 0 ? 0 : (s > SEQ - 1 ? SEQ - 1 : s); un[k] = ubase[(size_t)s * INW]; }
    }
#pragma unroll
    for (int i = 0; i < 32; ++i) {
      const float xc = cbias + cw0 * uw[i] + cw1 * uw[i + 1] + cw2 * uw[i + 2] + cw3 * uw[i + 3];
      const int m = dir ? 31 - i : i;
      xcb[m * 72 + lane] = bfr(xc);
      if ((lane >> 5) == half) xcf[m * 33 + (lane & 31)] = xc;
    }
    WAVE_SYNC();
    f32x16 ga = {}, gx = {};
#pragma unroll
    for (int s = 0; s < 4; ++s) {
      const bf16x8 a = *reinterpret_cast<const bf16x8*>(xcb + r * 72 + 16 * s + 8 * h);
      ga = MFMA32(a, wa[s], ga); gx = MFMA32(a, wx[s], gx);
    }
    float av[16], hv[16], cum[16];
#pragma unroll
    for (int i = 0; i < 16; ++i) {
      const int m = crow(i, h);
      const float xv = xcf[m * 33 + r];
      const float rr = fsig(ga[i] + ba), ii = fsig(gx[i] + bx);
      const float a = __builtin_amdgcn_exp2f(-sp8l * rr);
      av[i] = a;
      hv[i] = __builtin_amdgcn_sqrtf(fmaxf(1.f - a * a, 0.f)) * (ii * xv);
    }
    float Ag[4], Bg[4];
#pragma unroll
    for (int g = 0; g < 4; ++g) {
      cum[4 * g] = av[4 * g];
#pragma unroll
      for (int j = 1; j < 4; ++j) { hv[4 * g + j] = av[4 * g + j] * hv[4 * g + j - 1] + hv[4 * g + j]; cum[4 * g + j] = cum[4 * g + j - 1] * av[4 * g + j]; }
      Ag[g] = cum[4 * g + 3]; Bg[g] = hv[4 * g + 3];
    }
    float cin0[4], pre[4];
    float cc = 0.f, pp = 1.f;
#pragma unroll
    for (int g = 0; g < 4; ++g) {
      const float oA = __shfl_xor(Ag[g], 32), oB = __shfl_xor(Bg[g], 32);
      const float A0 = h ? oA : Ag[g], B0 = h ? oB : Bg[g], A1 = h ? Ag[g] : oA, B1 = h ? Bg[g] : oB;
      const float c0 = cc, p0 = pp; cc = A0 * cc + B0; pp = A0 * pp;
      const float c1 = cc, p1 = pp; cc = A1 * cc + B1; pp = A1 * pp;
      cin0[g] = h ? c1 : c0; pre[g] = h ? p1 : p0;
    }
    if (h == 0) { exch[(wid * 32 + r) * 2] = pp; exch[(wid * 32 + r) * 2 + 1] = cc; }
    __syncthreads();
    float tc = sc, mycin = sc;
#pragma unroll
    for (int j = 0; j < 8; ++j) { const float Aj = exch[(j * 32 + r) * 2], Bj = exch[(j * 32 + r) * 2 + 1]; if (j == wid) mycin = tc; tc = Aj * tc + Bj; }
    sc = tc;
#pragma unroll
    for (int i = 0; i < 16; ++i) {
      const float hf = hv[i] + cum[i] * (cin0[i >> 2] + pre[i >> 2] * mycin);
      const int s = smap(sg0 + crow(i, h), dir);
      hout[(size_t)s * 256] = bfr(hf);
    }
    __syncthreads();
  }
}

DI void s5_wg_item(const int tix, const Params& p, int l, int item, char* smem) {
  const int wid = __builtin_amdgcn_readfirstlane(tix >> 6), lane = tix & 63, r = lane & 31, h = lane >> 5;
  const int b = item >> 5, dir = (item >> 4) & 1, g = item & 15;
  const int ldg = (l * 2 + dir) * 16 + g;
  u16* Sl = (u16*)(smem + wid * 9216);
  float* exch = (float*)(smem + 8 * 9216);
  bf16x8 bb[4], cf[4];
  const int c16 = lane & 15, kq = lane >> 4;
#pragma unroll
  for (int nt = 0; nt < 4; ++nt) bb[nt] = *reinterpret_cast<const bf16x8*>(p.bbT + ((size_t)(ldg * 2 + (nt >> 1)) * 64 + (nt & 1) * 32 + r) * 16 + 8 * h);
#pragma unroll
  for (int s = 0; s < 4; ++s) cf[s] = *reinterpret_cast<const bf16x8*>(p.cc + ((size_t)ldg * 16 + c16) * 128 + 32 * s + 8 * kq);
  float ar[2][4], ai[2][4];
  float a8r_[2], a8i_[2];
  float a32r[2], a32i[2];
#pragma unroll
  for (int st = 0; st < 2; ++st) {
    const float a_r = p.sa[((size_t)ldg * 64 + st * 32 + r) * 2], a_i = p.sa[((size_t)ldg * 64 + st * 32 + r) * 2 + 1];
    ar[st][0] = a_r; ai[st][0] = a_i;
#pragma unroll
    for (int k = 1; k < 4; ++k) { ar[st][k] = ar[st][k - 1] * a_r - ai[st][k - 1] * a_i; ai[st][k] = ar[st][k - 1] * a_i + ai[st][k - 1] * a_r; }
    const float a4r = ar[st][3], a4i = ai[st][3];
    const float a8r = a4r * a4r - a4i * a4i, a8i = 2.f * a4r * a4i;
    a8r_[st] = a8r; a8i_[st] = a8i;
    const float a16r = a8r * a8r - a8i * a8i, a16i = 2.f * a8r * a8i;
    a32r[st] = a16r * a16r - a16i * a16i; a32i[st] = 2.f * a16r * a16i;
  }
  float scr[2] = {0.f, 0.f}, sci[2] = {0.f, 0.f};
  const u16* ubase = p.pbuf + (size_t)b * SEQ * INW + C_US + g * 16 + 8 * h;
  u16* yout = p.ys + ((size_t)dir * ROWS + (size_t)b * SEQ) * 256 + g * 16 + c16;
  bf16x8 uan = *reinterpret_cast<const bf16x8*>(ubase + (size_t)smap(wid * 32 + r, dir) * INW);
  for (int st_ = 0; st_ < SEQ / 256; ++st_) {
    const int sg0 = st_ * 256 + wid * 32;
    const bf16x8 ua = uan;
    { const int sgn = (st_ + 1 < SEQ / 256) ? sg0 + 256 : sg0; uan = *reinterpret_cast<const bf16x8*>(ubase + (size_t)smap(sgn + r, dir) * INW); }
    f32x16 z16 = {};
    f32x16 sre[2], sim[2];
    sre[0] = MFMA32(ua, bb[0], z16); sre[1] = MFMA32(ua, bb[1], z16); sim[0] = MFMA32(ua, bb[2], z16); sim[1] = MFMA32(ua, bb[3], z16);
    float cinr[2][4], cini[2][4];
#pragma unroll
    for (int st = 0; st < 2; ++st) {
      const float a_r = ar[st][0], a_i = ai[st][0];
      float Er[4], Ei[4];
#pragma unroll
      for (int g4 = 0; g4 < 4; ++g4) {
#pragma unroll
        for (int j = 1; j < 4; ++j) {
          const float pr = sre[st][4 * g4 + j - 1], pi = sim[st][4 * g4 + j - 1];
          sre[st][4 * g4 + j] += a_r * pr - a_i * pi;
          sim[st][4 * g4 + j] += a_r * pi + a_i * pr;
        }
        Er[g4] = sre[st][4 * g4 + 3]; Ei[g4] = sim[st][4 * g4 + 3];
      }
      float c_r = 0.f, c_i = 0.f;
      const float a4r = ar[st][3], a4i = ai[st][3];
#pragma unroll
      for (int g4 = 0; g4 < 4; ++g4) {
        const float oEr = __shfl_xor(Er[g4], 32), oEi = __shfl_xor(Ei[g4], 32);
        const float E0r = h ? oEr : Er[g4], E0i = h ? oEi : Ei[g4], E1r = h ? Er[g4] : oEr, E1i = h ? Ei[g4] : oEi;
        const float c0r = c_r, c0i = c_i;
        float nr = a4r * c_r - a4i * c_i + E0r, ni = a4r * c_i + a4i * c_r + E0i; c_r = nr; c_i = ni;
        const float c1r = c_r, c1i = c_i;
        nr = a4r * c_r - a4i * c_i + E1r; ni = a4r * c_i + a4i * c_r + E1i; c_r = nr; c_i = ni;
        cinr[st][g4] = h ? c1r : c0r; cini[st][g4] = h ? c1i : c0i;
      }
      if (h == 0) { exch[(wid * 32 + r) * 4 + st * 2] = c_r; exch[(wid * 32 + r) * 4 + st * 2 + 1] = c_i; }
    }
    __syncthreads();
#pragma unroll
    for (int st = 0; st < 2; ++st) {
      float tr = scr[st], ti = sci[st], mr = tr, mi = ti;
#pragma unroll
      for (int j = 0; j < 8; ++j) {
        const float er = exch[(j * 32 + r) * 4 + st * 2], ei = exch[(j * 32 + r) * 4 + st * 2 + 1];
        if (j == wid) { mr = tr; mi = ti; }
        const float nr = a32r[st] * tr - a32i[st] * ti + er, ni = a32r[st] * ti + a32i[st] * tr + ei; tr = nr; ti = ni;
      }
      scr[st] = tr; sci[st] = ti;
      float qr = h ? (ar[st][3] * mr - ai[st][3] * mi) : mr, qi = h ? (ar[st][3] * mi + ai[st][3] * mr) : mi;
#pragma unroll
      for (int g4 = 0; g4 < 4; ++g4) {
        const float cr_ = cinr[st][g4] + qr, ci_ = cini[st][g4] + qi;
        { const float nq = a8r_[st] * qr - a8i_[st] * qi; qi = a8r_[st] * qi + a8i_[st] * qr; qr = nq; }
#pragma unroll
        for (int j = 0; j < 4; ++j) {
          const int i = 4 * g4 + j;
          const float vr = sre[st][i] + ar[st][j] * cr_ - ai[st][j] * ci_;
          const float vi = sim[st][i] + ar[st][j] * ci_ + ai[st][j] * cr_;
          const int m = crow(i, h);
          const unsigned w = cvtpk(vr, vi);
          Sl[m * 136 + st * 32 + r] = (u16)(w & 0xffffu);
          Sl[m * 136 + 64 + st * 32 + r] = (u16)(w >> 16);
        }
      }
    }
    WAVE_SYNC();
#pragma unroll
    for (int mt = 0; mt < 2; ++mt) {
      f32x4 y = {};
#pragma unroll
      for (int s = 0; s < 4; ++s) {
        const bf16x8 a = *reinterpret_cast<const bf16x8*>(Sl + (mt * 16 + c16) * 136 + 32 * s + 8 * kq);
        y = __builtin_amdgcn_mfma_f32_16x16x32_bf16(a, cf[s], y, 0, 0, 0);
      }
#pragma unroll
      for (int j = 0; j < 4; ++j) { const int s = smap(sg0 + mt * 16 + kq * 4 + j, dir); yout[(size_t)s * 256] = f2bf(y[j]); }
    }
    __syncthreads();
  }
}

DI void phase_mix(const int tix, const Params& p, int l, char* smem, int* s_item, int cbase = 0) {
  const int tid = tix, wid = __builtin_amdgcn_readfirstlane(tid >> 6);
#define NEXT_ITEM(cidx) if (tid == 0) *s_item = atomicAdd(&p.counters[l * 8 + cbase + (cidx)], 1); __syncthreads(); const int item = *s_item; __syncthreads();
  for (int rep = 0; rep < ((PROBE_DUP & 1) ? 2 : 1); ++rep)
  for (;;) { NEXT_ITEM(0 + 3 * rep); if (item >= 128) break; lru_wg_item(tix, p, l, item, smem); }
  for (int rep = 0; rep < ((PROBE_DUP & 2) ? 2 : 1); ++rep)
  for (;;) { NEXT_ITEM(1 + 3 * rep); if (item >= 256) break; s5_wg_item(tix, p, l, item, smem); }
  const int n_att = 1024 + (l == 0 ? 64 : 0);
  for (int rep = 0; rep < ((PROBE_DUP & 4) ? 2 : 1); ++rep)
  for (;;) {
    NEXT_ITEM(2 + 3 * rep); if (item >= n_att) break;
    int b, hm, q0, seq;
    if (item < 1024) { const int qb = item & 15; hm = (item >> 4) & 7; b = item >> 7; q0 = TC + qb * 256; seq = SEQ; }
    else { const int a = item - 1024; hm = a & 7; b = a >> 3; q0 = 0; seq = TC; }
    const u16* base = p.pbuf + (size_t)b * SEQ * INW;
    at::attn_body(tix, base + (size_t)q0 * INW + C_Q + hm * 64, base + C_K + hm * 64, base + C_V + (hm >> 1) * 128,
                  p.obuf + ((size_t)b * SEQ + q0) * 1024 + hm * 128, seq, smem);
  }
#undef NEXT_ITEM
}

DI void unpack8(const bf16x8 v, float* f) {
#pragma unroll
  for (int k = 0; k < 8; ++k) f[k] = bf2f((u16)v[k]);
}
DI bf16x8 pack8(const float* f) {
  u32x4 w = {cvtpk(f[0], f[1]), cvtpk(f[2], f[3]), cvtpk(f[4], f[5]), cvtpk(f[6], f[7])};
  return *reinterpret_cast<bf16x8*>(&w);
}
DI void phase_combine(const int tix, const Params& p, int l, char* smem) {
  const int tid = tix, wid = tid >> 6, lane = tid & 63, r = lane & 31, h = lane >> 5;
  float* zf = (float*)smem;
  u16* zb = (u16*)(smem + 32 * 260 * 4);
  const float lam = p.lamv[l], onem = 1.f - p.lamv[2 + l];
  bf16x8 wg[16];
  { const u16* wt = p.wgluT + (size_t)l * 65536 + (size_t)(wid * 32 + r) * 256 + 8 * h;
#pragma unroll
    for (int s = 0; s < 16; ++s) wg[s] = *reinterpret_cast<const bf16x8*>(wt + 16 * s); }
  const float bglu = p.s5_b_glu[l * 256 + wid * 32 + r];
  const size_t DSTRIDE = (size_t)ROWS * 256;
  for (int item = blockIdx.x; item < ROWS / 32; item += gridDim.x) {
    const int row0 = item * 32;
    if (l == 1 && (row0 % SEQ) < TC) continue;
#pragma unroll
    for (int i = 0; i < 2; ++i) {
      const int id = tid + NTHR * i, rr = id >> 5, c8 = (id & 31) * 8; const size_t row = row0 + rr;
      const u16* pr = p.pbuf + row * INW;
      float h0[8], h1[8], y0[8], y1[8], ga[8], us[8], o[8], z[8];
      unpack8(*reinterpret_cast<const bf16x8*>(p.hl + row * 256 + c8), h0);
      unpack8(*reinterpret_cast<const bf16x8*>(p.hl + DSTRIDE + row * 256 + c8), h1);
      unpack8(*reinterpret_cast<const bf16x8*>(p.ys + row * 256 + c8), y0);
      unpack8(*reinterpret_cast<const bf16x8*>(p.ys + DSTRIDE + row * 256 + c8), y1);
      unpack8(*reinterpret_cast<const bf16x8*>(pr + C_GA + c8), ga);
      unpack8(*reinterpret_cast<const bf16x8*>(pr + C_US + c8), us);
      const f32x4 d0 = *reinterpret_cast<const f32x4*>(p.s5_d + l * 256 + c8), d1 = *reinterpret_cast<const f32x4*>(p.s5_d + l * 256 + c8 + 4);
#pragma unroll
      for (int k = 0; k < 8; ++k) {
        o[k] = (h0[k] + h1[k]) * silu_f(ga[k]);
        z[k] = gelu_tanh((k < 4 ? d0[k] : d1[k - 4]) * us[k] + y0[k] + y1[k]);
      }
      *reinterpret_cast<bf16x8*>(p.nbuf + row * 1024 + c8) = pack8(o);
      *reinterpret_cast<f32x4*>(zf + rr * 260 + c8) = f32x4{z[0], z[1], z[2], z[3]};
      *reinterpret_cast<f32x4*>(zf + rr * 260 + c8 + 4) = f32x4{z[4], z[5], z[6], z[7]};
      *reinterpret_cast<bf16x8*>(zb + rr * 264 + c8) = pack8(z);
    }
    __syncthreads();
    f32x16 acc = {};
#pragma unroll
    for (int s = 0; s < 16; ++s) {
      const bf16x8 a = *reinterpret_cast<const bf16x8*>(zb + r * 264 + 16 * s + 8 * h);
      acc = MFMA32(a, wg[s], acc);
    }
#pragma unroll
    for (int i = 0; i < 16; ++i) {
      const int m = crow(i, h), col = wid * 32 + r;
      const float zz = zf[m * 260 + col];
      zf[m * 260 + col] = zz * sigmoid_f(acc[i] + bglu);
    }
    __syncthreads();
#pragma unroll
    for (int i = 0; i < 2; ++i) {
      const int id = tid + NTHR * i, rr = id >> 5, c8 = (id & 31) * 8; const size_t row = row0 + rr;
      float gs[8], o[8];
      unpack8(*reinterpret_cast<const bf16x8*>(p.pbuf + row * INW + C_GS + c8), gs);
      const f32x4 g0 = *reinterpret_cast<const f32x4*>(zf + rr * 260 + c8), g1 = *reinterpret_cast<const f32x4*>(zf + rr * 260 + c8 + 4);
#pragma unroll
      for (int k = 0; k < 8; ++k) o[k] = (k < 4 ? g0[k] : g1[k - 4]) * silu_f(gs[k]);
      *reinterpret_cast<bf16x8*>(p.nbuf + row * 1024 + 256 + c8) = pack8(o);
    }
#pragma unroll
    for (int it = 0; it < 4; ++it) {
      const int pair = (tid >> 4) + 32 * it, rr = pair >> 2, head = pair & 3, e8 = (tid & 15) * 8; const size_t row = row0 + rr;
      float o1[8], o2[8], gd[8], v[8], o[8];
      unpack8(*reinterpret_cast<const bf16x8*>(p.obuf + row * 1024 + head * 256 + e8), o1);
      unpack8(*reinterpret_cast<const bf16x8*>(p.obuf + row * 1024 + head * 256 + 128 + e8), o2);
      unpack8(*reinterpret_cast<const bf16x8*>(p.pbuf + row * INW + C_GD + head * 128 + e8), gd);
      const f32x4 n0 = *reinterpret_cast<const f32x4*>(p.da_norm_g + l * 128 + e8), n1 = *reinterpret_cast<const f32x4*>(p.da_norm_g + l * 128 + e8 + 4);
      float ss = 0.f;
#pragma unroll
      for (int k = 0; k < 8; ++k) { v[k] = o1[k] - lam * o2[k]; ss += v[k] * v[k]; }
      ss += __shfl_xor(ss, 1); ss += __shfl_xor(ss, 2); ss += __shfl_xor(ss, 4); ss += __shfl_xor(ss, 8);
      const float rinv = rsqrtf(ss * (1.f / 128.f) + EPS) * onem;
#pragma unroll
      for (int k = 0; k < 8; ++k) o[k] = v[k] * rinv * (k < 4 ? n0[k] : n1[k - 4]) * silu_f(gd[k]);
      *reinterpret_cast<bf16x8*>(p.nbuf + row * 1024 + 512 + head * 128 + e8) = pack8(o);
    }
    __syncthreads();
  }
}

DI void phase_final(const int tix, const Params& p) {
  const int wid = tix >> 6, lane = tix & 63;
  for (int row = blockIdx.x * 8 + wid; row < NB * TL; row += gridDim.x * 8) {
    float* src = p.out + (size_t)row * 1024;
    f32x4 v[4]; float ss = 0.f;
#pragma unroll
    for (int i = 0; i < 4; ++i) { v[i] = *(const f32x4*)(src + i * 256 + lane * 4); ss += v[i][0] * v[i][0] + v[i][1] * v[i][1] + v[i][2] * v[i][2] + v[i][3] * v[i][3]; }
    ss = wave_sum(ss);
    const float r = rsqrtf(ss * (1.f / 1024.f) + EPS);
#pragma unroll
    for (int i = 0; i < 4; ++i) {
      f32x4 gg = *(const f32x4*)(p.final_g + i * 256 + lane * 4);
      f32x4 o = {v[i][0] * r * gg[0], v[i][1] * r * gg[1], v[i][2] * r * gg[2], v[i][3] * r * gg[3]};
      *(f32x4*)(src + i * 256 + lane * 4) = o;
    }
  }
}


#define XB_TMO      128
#define XB_XCNT(j)  (256  + 64 * (j))
#define XB_XSUB(j)  (1280 + 64 * (j))
#define XB_XGEN(j)  (2304 + 64 * (j))
#define XB_TOP      3328
#define XB_TOPGEN   3392
#define XCD_BAR_WORDS 3456
#define XB_SPIN_CAP (1u << 18)
#define LAS __attribute__((address_space(3)))
DI unsigned xb_ld(unsigned* p)              { return __hip_atomic_load(p, __ATOMIC_RELAXED, __HIP_MEMORY_SCOPE_AGENT); }
DI unsigned xb_add(unsigned* p, unsigned v) { return __hip_atomic_fetch_add(p, v, __ATOMIC_RELAXED, __HIP_MEMORY_SCOPE_AGENT); }
DI unsigned xb_xcc_id() { return (unsigned)__builtin_amdgcn_s_getreg((3 << 11) | 20) & 0xFu; }
#define XB_SPIN(cond, bar) do { unsigned _sp = 0; while (cond) { __builtin_amdgcn_s_sleep(1); \
    if ((++_sp & 255u) == 0u) { if (xb_ld(&(bar)[XB_TMO])) break; if (_sp > XB_SPIN_CAP) { atomicAdd(&(bar)[XB_TMO], 1u); break; } } } } while (0)
struct XcdBarrier { unsigned* bar; unsigned x; volatile LAS unsigned* st; };
DI XcdBarrier xcd_barrier_post(int tid, unsigned* bar, volatile LAS unsigned* st) {
  XcdBarrier b; b.bar = bar; b.x = xb_xcc_id(); b.st = st;
  if (tid == 0) (void)xb_add(&bar[XB_XCNT(b.x)], 1u);
  return b;
}
DI void xcd_barrier_complete(unsigned* bar, unsigned x, unsigned& nloc, unsigned& nx) {
  const unsigned G = gridDim.x;
  unsigned sum, cnt, mine, sp = 0u;
  for (;;) {
    sum = 0u; cnt = 0u; mine = 0u;
#pragma unroll
    for (unsigned j = 0; j < 16; ++j) { const unsigned c = xb_ld(&bar[XB_XCNT(j)]); sum += c; cnt += (c > 0u) ? 1u : 0u; mine = (j == x) ? c : mine; }
    if (sum == G) break;
    __builtin_amdgcn_s_sleep(1);
    if ((++sp & 255u) == 0u) { if (xb_ld(&bar[XB_TMO])) break; if (sp > XB_SPIN_CAP) { atomicAdd(&bar[XB_TMO], 1u); break; } }
  }
  nloc = mine > 0u ? mine : 1u; nx = cnt > 0u ? cnt : 1u;
}
DI void xcd_barrier(int tid, const XcdBarrier& b) {
  asm volatile("s_waitcnt vmcnt(0)" ::: "memory");
  __syncthreads();
  if (tid == 0) {
    unsigned* bar = b.bar;
    __builtin_amdgcn_s_waitcnt(0);
    unsigned nloc = b.st[0], nx = b.st[1];
    if (nloc == 0u) { xcd_barrier_complete(bar, b.x, nloc, nx); b.st[0] = nloc; b.st[1] = nx; }
    const unsigned old = xb_add(&bar[XB_XSUB(b.x)], 1u);
    const unsigned gen = old / nloc;
    if (old + 1u == (gen + 1u) * nloc) {
      __builtin_amdgcn_fence(__ATOMIC_RELEASE, "agent");
      asm volatile("s_waitcnt vmcnt(0)" ::: "memory");
      const unsigned og = xb_add(&bar[XB_TOP], 1u);
      const unsigned tg = og / nx;
      if (og + 1u == (tg + 1u) * nx) xb_add(&bar[XB_TOPGEN], 1u);
      else XB_SPIN(xb_ld(&bar[XB_TOPGEN]) == tg, bar);
      __builtin_amdgcn_fence(__ATOMIC_ACQUIRE, "agent");
      xb_add(&bar[XB_XGEN(b.x)], 1u);
      asm volatile("s_waitcnt vmcnt(0)" ::: "memory");
    } else {
      XB_SPIN(xb_ld(&bar[XB_XGEN(b.x)]) == gen, bar);
      __builtin_amdgcn_fence(__ATOMIC_ACQUIRE, "agent");
      asm volatile("s_waitcnt vmcnt(0)" ::: "memory");
    }
  }
  __syncthreads();
}

#if MULTI
template <int K> __global__ void __launch_bounds__(NTHR) phase_kernel(Params p, int ph) {
  extern __shared__ __attribute__((aligned(16))) char smem[];
  __shared__ int s_item;
  const int wid_s = __builtin_amdgcn_readfirstlane((int)__builtin_amdgcn_workitem_id_x() >> 6);
  const int l = (ph - 1) / 5;
  if (K == 0) phase_prep(tid_opaque(wid_s), p, smem);
  else if (K == 6) phase_final(tid_opaque(wid_s), p);
  else if (K == 1) phase_norm(tid_opaque(wid_s), p, l);
  else if (K == 2) gm::gemm_phase<0>(tid_opaque(wid_s), p, l, p.nbuf, p.winT + (size_t)l * 3072 * 1024, 12, smem);
  else if (K == 3) phase_mix(tid_opaque(wid_s), p, l, smem, &s_item);
  else if (K == 4) phase_combine(tid_opaque(wid_s), p, l, smem);
  else gm::gemm_phase<1>(tid_opaque(wid_s), p, l, p.nbuf, p.woutT + (size_t)l * 1024 * 1024, 4, smem);
}
template <int K> static void launch_phase(const Params& p, int ph, hipStream_t stream) {
  (void)hipFuncSetAttribute((const void*)phase_kernel<K>, hipFuncAttributeMaxDynamicSharedMemorySize, LDS_BYTES);
  hipLaunchKernelGGL(phase_kernel<K>, dim3(256), dim3(NTHR), LDS_BYTES, stream, p, ph);
}
#else
__global__ void __launch_bounds__(NTHR) mega_kernel(Params p) {
  extern __shared__ __attribute__((aligned(16))) char smem[];
  __shared__ uint4 sh_words;
  int* s_item = (int*)&sh_words;
  const int wid_s = __builtin_amdgcn_readfirstlane((int)__builtin_amdgcn_workitem_id_x() >> 6);
  cg::grid_group grid = cg::this_grid();
  if (tid_opaque(wid_s) == 0) sh_words = make_uint4(0u, 0u, 0u, 0u);
  __syncthreads();
  XcdBarrier xb = xcd_barrier_post(tid_opaque(wid_s), p.xbar, (volatile LAS unsigned*)((unsigned*)&sh_words + 2));
#define GSYNC() xcd_barrier(tid_opaque(wid_s), xb)
  for (int rep = 0; rep < ((PROBE_DUP & 64) ? 2 : 1); ++rep) { phase_prep(tid_opaque(wid_s), p, smem); grid.sync(); }
  for (int l = 0; l < 2; ++l) {
    for (int rep = 0; rep < ((PROBE_DUP & 8) ? 2 : 1); ++rep) { phase_norm(tid_opaque(wid_s), p, l); GSYNC(); }
    for (int rep = 0; rep < ((PROBE_DUP & 16) ? 2 : 1); ++rep) { gm::gemm_phase<0>(tid_opaque(wid_s), p, l, p.nbuf, p.winT + (size_t)l * 3072 * 1024, 12, smem); GSYNC(); }
    for (int rep = 0; rep < ((PROBE_DUP & 128) ? 2 : 1); ++rep) { phase_mix(tid_opaque(wid_s), p, l, smem, s_item, rep * 3); GSYNC(); }
    for (int rep = 0; rep < ((PROBE_DUP & 32) ? 2 : 1); ++rep) { phase_combine(tid_opaque(wid_s), p, l, smem); GSYNC(); }
    for (int rep = 0; rep < (((PROBE_DUP & 256) && l == 0) ? 2 : 1); ++rep) { gm::gemm_phase<1>(tid_opaque(wid_s), p, l, p.nbuf, p.woutT + (size_t)l * 1024 * 1024, 4, smem); GSYNC(); }
  }
  phase_final(tid_opaque(wid_s), p);
#undef GSYNC
}
#endif

extern "C" void kernel_launch(void* const* d_in, const int* in_sizes, int n_in, void* d_out, int out_size, void* d_ws, size_t ws_size, hipStream_t stream) {
  Params p{};
  const float** pf = (const float**)&p;
  for (int i = 0; i < 29; ++i) pf[i] = (const float*)d_in[i];
  p.out = (float*)d_out;
  char* w = (char*)d_ws; size_t off = 0;
  auto take = [&](size_t bytes) { char* r = w + off; off += (bytes + 255) & ~(size_t)255; return r; };
  p.nbuf = (u16*)take((size_t)ROWS * 1024 * 2);
  p.pbuf = (u16*)take((size_t)ROWS * INW * 2);
  p.hl = (u16*)take((size_t)2 * ROWS * 256 * 2);
  p.ys = (u16*)take((size_t)2 * ROWS * 256 * 2);
  p.obuf = (u16*)take((size_t)ROWS * 1024 * 2);
  p.winT = (u16*)take((size_t)2 * 3072 * 1024 * 2);
  p.woutT = (u16*)take((size_t)2 * 1024 * 1024 * 2);
  p.wgluT = (u16*)take((size_t)2 * 65536 * 2);
  p.bbT = (u16*)take((size_t)64 * 2 * 64 * 16 * 2);
  p.cc = (u16*)take((size_t)131072 * 2);
  p.lruWT = (u16*)take((size_t)32 * 4096 * 2);
  p.hc = (float*)take((size_t)NB * TC * 1024 * 4);
  p.mod = (float*)take((size_t)2 * 9 * 3072 * 4);
  p.sa = (float*)take((size_t)4096 * 2 * 4);
  p.rope = (float*)take((size_t)2048 * 4);
  p.lamv = (float*)take(256);
  p.counters = (int*)take(256);
  p.xbar = (unsigned*)take((size_t)XCD_BAR_WORDS * 4);
  if (off > ws_size) { fprintf(stderr, "kernel_launch: workspace too small: need %zu have %zu\n", off, ws_size); return; }
#if MULTI
  launch_phase<0>(p, 0, stream);
  for (int l = 0; l < 2; ++l) {
    launch_phase<1>(p, 1 + 5 * l, stream); launch_phase<2>(p, 2 + 5 * l, stream); launch_phase<3>(p, 3 + 5 * l, stream);
    launch_phase<4>(p, 4 + 5 * l, stream); launch_phase<5>(p, 5 + 5 * l, stream);
  }
  launch_phase<6>(p, 11, stream);
#else
  static int grid_blocks = 0;
  if (!grid_blocks) {
    int dev = 0, cus = 0, per_cu = 0;
    hipGetDevice(&dev);
    hipDeviceGetAttribute(&cus, hipDeviceAttributeMultiprocessorCount, dev);
    hipFuncSetAttribute((const void*)mega_kernel, hipFuncAttributeMaxDynamicSharedMemorySize, LDS_BYTES);
    hipOccupancyMaxActiveBlocksPerMultiprocessor(&per_cu, (const void*)mega_kernel, NTHR, LDS_BYTES);
    if (per_cu < 1) per_cu = 1;
    grid_blocks = cus * per_cu;
  }
  (void)hipMemsetAsync(p.xbar, 0, (size_t)XCD_BAR_WORDS * 4, stream);
  void* args[] = {&p};
  hipError_t e = hipLaunchCooperativeKernel((const void*)mega_kernel, dim3(grid_blocks), dim3(NTHR), args, LDS_BYTES, stream);
  if (e != hipSuccess) fprintf(stderr, "cooperative launch failed: %s (grid %d)\n", hipGetErrorString(e), grid_blocks);
#endif
}
```

```cpp
#include <hip/hip_runtime.h>
#include <hip/hip_bf16.h>
#include <hip/hip_cooperative_groups.h>
#include <cstdio>
#include <cstdint>
namespace cg = cooperative_groups;

#ifndef MULTI
#define MULTI 0
#endif
#ifndef PROBE_DUP
#define PROBE_DUP 0
#endif

#define DI __device__ __forceinline__
typedef unsigned short u16;
using bf16x8 = __attribute__((ext_vector_type(8))) short;
using s16x4  = __attribute__((ext_vector_type(4))) short;
using f32x4  = __attribute__((ext_vector_type(4))) float;
using f32x16 = __attribute__((ext_vector_type(16))) float;
using u32x4  = __attribute__((ext_vector_type(4))) unsigned;

constexpr int NB = 8, TL = 4096, DM = 1024, TC = 256, SEQ = TC + TL, ROWS = NB * SEQ;
constexpr int INW = 3072;
constexpr int C_UA = 0, C_US = 256, C_K = 512, C_V = 1024, C_GA = 1536, C_GS = 1792, C_Q = 2048, C_GD = 2560;
constexpr int NTHR = 512;
constexpr int LDS_BYTES = 131072;
constexpr float EPS = 1e-6f;

struct Params {
  const float *x, *c, *ctx, *c_ctx, *norm_g, *w_mod, *b_mod, *w_in, *w_out, *conv_w, *conv_b, *lru_wa, *lru_ba, *lru_wx, *lru_bx, *lru_lam,
      *s5_lam_re, *s5_lam_im, *s5_log_dt, *s5_b_re, *s5_b_im, *s5_c_re, *s5_c_im, *s5_d, *s5_w_glu, *s5_b_glu, *da_lam, *da_norm_g, *final_g;
  float* out;
  u16 *nbuf, *pbuf, *hl, *ys, *obuf, *winT, *woutT, *wgluT, *bbT, *cc, *lruWT;
  float *hc, *mod, *sa, *rope, *lamv;
  int* counters;
  unsigned* xbar;
};

DI float bf2f(u16 u) { return __uint_as_float(((unsigned)u) << 16); }
DI u16 f2bf(float x) { unsigned u = __float_as_uint(x); u += 0x7fffu + ((u >> 16) & 1u); return (u16)(u >> 16); }
DI float sigmoid_f(float v) { return 1.f / (1.f + __expf(-v)); }
DI float silu_f(float v) { return v / (1.f + __expf(-v)); }
DI float gelu_tanh(float y) { float u = 0.7978845608028654f * (y + 0.044715f * y * y * y); float t = 1.f - 2.f / (__expf(2.f * u) + 1.f); return 0.5f * y * (1.f + t); }
DI int crow(int r, int hi) { return (r & 3) + 8 * (r >> 2) + 4 * hi; }
DI unsigned cvtpk(float lo, float hi) { unsigned r; asm volatile("v_cvt_pk_bf16_f32 %0, %1, %2" : "=v"(r) : "v"(lo), "v"(hi)); return r; }
DI float wave_sum(float v) { for (int o = 32; o > 0; o >>= 1) v += __shfl_xor(v, o); return v; }
DI int tid_opaque(int wid_s) { int t; asm volatile("v_mbcnt_lo_u32_b32 %0, -1, 0\n\tv_mbcnt_hi_u32_b32 %0, -1, %0" : "=v"(t)); return (wid_s << 6) + t; }
#define MFMA32(a, b, c) __builtin_amdgcn_mfma_f32_32x32x16_bf16((a), (b), (c), 0, 0, 0)

DI void transpose_job(const int tix, const float* __restrict__ src, u16* __restrict__ dst, int K, int N, int kt, int nt, float* lds) {
  const int tid = tix, c = tid & 63, r0 = tid >> 6;
  for (int i = 0; i < 8; ++i) { int r = r0 + 8 * i; lds[r * 65 + c] = src[(size_t)(kt * 64 + r) * N + nt * 64 + c]; }
  __syncthreads();
  for (int i = 0; i < 8; ++i) { int r = r0 + 8 * i; dst[(size_t)(nt * 64 + r) * K + kt * 64 + c] = f2bf(lds[c * 65 + r]); }
  __syncthreads();
}

DI void mod_job(const int tix, const Params& p, int job, float* lds) {
  const int tid = tix;
  const int l = job / 96, cb = (job % 96) * 32;
  for (int i = tid; i < 9 * 1024; i += NTHR) { float v = i < 8192 ? p.c[i] : p.c_ctx[i - 8192]; lds[i] = silu_f(v); }
  __syncthreads();
  const int col = tid & 31, kg = tid >> 5;
  float acc[9];
#pragma unroll
  for (int r = 0; r < 9; ++r) acc[r] = 0.f;
  for (int k = kg * 64; k < kg * 64 + 64; ++k) {
    float w = p.w_mod[((size_t)l * 1024 + k) * 3072 + cb + col];
#pragma unroll
    for (int r = 0; r < 9; ++r) acc[r] += lds[r * 1024 + k] * w;
  }
  float* red = lds + 9 * 1024;
#pragma unroll
  for (int r = 0; r < 9; ++r) red[(kg * 9 + r) * 32 + col] = acc[r];
  __syncthreads();
  if (tid < 288) {
    int r = tid >> 5, c2 = tid & 31; float s = p.b_mod[l * 3072 + cb + c2];
    for (int g = 0; g < 16; ++g) s += red[(g * 9 + r) * 32 + c2];
    p.mod[(l * 9 + r) * 3072 + cb + c2] = s;
  }
  __syncthreads();
}

DI void phase_prep(const int tix, const Params& p, char* smem) {
  float* lds = (float*)smem;
  constexpr int J_WIN = 2 * 16 * 48, J_WOUT = 2 * 16 * 16, J_GLU = 2 * 4 * 4, J_LRU = 32, J_MOD = 192;
  constexpr int JT = J_WIN + J_WOUT + J_GLU + J_LRU + J_MOD;
  for (int job = blockIdx.x; job < JT; job += gridDim.x) {
    int j = job;
    if (j < J_WIN) { int l = j / 768, r = j % 768; transpose_job(tix, p.w_in + (size_t)l * 1024 * 3072, p.winT + (size_t)l * 3072 * 1024, 1024, 3072, r / 48, r % 48, lds); continue; }
    j -= J_WIN;
    if (j < J_WOUT) { int l = j / 256, r = j % 256; transpose_job(tix, p.w_out + (size_t)l * 1024 * 1024, p.woutT + (size_t)l * 1024 * 1024, 1024, 1024, r / 16, r % 16, lds); continue; }
    j -= J_WOUT;
    if (j < J_GLU) { int l = j / 16, r = j % 16; transpose_job(tix, p.s5_w_glu + (size_t)l * 65536, p.wgluT + (size_t)l * 65536, 256, 256, r / 4, r % 4, lds); continue; }
    j -= J_GLU;
    if (j < J_LRU) { int m = j >> 1, gate = j & 1;
      transpose_job(tix, (gate ? p.lru_wx : p.lru_wa) + (size_t)m * 4096, p.lruWT + (size_t)(m * 2 + gate) * 4096, 64, 64, 0, 0, lds); continue; }
    j -= J_LRU;
    mod_job(tix, p, j, lds);
  }
  const int gtid = blockIdx.x * NTHR + tix, gsz = gridDim.x * NTHR;
  constexpr int N_S5 = 4096, N_CC = 131072, N_ROPE = 1024;
  for (int i = gtid; i < N_S5 + N_CC + N_ROPE + 4; i += gsz) {
    if (i < N_S5) {
      const int idx = i, ldg = idx >> 6, pp = idx & 63;
      float lr = p.s5_lam_re[idx], li = p.s5_lam_im[idx], dt = expf(p.s5_log_dt[ldg]);
      float mag = expf(lr * dt), ang = li * dt, sn = sinf(ang), cs = cosf(ang);
      float abr = mag * cs, abi = mag * sn, nr = abr - 1.f, ni = abi, den = lr * lr + li * li;
      float cfr = (nr * lr + ni * li) / den, cfi = (ni * lr - nr * li) / den;
      p.sa[idx * 2] = abr; p.sa[idx * 2 + 1] = abi;
      for (int h = 0; h < 16; ++h) {
        float br = p.s5_b_re[idx * 16 + h], bi = p.s5_b_im[idx * 16 + h];
        p.bbT[((size_t)(ldg * 2 + 0) * 64 + pp) * 16 + h] = f2bf(cfr * br - cfi * bi);
        p.bbT[((size_t)(ldg * 2 + 1) * 64 + pp) * 16 + h] = f2bf(cfr * bi + cfi * br);
      }
    } else if (i < N_S5 + N_CC) {
      const int e = i - N_S5, k = e & 127, lc = e >> 7;
      float v = k < 64 ? p.s5_c_re[lc * 64 + k] : -p.s5_c_im[lc * 64 + (k - 64)];
      p.cc[e] = f2bf(v);
    } else if (i < N_S5 + N_CC + N_ROPE) {
      const int e = i - N_S5 - N_CC, pos = e >> 4, f = e & 15;
      float inv = expf(-9.210340371976184f * (float)f / 16.f), ang = (float)pos * inv;
      p.rope[e] = cosf(ang); p.rope[1024 + e] = sinf(ang);
    } else {
      const int e = i - N_S5 - N_CC - N_ROPE;
      if (e < 2) {
        const int l = e; const float* dl = p.da_lam + l * 256;
        float s0 = 0.f, s1 = 0.f;
        for (int k = 0; k < 64; ++k) { s0 += dl[k] * dl[64 + k]; s1 += dl[128 + k] * dl[192 + k]; }
        float lam_init = 0.8f - 0.6f * expf(-0.3f * (float)l);
        p.lamv[l] = expf(s0) - expf(s1) + lam_init; p.lamv[2 + l] = lam_init;
      } else { for (int k = 0; k < 8; ++k) p.counters[(e - 2) * 8 + k] = 0; }
    }
  }
}

DI void phase_norm(const int tix, const Params& p, int l) {
  const int wid = tix >> 6, lane = tix & 63;
  const float* g = p.norm_g + l * 1024;
  for (int row = blockIdx.x * 8 + wid; row < ROWS; row += gridDim.x * 8) {
    const int b = row / SEQ, s = row % SEQ;
    const float* src; int mrow;
    if (s < TC) { src = (l == 0 ? p.ctx : p.hc) + ((size_t)b * TC + s) * 1024; mrow = 8; }
    else { src = (l == 0 ? p.x : p.out) + ((size_t)b * TL + (s - TC)) * 1024; mrow = b; }
    const float* md = p.mod + (l * 9 + mrow) * 3072;
    f32x4 v[4]; float ss = 0.f;
#pragma unroll
    for (int i = 0; i < 4; ++i) { v[i] = *(const f32x4*)(src + i * 256 + lane * 4); ss += v[i][0] * v[i][0] + v[i][1] * v[i][1] + v[i][2] * v[i][2] + v[i][3] * v[i][3]; }
    ss = wave_sum(ss);
    const float r = rsqrtf(ss * (1.f / 1024.f) + EPS);
#pragma unroll
    for (int i = 0; i < 4; ++i) {
      const int c0 = i * 256 + lane * 4;
      f32x4 gg = *(const f32x4*)(g + c0), sh = *(const f32x4*)(md + c0), sc = *(const f32x4*)(md + 1024 + c0);
      float o0 = v[i][0] * r * gg[0] * (1.f + sc[0]) + sh[0], o1 = v[i][1] * r * gg[1] * (1.f + sc[1]) + sh[1];
      float o2 = v[i][2] * r * gg[2] * (1.f + sc[2]) + sh[2], o3 = v[i][3] * r * gg[3] * (1.f + sc[3]) + sh[3];
      uint2 w; w.x = cvtpk(o0, o1); w.y = cvtpk(o2, o3);
      *(uint2*)(p.nbuf + (size_t)row * 1024 + c0) = w;
    }
  }
}

namespace gm {
constexpr int BM = 256, BK = 64, HALF = 128, NXCD = 8, WGM = 8, HT = HALF * BK, KD = 1024;
DI int lds_byte(int r, int c) { int st = (r >> 4) * 2 + (c >> 5), rr = r & 15, cc = c & 31, ob = rr * 64 + cc * 2; return st * 1024 + (ob ^ (((ob >> 9) & 1) << 5)); }
DI void stage_rc(int b, int& R, int& C) { int st = b / 1024, sb = b % 1024, swz = sb ^ (((sb >> 9) & 1) << 5); R = (st >> 1) * 16 + swz / 64; C = (st & 1) * 32 + (swz % 64) / 2; }

template <int MODE>
DI void gemm_tile(const int tix, const Params& p, int l, const u16* __restrict__ A, const u16* __restrict__ Bt, int brow, int bcol, u16* shm) {
  constexpr int K = KD;
#define SA(b, h) (shm + ((b) * 2 + (h)) * HT)
#define SB(b, h) (shm + (4 + (b) * 2 + (h)) * HT)
#define STAGE(P, BASE, br, kt) do { const u16* _gp = (BASE) + ((long)(br) * K + (long)(kt) * BK); \
      __builtin_amdgcn_global_load_lds((const unsigned*)(_gp + voff0), (__attribute__((address_space(3))) unsigned*)((char*)(P) + wbase), 16, 0, 0); \
      __builtin_amdgcn_global_load_lds((const unsigned*)(_gp + voff1), (__attribute__((address_space(3))) unsigned*)((char*)(P) + wbase + 8192), 16, 0, 0); } while (0)
#define LDA(dst, b, h) for (int m = 0; m < 4; ++m) for (int k = 0; k < 2; ++k) \
    dst[m][k] = *reinterpret_cast<const bf16x8*>((char*)SA(b, h) + lds_byte(wr * 64 + m * 16 + fr, k * 32 + fq * 8))
#define LDB(dst, b, h) for (int n = 0; n < 2; ++n) for (int k = 0; k < 2; ++k) \
    dst[n][k] = *reinterpret_cast<const bf16x8*>((char*)SB(b, h) + lds_byte(wc * 32 + n * 16 + fr, k * 32 + fq * 8))
#define MMA(ai, bj, At, Bt_) do { __builtin_amdgcn_s_setprio(1); \
    for (int m = 0; m < 4; ++m) for (int n = 0; n < 2; ++n) for (int k = 0; k < 2; ++k) \
      acc[ai][bj][m][n] = __builtin_amdgcn_mfma_f32_16x16x32_bf16(Bt_[n][k], At[m][k], acc[ai][bj][m][n], 0, 0, 0); \
    __builtin_amdgcn_s_setprio(0); } while (0)
#define WAIT_V(n) asm volatile("s_waitcnt vmcnt(" #n ")" ::: "memory")
#define WAIT_L(n) asm volatile("s_waitcnt lgkmcnt(" #n ")" ::: "memory")
#define BAR __builtin_amdgcn_s_barrier()
#define SCHED __builtin_amdgcn_sched_barrier(0)
  const int wid = __builtin_amdgcn_readfirstlane(tix >> 6), lane = tix & 63, wr = wid >> 2, wc = wid & 3, fr = lane & 15, fq = lane >> 4;
  const int wbase = wid * 1024;
  int voff0, voff1;
  { int _r, _c; stage_rc(tix * 16, _r, _c); voff0 = _r * K + _c; stage_rc(tix * 16 + 8192, _r, _c); voff1 = _r * K + _c; }
  f32x4 acc[2][2][4][2] = {};
  bf16x8 At[4][2], B0[2][2], B1[2][2];
  constexpr int nt = K / BK;
  STAGE(SB(0, 0), Bt, bcol, 0); STAGE(SA(0, 0), A, brow, 0);
  STAGE(SB(0, 1), Bt, bcol + HALF, 0); STAGE(SA(0, 1), A, brow + HALF, 0);
  if (wr == 1) BAR;
  WAIT_V(4); BAR;
  STAGE(SB(1, 0), Bt, bcol, 1); STAGE(SA(1, 0), A, brow, 1); STAGE(SB(1, 1), Bt, bcol + HALF, 1);
  WAIT_V(6); BAR;
  for (int t = 0; t < nt - 2; t += 2) {
    LDB(B0, 0, 0); SCHED; LDA(At, 0, 0); STAGE(SA(1, 1), A, brow + HALF, t + 1);
    WAIT_L(8); BAR; WAIT_L(0); MMA(0, 0, At, B0); BAR; SCHED;
    LDB(B1, 0, 1); STAGE(SB(0, 0), Bt, bcol, t + 2);
    BAR; WAIT_L(0); MMA(0, 1, At, B1); BAR;
    LDA(At, 0, 1); STAGE(SA(0, 0), A, brow, t + 2);
    BAR; WAIT_L(0); MMA(1, 0, At, B0); BAR; SCHED;
    STAGE(SB(0, 1), Bt, bcol + HALF, t + 2);
    WAIT_V(6); BAR; MMA(1, 1, At, B1); BAR;
    LDB(B0, 1, 0); SCHED; LDA(At, 1, 0); STAGE(SA(0, 1), A, brow + HALF, t + 2);
    WAIT_L(8); BAR; WAIT_L(0); MMA(0, 0, At, B0); BAR; SCHED;
    LDB(B1, 1, 1); STAGE(SB(1, 0), Bt, bcol, t + 3);
    BAR; WAIT_L(0); MMA(0, 1, At, B1); BAR;
    LDA(At, 1, 1); STAGE(SA(1, 0), A, brow, t + 3);
    BAR; WAIT_L(0); MMA(1, 0, At, B0); BAR; SCHED;
    STAGE(SB(1, 1), Bt, bcol + HALF, t + 3);
    WAIT_V(6); BAR; MMA(1, 1, At, B1); BAR;
  }
  { LDB(B0, 0, 0); LDA(At, 0, 0); STAGE(SA(1, 1), A, brow + HALF, nt - 1);
    BAR; WAIT_L(0); MMA(0, 0, At, B0); BAR;
    LDB(B1, 0, 1); BAR; WAIT_L(0); MMA(0, 1, At, B1); BAR;
    LDA(At, 0, 1); WAIT_V(4); BAR; WAIT_L(0); MMA(1, 0, At, B0); MMA(1, 1, At, B1); BAR; }
  { LDB(B0, 1, 0); LDA(At, 1, 0); WAIT_V(2); BAR; WAIT_L(0); MMA(0, 0, At, B0); BAR;
    LDB(B1, 1, 1); WAIT_V(0); BAR; WAIT_L(0); MMA(0, 1, At, B1); BAR;
    LDA(At, 1, 1); BAR; WAIT_L(0); MMA(1, 0, At, B0); MMA(1, 1, At, B1); BAR; }
  if (wr == 0) BAR;
  int fr_ = fr, fq_ = fq, wr_ = wr, wc_ = wc;
  asm volatile("" : "+v"(fr_), "+v"(fq_), "+s"(wr_), "+s"(wc_));
#define fr fr_
#define fq fq_
#define wr wr_
#define wc wc_
  const int b = brow / SEQ, s0 = brow % SEQ;
  if (MODE == 0) {
    const bool lat = s0 >= TC;
#pragma unroll
    for (int ai = 0; ai < 2; ++ai)
#pragma unroll
      for (int bj = 0; bj < 2; ++bj) {
        const int colbase = bcol + bj * HALF + wc * 32;
        const bool isrope = lat && ((colbase >= C_K && colbase < C_V) || (colbase >= C_Q && colbase < C_GD));
#pragma unroll
        for (int m = 0; m < 4; ++m) {
          const int lr = ai * HALF + wr * 64 + m * 16 + fr;
          f32x4 x1 = acc[ai][bj][m][0], x2 = acc[ai][bj][m][1];
          if (isrope) {
            const int t = s0 + lr - TC; const int pos = (colbase & 32) ? (t & 63) : (t >> 6);
            const f32x4 cs = *reinterpret_cast<const f32x4*>(p.rope + pos * 16 + fq * 4), sn = *reinterpret_cast<const f32x4*>(p.rope + 1024 + pos * 16 + fq * 4);
            const f32x4 o1 = x1 * cs - x2 * sn, o2 = x2 * cs + x1 * sn; x1 = o1; x2 = o2;
          }
          u16* dst = p.pbuf + (size_t)(brow + lr) * INW + colbase + fq * 4;
          uint2 w1, w2; w1.x = cvtpk(x1[0] + 0.f, x1[1] + 0.f); w1.y = cvtpk(x1[2] + 0.f, x1[3] + 0.f); w2.x = cvtpk(x2[0] + 0.f, x2[1] + 0.f); w2.y = cvtpk(x2[2] + 0.f, x2[3] + 0.f);
          *reinterpret_cast<uint2*>(dst) = w1; *reinterpret_cast<uint2*>(dst + 16) = w2;
        }
      }
  } else {
    const bool isctx = s0 < TC;
    const float* gate = p.mod + (l * 9 + (isctx ? 8 : b)) * 3072 + 2048;
    const float* srcb = isctx ? ((l == 0) ? p.ctx : p.hc) : ((l == 0) ? p.x : p.out);
    float* dstb = isctx ? p.hc : p.out;
    const size_t rbase = isctx ? (size_t)b * TC : ((size_t)b * TL - TC);
#pragma unroll
    for (int ai = 0; ai < 2; ++ai)
#pragma unroll
      for (int bj = 0; bj < 2; ++bj)
#pragma unroll
        for (int n = 0; n < 2; ++n) {
          const int col = bcol + bj * HALF + wc * 32 + n * 16 + fq * 4;
          const f32x4 gt = *reinterpret_cast<const f32x4*>(gate + col);
#pragma unroll
          for (int m = 0; m < 4; ++m) {
            const int lr = ai * HALF + wr * 64 + m * 16 + fr; const int s = s0 + lr;
            const size_t off = (rbase + s) * 1024 + col;
            const f32x4 sv = *reinterpret_cast<const f32x4*>(srcb + off);
            *reinterpret_cast<f32x4*>(dstb + off) = sv + gt * acc[ai][bj][m][n];
          }
        }
  }
  __syncthreads();
#undef fr
#undef fq
#undef wr
#undef wc
#undef SA
#undef SB
#undef STAGE
#undef LDA
#undef LDB
#undef MMA
}

template <int MODE>
DI void gemm_phase(const int tix, const Params& p, int l, const u16* A, const u16* Bt, int nN, char* smem) {
  constexpr int nM = ROWS / BM;
  const int nwg = nM * nN; const bool last = (l == 1);
  for (int T = blockIdx.x; T < nwg; T += gridDim.x) {
    int wgid = T;
    { int q = nwg / NXCD, r = nwg % NXCD, xcd = wgid % NXCD, off = wgid / NXCD; wgid = (xcd < r ? xcd * (q + 1) : r * (q + 1) + (xcd - r) * q) + off; }
    int nig = WGM * nN, gid = wgid / nig, fm = gid * WGM, gsz = min(nM - fm, WGM);
    int pm = fm + ((wgid % nig) % gsz), pn = (wgid % nig) / gsz;
    const bool isctx = (pm % 17) == 0;
    if (last && isctx && (MODE == 1 || pn >= 6)) continue;
    gemm_tile<MODE>(tix, p, l, A, Bt, pm * BM, pn * BM, (u16*)smem);
  }
}
}


namespace pg {
#define PG_LAS __attribute__((address_space(3)))
constexpr int BM = 256, BK = 64, HALF = 128, HTB = HALF * BK * 2, NXCD = 8, WGM = 8, KD = 1024;
struct Unit { int pm, pn; };
struct Sched {
  int kind, nN, G, c;
  DI bool next(int i, Unit& u) const {
    const int nMv = (kind == 0) ? 136 : 128, main = nMv * nN, total = main + (kind == 2 ? 48 : 0);
    const int L = i * G + c; if (L >= total) return false;
    if (L >= main) { const int e = L - main; u.pm = (e / 6) * 17; u.pn = e % 6; return true; }
    int wgid = L; { const int q = main / NXCD, r = main % NXCD, xcd = wgid % NXCD, off = wgid / NXCD; wgid = (xcd < r ? xcd * (q + 1) : r * (q + 1) + (xcd - r) * q) + off; }
    const int nig = WGM * nN, gid = wgid / nig, fm = gid * WGM, gsz = (nMv - fm) < WGM ? (nMv - fm) : WGM;
    const int v = fm + ((wgid % nig) % gsz); u.pn = (wgid % nig) / gsz;
    u.pm = (kind == 0) ? v : (v + v / 16 + 1);
    return true;
  }
};
struct EpiIn {
  const Params& p; int l;
  DI void operator()(const f32x4 (&acc)[2][2][4][2], const Unit& u, int wr, int wc, int fr, int fq) const {
    const int brow = u.pm * BM, bcol = u.pn * BM;
    const int s0 = brow % SEQ; const bool lat = s0 >= TC;
#pragma unroll
    for (int ai = 0; ai < 2; ++ai)
#pragma unroll
      for (int bj = 0; bj < 2; ++bj) {
        const int colbase = bcol + bj * HALF + wc * 32;
        const bool isrope = lat && ((colbase >= C_K && colbase < C_V) || (colbase >= C_Q && colbase < C_GD));
#pragma unroll
        for (int m = 0; m < 4; ++m) {
          const int lr = ai * HALF + wr * 64 + m * 16 + fr;
          f32x4 x1 = acc[ai][bj][m][0], x2 = acc[ai][bj][m][1];
          if (isrope) {
            const int t = s0 + lr - TC; const int pos = (colbase & 32) ? (t & 63) : (t >> 6);
            const f32x4 cs = *reinterpret_cast<const f32x4*>(p.rope + pos * 16 + fq * 4), sn = *reinterpret_cast<const f32x4*>(p.rope + 1024 + pos * 16 + fq * 4);
            const f32x4 o1 = x1 * cs - x2 * sn, o2 = x2 * cs + x1 * sn; x1 = o1; x2 = o2;
          }
          u16* dst = p.pbuf + (size_t)(brow + lr) * INW + colbase + fq * 4;
          uint2 w1, w2; w1.x = cvtpk(x1[0] + 0.f, x1[1] + 0.f); w1.y = cvtpk(x1[2] + 0.f, x1[3] + 0.f); w2.x = cvtpk(x2[0] + 0.f, x2[1] + 0.f); w2.y = cvtpk(x2[2] + 0.f, x2[3] + 0.f);
          *reinterpret_cast<uint2*>(dst) = w1; *reinterpret_cast<uint2*>(dst + 16) = w2;
        }
      }
  }
};
struct EpiOut {
  const Params& p; int l;
  DI void operator()(const f32x4 (&acc)[2][2][4][2], const Unit& u, int wr, int wc, int fr, int fq) const {
    const int brow = u.pm * BM, bcol = u.pn * BM;
    const int b = brow / SEQ, s0 = brow % SEQ; const bool isctx = s0 < TC;
    const float* gate = p.mod + (l * 9 + (isctx ? 8 : b)) * 3072 + 2048;
    const float* srcb = isctx ? ((l == 0) ? p.ctx : p.hc) : ((l == 0) ? p.x : p.out);
    float* dstb = isctx ? p.hc : p.out;
    const size_t rbase = isctx ? (size_t)b * TC : ((size_t)b * TL - TC);
#pragma unroll
    for (int ai = 0; ai < 2; ++ai)
#pragma unroll
      for (int bj = 0; bj < 2; ++bj)
#pragma unroll
        for (int n = 0; n < 2; ++n) {
          const int col = bcol + bj * HALF + wc * 32 + n * 16 + fq * 4;
          const f32x4 gt = *reinterpret_cast<const f32x4*>(gate + col);
#pragma unroll
          for (int m = 0; m < 4; ++m) {
            const int lr = ai * HALF + wr * 64 + m * 16 + fr; const int s = s0 + lr;
            const size_t off = (rbase + s) * 1024 + col;
            const f32x4 sv = *reinterpret_cast<const f32x4*>(srcb + off);
            *reinterpret_cast<f32x4*>(dstb + off) = sv + gt * acc[ai][bj][m][n];
          }
        }
  }
};

template <class Epi>
DI void gemm_stream(const int tix, PG_LAS unsigned char* lds, const u16* Ab, const u16* Btb, const Sched& S, const Epi& E) {
  const int tid = tix, wid = __builtin_amdgcn_readfirstlane(tid >> 6), lane = tid & 63, wr = wid >> 2, wc = wid & 3, fr = lane & 15, fq = lane >> 4;
  constexpr int K = KD, nt = K / BK;
  unsigned voffA[2];
#pragma unroll
  for (int i = 0; i < 2; ++i) { int R, C; gm::stage_rc(tid * 16 + i * 8192, R, C); voffA[i] = (unsigned)(R * K + C) * 2u; }
  const size_t kstep = (size_t)(BK * 2);
  const size_t hstep = (size_t)HALF * K * 2;
  const size_t tstep = 2 * hstep;
  const unsigned ldsw = (unsigned)wid * 1024u;
  const int aoff = gm::lds_byte(wr * 64 + fr, fq * 8), boff = gm::lds_byte(wc * 32 + fr, fq * 8);
#define PG_SA(b, h) (((b) * 2 + (h)) * HTB)
#define PG_SB(b, h) ((4 + (b) * 2 + (h)) * HTB)
#define PG_STAGE(bufoff, gbase) do { _Pragma("unroll") for (int _i = 0; _i < 2; ++_i) \
    __builtin_amdgcn_global_load_lds((const unsigned*)((const char*)(gbase) + voffA[_i]), (PG_LAS unsigned*)(lds + (bufoff) + ldsw + _i * 8192), 16, 0, 0); } while (0)
#define PG_LDA(dst, b, h) do { _Pragma("unroll") for (int m = 0; m < 4; ++m) _Pragma("unroll") for (int k = 0; k < 2; ++k) dst[m][k] = *(const PG_LAS bf16x8*)(lds + PG_SA(b, h) + aoff + m * 2048 + k * 1024); } while (0)
#define PG_LDB(dst, b, h) do { _Pragma("unroll") for (int n = 0; n < 2; ++n) _Pragma("unroll") for (int k = 0; k < 2; ++k) dst[n][k] = *(const PG_LAS bf16x8*)(lds + PG_SB(b, h) + boff + n * 2048 + k * 1024); } while (0)
#define PG_MMA(ai, bj, At, Bt) do { __builtin_amdgcn_s_setprio(1); _Pragma("unroll") for (int m = 0; m < 4; ++m) _Pragma("unroll") for (int n = 0; n < 2; ++n) _Pragma("unroll") for (int k = 0; k < 2; ++k) \
    acc[ai][bj][m][n] = __builtin_amdgcn_mfma_f32_16x16x32_bf16(Bt[n][k], At[m][k], acc[ai][bj][m][n], 0, 0, 0); __builtin_amdgcn_s_setprio(0); } while (0)
#define PG_WAIT_V(n) asm volatile("s_waitcnt vmcnt(" #n ")" ::: "memory")
#define PG_WAIT_L(n) asm volatile("s_waitcnt lgkmcnt(" #n ")" ::: "memory")
#define PG_BAR __builtin_amdgcn_s_barrier()
#define PG_SCHED __builtin_amdgcn_sched_barrier(0)
  Unit cur, nxt; int ui = 0;
  if (!S.next(0, cur)) return;
  f32x4 acc[2][2][4][2];
#pragma unroll
  for (int a = 0; a < 2; ++a)
#pragma unroll
    for (int b = 0; b < 2; ++b)
#pragma unroll
      for (int m = 0; m < 4; ++m)
#pragma unroll
        for (int n = 0; n < 2; ++n) acc[a][b][m][n] = (f32x4){0.f, 0.f, 0.f, 0.f};
  bf16x8 At[4][2], B0[2][2], B1[2][2];
  const char* cA = (const char*)Ab + (size_t)cur.pm * tstep; const char* cB = (const char*)Btb + (size_t)cur.pn * tstep;
  PG_STAGE(PG_SB(0, 0), cB); PG_STAGE(PG_SA(0, 0), cA); PG_STAGE(PG_SB(0, 1), cB + hstep); PG_STAGE(PG_SA(0, 1), cA + hstep);
  if (wr == 1) PG_BAR;
  PG_WAIT_V(4); PG_BAR;
  PG_STAGE(PG_SB(1, 0), cB + kstep); PG_STAGE(PG_SA(1, 0), cA + kstep); PG_STAGE(PG_SB(1, 1), cB + hstep + kstep);
  PG_WAIT_V(6); PG_BAR;
  for (;;) {
    const bool has_next = S.next(ui + 1, nxt);
    const char* nA = has_next ? (const char*)Ab + (size_t)nxt.pm * tstep : cA; const char* nB = has_next ? (const char*)Btb + (size_t)nxt.pn * tstep : cB;
    for (int t = 0; t < nt; t += 2) {
      const bool last = (t == nt - 2);
      const char* a1 = cA + (size_t)(t + 1) * kstep;
      const char* a2 = last ? nA : cA + (size_t)(t + 2) * kstep; const char* b2 = last ? nB : cB + (size_t)(t + 2) * kstep;
      const char* a3 = a2 + kstep; const char* b3 = b2 + kstep;
      PG_LDB(B0, 0, 0); PG_SCHED; PG_LDA(At, 0, 0); PG_STAGE(PG_SA(1, 1), a1 + hstep);
      PG_WAIT_L(8); PG_BAR; PG_WAIT_L(0); PG_MMA(0, 0, At, B0); PG_BAR; PG_SCHED;
      PG_LDB(B1, 0, 1); PG_STAGE(PG_SB(0, 0), b2);
      PG_BAR; PG_WAIT_L(0); PG_MMA(0, 1, At, B1); PG_BAR;
      PG_LDA(At, 0, 1); PG_STAGE(PG_SA(0, 0), a2);
      PG_BAR; PG_WAIT_L(0); PG_MMA(1, 0, At, B0); PG_BAR; PG_SCHED;
      PG_STAGE(PG_SB(0, 1), b2 + hstep);
      PG_WAIT_V(6); PG_BAR; PG_MMA(1, 1, At, B1); PG_BAR;
      PG_LDB(B0, 1, 0); PG_SCHED; PG_LDA(At, 1, 0); PG_STAGE(PG_SA(0, 1), a2 + hstep);
      PG_WAIT_L(8); PG_BAR; PG_WAIT_L(0); PG_MMA(0, 0, At, B0); PG_BAR; PG_SCHED;
      PG_LDB(B1, 1, 1); PG_STAGE(PG_SB(1, 0), b3);
      PG_BAR; PG_WAIT_L(0); PG_MMA(0, 1, At, B1); PG_BAR;
      PG_LDA(At, 1, 1); PG_STAGE(PG_SA(1, 0), a3);
      PG_BAR; PG_WAIT_L(0); PG_MMA(1, 0, At, B0); PG_BAR; PG_SCHED;
      PG_STAGE(PG_SB(1, 1), b3 + hstep);
      PG_WAIT_V(6); PG_BAR; PG_MMA(1, 1, At, B1); PG_BAR;
    }
    E(acc, cur, wr, wc, fr, fq);
    if (!has_next) break;
#pragma unroll
    for (int a = 0; a < 2; ++a)
#pragma unroll
      for (int b = 0; b < 2; ++b)
#pragma unroll
        for (int m = 0; m < 4; ++m)
#pragma unroll
          for (int n = 0; n < 2; ++n) acc[a][b][m][n] = (f32x4){0.f, 0.f, 0.f, 0.f};
    cur = nxt; cA = nA; cB = nB; ++ui;
  }
  PG_WAIT_V(0);
  if (wr == 0) PG_BAR;
  PG_BAR;
#undef PG_SA
#undef PG_SB
#undef PG_STAGE
#undef PG_LDA
#undef PG_LDB
#undef PG_MMA
#undef PG_WAIT_V
#undef PG_WAIT_L
#undef PG_BAR
#undef PG_SCHED
}
}

namespace at {
constexpr int NW = 8, QBLK = 32, KVBLK = 64;
constexpr float SCALE = 0.125f, THR = 8.f;
constexpr int LDQ = INW, LDK = INW, LDO = 1024;
constexpr int SHM_V = KVBLK * 128 * 2, SHM_K = KVBLK * 64 * 2;
#define KSWZ(row, colB) ((row) * 128 + ((colB) ^ (((row) & 7) << 4)))
#define SBAR() __builtin_amdgcn_sched_barrier(0)

DI void partialSM(f32x16& p0, f32x16& p1, float& m_reg, float& mn, float& alpha) {
  constexpr float C = SCALE * 1.4426950408889634f;
  float pmax = p0[0];
  for (int r = 1; r < 16; ++r) pmax = fmaxf(pmax, p0[r]);
  for (int r = 0; r < 16; ++r) pmax = fmaxf(pmax, p1[r]);
  { auto rr = __builtin_amdgcn_permlane32_swap(__float_as_uint(pmax), __float_as_uint(pmax), false, false);
    pmax = fmaxf(__uint_as_float(rr[0]), __uint_as_float(rr[1])); }
  if (__builtin_expect(__all(pmax - m_reg <= THR / SCALE), 1)) { mn = m_reg; alpha = 1.f; }
  else { mn = fmaxf(m_reg, pmax); alpha = __builtin_amdgcn_exp2f((m_reg - mn) * C); m_reg = mn; }
  float mnC = -mn * C;
  for (int r = 0; r < 16; ++r) p0[r] = fmaf(p0[r], C, mnC);
  for (int r = 0; r < 16; ++r) p1[r] = fmaf(p1[r], C, mnC);
  for (int r = 0; r < 16; ++r) p0[r] = __builtin_amdgcn_exp2f(p0[r]);
}
DI void finishSM(f32x16& p0, f32x16& p1, float alpha, float& l_reg, bf16x8& pa0, bf16x8& pa1, bf16x8& pa2, bf16x8& pa3) {
  for (int r = 0; r < 16; ++r) p1[r] = __builtin_amdgcn_exp2f(p1[r]);
  float ps = 0;
  for (int r = 0; r < 16; ++r) ps += p0[r];
  for (int r = 0; r < 16; ++r) ps += p1[r];
  { auto rr = __builtin_amdgcn_permlane32_swap(__float_as_uint(ps), __float_as_uint(ps), false, false);
    ps = __uint_as_float(rr[0]) + __uint_as_float(rr[1]); }
  l_reg = l_reg * alpha + ps;
#define PK4(P, BASE, OUT) do { unsigned a0 = cvtpk(P[BASE + 0], P[BASE + 1]), a1 = cvtpk(P[BASE + 2], P[BASE + 3]);   \
    unsigned b0 = cvtpk(P[BASE + 4], P[BASE + 5]), b1 = cvtpk(P[BASE + 6], P[BASE + 7]);                              \
    auto r0 = __builtin_amdgcn_permlane32_swap(a0, b0, false, false); auto r1 = __builtin_amdgcn_permlane32_swap(a1, b1, false, false); \
    u32x4 w = {r0[0], r1[0], r0[1], r1[1]}; OUT = *reinterpret_cast<bf16x8*>(&w); } while (0)
  PK4(p0, 0, pa0); PK4(p0, 8, pa1); PK4(p1, 0, pa2); PK4(p1, 8, pa3);
#undef PK4
}
DI void qkt(f32x16& p0, f32x16& p1, const char* Ks, const bf16x8* qr, int r32, int hi) {
  p0 = f32x16{}; p1 = f32x16{};
#pragma unroll
  for (int d0 = 0; d0 < 4; ++d0) { int cb = (d0 * 16 + hi * 8) * 2;
    bf16x8 b0 = *reinterpret_cast<const bf16x8*>(Ks + KSWZ(r32, cb));
    bf16x8 b1 = *reinterpret_cast<const bf16x8*>(Ks + KSWZ(32 + r32, cb));
    p0 = MFMA32(b0, qr[d0], p0);
    p1 = MFMA32(b1, qr[d0], p1); }
}
DI int v_st(int k, int c) { const int kk = (k & ~0xC) | ((k & 4) << 1) | ((k & 8) >> 1); return ((kk >> 3) * 4 + (c >> 5)) * 512 + ((kk & 7) * 32 + (c & 31)) * 2; }
DI int v_rd_base(int lane) { return ((lane & 3) << 3) | (((lane >> 2) & 3) << 6) | (((lane >> 4) & 1) << 5) | (((lane >> 5) & 1) << 8); }
constexpr int v_rd_off(int d0, int ks, int half) { return d0 * 512 + ks * 4096 + half * 2048; }
template <int OFF> DI s16x4 tr_read(int vb) {
  s16x4 r; asm volatile("ds_read_b64_tr_b16 %0, %1 offset:%2" : "=&v"(r) : "v"(vb), "i"(OFF) : "memory"); return r;
}
template <int D0> DI void pv_one(f32x16& od, int vb, bf16x8 pa0, bf16x8 pa1, bf16x8 pa2, bf16x8 pa3) {
  const s16x4 l0 = tr_read<v_rd_off(D0, 0, 0)>(vb), h0 = tr_read<v_rd_off(D0, 0, 1)>(vb), l1 = tr_read<v_rd_off(D0, 1, 0)>(vb), h1 = tr_read<v_rd_off(D0, 1, 1)>(vb);
  const s16x4 l2 = tr_read<v_rd_off(D0, 2, 0)>(vb), h2 = tr_read<v_rd_off(D0, 2, 1)>(vb), l3 = tr_read<v_rd_off(D0, 3, 0)>(vb), h3 = tr_read<v_rd_off(D0, 3, 1)>(vb);
  asm volatile("s_waitcnt lgkmcnt(0)" ::: "memory"); SBAR();
#define PK(L, H) (bf16x8){L[0], L[1], L[2], L[3], H[0], H[1], H[2], H[3]}
  od = MFMA32(pa0, PK(l0, h0), od);
  od = MFMA32(pa1, PK(l1, h1), od);
  od = MFMA32(pa2, PK(l2, h2), od);
  od = MFMA32(pa3, PK(l3, h3), od);
#undef PK
}
DI void pv_d0(f32x16* o, int vb, bf16x8 pa0, bf16x8 pa1, bf16x8 pa2, bf16x8 pa3) {
  pv_one<0>(o[0], vb, pa0, pa1, pa2, pa3); pv_one<1>(o[1], vb, pa0, pa1, pa2, pa3); pv_one<2>(o[2], vb, pa0, pa1, pa2, pa3); pv_one<3>(o[3], vb, pa0, pa1, pa2, pa3);
}

DI void attn_body(const int tix, const u16* __restrict__ Qb, const u16* __restrict__ Kh, const u16* __restrict__ Vh, u16* __restrict__ Ob, int seq, char* lds) {
  const int tid = tix, wid = tid >> 6, lane = tid & 63, r32 = lane & 31, hi = lane >> 5;
  char* V_lds = lds; char* K_lds = lds + 2 * SHM_V;
  float* ws = (float*)(lds + 2 * SHM_V + 2 * SHM_K) + wid * 64; float* li_l = ws; float* al_l = ws + 32;
  float m_reg = -1e30f, l_reg = 0; f32x16 o[4] = {}; bf16x8 qr[4];
  const u16* Qw = Qb + (long)(wid * QBLK + r32) * LDQ + hi * 8;
#pragma unroll
  for (int d0 = 0; d0 < 4; ++d0) qr[d0] = *reinterpret_cast<const bf16x8*>(Qw + d0 * 16);
  const int sr = tid >> 4, sc = (tid & 15) * 8, vst0 = v_st(sr, sc), vst1 = v_st(32 + sr, sc);
  const int ksr = tid >> 3, ksc = (tid & 7) * 8, kst = KSWZ(ksr, ksc * 2);
  const int vb0 = (int)(uintptr_t)V_lds + v_rd_base(lane);
  struct { bf16x8 vs0, vs1, ks0; } sr_[2];
#define SLOAD(i, k0) do { sr_[i].vs0 = *reinterpret_cast<const bf16x8*>(&Vh[(long)((k0) + sr) * LDK + sc]); sr_[i].vs1 = *reinterpret_cast<const bf16x8*>(&Vh[(long)((k0) + 32 + sr) * LDK + sc]); \
    sr_[i].ks0 = *reinterpret_cast<const bf16x8*>(&Kh[(long)((k0) + ksr) * LDK + ksc]); } while (0)
#define SWRITE(b, i) do { *(bf16x8*)(V_lds + (b) * SHM_V + vst0) = sr_[i].vs0;          \
    *(bf16x8*)(V_lds + (b) * SHM_V + vst1) = sr_[i].vs1;               \
    *(bf16x8*)(K_lds + (b) * SHM_K + kst) = sr_[i].ks0; } while (0)
#define SWAIT() asm volatile("s_waitcnt vmcnt(3)" ::: "memory")
#define RESC(a) do { if (__any((a) < 1.f)) { if (hi == 0) al_l[r32] = (a); asm volatile("s_waitcnt lgkmcnt(0)" ::: "memory"); \
    for (int d = 0; d < 4; ++d) for (int r = 0; r < 16; ++r) o[d][r] *= al_l[crow(r, hi)]; } } while (0)
  f32x16 pA0, pA1, pB0, pB1; float mnA, mnB, alA, alB; bf16x8 pa0, pa1, pa2, pa3; const int NT = seq / KVBLK;
  constexpr int SE = 0, SO = 1;
  SLOAD(SE, 0); asm volatile("s_waitcnt vmcnt(0)" ::: "memory"); SWRITE(0, SE); __syncthreads();
  qkt(pA0, pA1, K_lds, qr, r32, hi); partialSM(pA0, pA1, m_reg, mnA, alA);
  SLOAD(SO, KVBLK); if (2 < NT) SLOAD(SE, 2 * KVBLK);
  SWAIT(); SWRITE(1, SO); __syncthreads();
  for (int j = 1; j + 1 < NT; j += 2) {
    SBAR(); qkt(pB0, pB1, K_lds + SHM_K, qr, r32, hi);
    finishSM(pA0, pA1, alA, l_reg, pa0, pa1, pa2, pa3); SBAR();
    SLOAD(SO, (j + 2) * KVBLK); SBAR();
    pv_d0(o, vb0, pa0, pa1, pa2, pa3); partialSM(pB0, pB1, m_reg, mnB, alB);
    __syncthreads(); SWAIT(); SWRITE(0, SE);
    RESC(alB); __syncthreads();
    SBAR(); qkt(pA0, pA1, K_lds, qr, r32, hi);
    finishSM(pB0, pB1, alB, l_reg, pa0, pa1, pa2, pa3); SBAR();
    if (j + 3 < NT) SLOAD(SE, (j + 3) * KVBLK); SBAR();
    pv_d0(o, vb0 + (int)SHM_V, pa0, pa1, pa2, pa3); partialSM(pA0, pA1, m_reg, mnA, alA);
    __syncthreads(); SWAIT(); SWRITE(1, SO);
    RESC(alA); __syncthreads();
  }
  SBAR(); qkt(pB0, pB1, K_lds + SHM_K, qr, r32, hi);
  finishSM(pA0, pA1, alA, l_reg, pa0, pa1, pa2, pa3); SBAR();
  pv_d0(o, vb0, pa0, pa1, pa2, pa3); partialSM(pB0, pB1, m_reg, mnB, alB);
  __syncthreads(); RESC(alB);
  finishSM(pB0, pB1, alB, l_reg, pa0, pa1, pa2, pa3); SBAR();
  pv_d0(o, vb0 + (int)SHM_V, pa0, pa1, pa2, pa3);
  if (hi == 0) li_l[r32] = l_reg; asm volatile("s_waitcnt lgkmcnt(0)" ::: "memory");
  float rli[16];
#pragma unroll
  for (int r = 0; r < 16; ++r) rli[r] = __builtin_amdgcn_rcpf(li_l[crow(r, hi)]);
  u16* Ow = Ob + (long)(wid * QBLK) * LDO;
#pragma unroll
  for (int r = 0; r < 16; ++r) { int orow = crow(r, hi);
#pragma unroll
    for (int d0 = 0; d0 < 4; ++d0) Ow[(long)orow * LDO + d0 * 32 + r32] = f2bf(o[d0][r] * rli[r]); }
  __syncthreads();
#undef SLOAD
#undef SWRITE
#undef SWAIT
#undef RESC
}
}

DI int smap(int sigma, int dir) { return dir == 0 ? sigma : (sigma < TC ? (TC - 1 - sigma) : (SEQ + TC - 1 - sigma)); }

DI float fsig(float v) { return __builtin_amdgcn_rcpf(1.f + __builtin_amdgcn_exp2f(-1.4426950408889634f * v)); }
DI u16 bfr(float x) { return (u16)(cvtpk(x, x) & 0xffffu); }
#define WAVE_SYNC() do { __builtin_amdgcn_fence(__ATOMIC_RELEASE, "wavefront"); __builtin_amdgcn_wave_barrier(); __builtin_amdgcn_fence(__ATOMIC_ACQUIRE, "wavefront"); } while (0)

DI void lru_wg_item(const int tix, const Params& p, int l, int item, char* smem) {
  const int wid = __builtin_amdgcn_readfirstlane(tix >> 6), lane = tix & 63, r = lane & 31, h = lane >> 5;
  const int b = item >> 4, dir = (item >> 3) & 1, n = (item >> 1) & 3, half = item & 1;
  char* wlds = smem + wid * 9216;
  u16* xcb = (u16*)wlds;
  float* xcf = (float*)(wlds + 32 * 144);
  float* exch = (float*)(smem + 8 * 9216);
  const int ld = l * 2 + dir;
  bf16x8 wa[4], wx[4];
  { const u16* wt = p.lruWT + (size_t)(((ld * 4 + n) * 2) * 4096) + (half * 32 + r) * 64 + 8 * h;
#pragma unroll
    for (int s = 0; s < 4; ++s) { wa[s] = *reinterpret_cast<const bf16x8*>(wt + 16 * s); wx[s] = *reinterpret_cast<const bf16x8*>(wt + 4096 + 16 * s); } }
  const int ch = n * 64 + half * 32 + r;
  const float ba = p.lru_ba[ld * 256 + ch], bx = p.lru_bx[ld * 256 + ch];
  const float sp8l = 8.f * 1.4426950408889634f * log1pf(expf(-p.lru_lam[ld * 256 + ch]));
  const int cch = n * 64 + lane;
  const float cw0 = p.conv_w[(l * 4 + 0) * 256 + cch], cw1 = p.conv_w[(l * 4 + 1) * 256 + cch], cw2 = p.conv_w[(l * 4 + 2) * 256 + cch], cw3 = p.conv_w[(l * 4 + 3) * 256 + cch];
  const float cbias = p.conv_b[l * 256 + cch];
  const u16* ubase = p.pbuf + (size_t)b * SEQ * INW + C_UA + cch;
  u16* hout = p.hl + ((size_t)dir * ROWS + (size_t)b * SEQ) * 256 + ch;
  float sc = 0.f;
  u16 un[35];
  { const int sg = wid * 32; const int smin0 = dir == 0 ? sg : smap(sg + 31, 1);
#pragma unroll
    for (int k = 0; k < 35; ++k) { int s = smin0 - 2 + k; s = s < 0 ? 0 : (s > SEQ - 1 ? SEQ - 1 : s); un[k] = ubase[(size_t)s * INW]; } }
  for (int st = 0; st < SEQ / 256; ++st) {
    const int sg0 = st * 256 + wid * 32;
    const int smin = dir == 0 ? sg0 : smap(sg0 + 31, 1);
    const int seg_lo = smin < TC ? 0 : TC, seg_hi = smin < TC ? TC : SEQ;
    float uw[35];
#pragma unroll
    for (int k = 0; k < 35; ++k) { const int s = smin - 2 + k; uw[k] = (s >= seg_lo && s < seg_hi) ? bf2f(un[k]) : 0.f; }
    if (st + 1 < SEQ / 256) {
      const int smin1 = dir == 0 ? sg0 + 256 : smap(sg0 + 256 + 31, 1);
#pragma unroll
      for (int k = 0; k < 35; ++k) { int s = smin1 - 2 + k; s = s < 0 ? 0 : (s > SEQ - 1 ? SEQ - 1 : s); un[k] = ubase[(size_t)s * INW]; }
    }
#pragma unroll
    for (int i = 0; i < 32; ++i) {
      const float xc = cbias + cw0 * uw[i] + cw1 * uw[i + 1] + cw2 * uw[i + 2] + cw3 * uw[i + 3];
      const int m = dir ? 31 - i : i;
      xcb[m * 72 + lane] = bfr(xc);
      if ((lane >> 5) == half) xcf[m * 33 + (lane & 31)] = xc;
    }
    WAVE_SYNC();
    f32x16 ga = {}, gx = {};
#pragma unroll
    for (int s = 0; s < 4; ++s) {
      const bf16x8 a = *reinterpret_cast<const bf16x8*>(xcb + r * 72 + 16 * s + 8 * h);
      ga = MFMA32(a, wa[s], ga); gx = MFMA32(a, wx[s], gx);
    }
    float av[16], hv[16], cum[16];
#pragma unroll
    for (int i = 0; i < 16; ++i) {
      const int m = crow(i, h);
      const float xv = xcf[m * 33 + r];
      const float rr = fsig(ga[i] + ba), ii = fsig(gx[i] + bx);
      const float a = __builtin_amdgcn_exp2f(-sp8l * rr);
      av[i] = a;
      hv[i] = __builtin_amdgcn_sqrtf(fmaxf(1.f - a * a, 0.f)) * (ii * xv);
    }
    float Ag[4], Bg[4];
#pragma unroll
    for (int g = 0; g < 4; ++g) {
      cum[4 * g] = av[4 * g];
#pragma unroll
      for (int j = 1; j < 4; ++j) { hv[4 * g + j] = av[4 * g + j] * hv[4 * g + j - 1] + hv[4 * g + j]; cum[4 * g + j] = cum[4 * g + j - 1] * av[4 * g + j]; }
      Ag[g] = cum[4 * g + 3]; Bg[g] = hv[4 * g + 3];
    }
    float cin0[4], pre[4];
    float cc = 0.f, pp = 1.f;
#pragma unroll
    for (int g = 0; g < 4; ++g) {
      const float oA = __shfl_xor(Ag[g], 32), oB = __shfl_xor(Bg[g], 32);
      const float A0 = h ? oA : Ag[g], B0 = h ? oB : Bg[g], A1 = h ? Ag[g] : oA, B1 = h ? Bg[g] : oB;
      const float c0 = cc, p0 = pp; cc = A0 * cc + B0; pp = A0 * pp;
      const float c1 = cc, p1 = pp; cc = A1 * cc + B1; pp = A1 * pp;
      cin0[g] = h ? c1 : c0; pre[g] = h ? p1 : p0;
    }
    if (h == 0) { exch[(wid * 32 + r) * 2] = pp; exch[(wid * 32 + r) * 2 + 1] = cc; }
    __syncthreads();
    float tc = sc, mycin = sc;
#pragma unroll
    for (int j = 0; j < 8; ++j) { const float Aj = exch[(j * 32 + r) * 2], Bj = exch[(j * 32 + r) * 2 + 1]; if (j == wid) mycin = tc; tc = Aj * tc + Bj; }
    sc = tc;
#pragma unroll
    for (int i = 0; i < 16; ++i) {
      const float hf = hv[i] + cum[i] * (cin0[i >> 2] + pre[i >> 2] * mycin);
      const int s = smap(sg0 + crow(i, h), dir);
      hout[(size_t)s * 256] = bfr(hf);
    }
    __syncthreads();
  }
}

DI void s5_wg_item(const int tix, const Params& p, int l, int item, char* smem) {
  const int wid = __builtin_amdgcn_readfirstlane(tix >> 6), lane = tix & 63, r = lane & 31, h = lane >> 5;
  const int b = item >> 5, dir = (item >> 4) & 1, g = item & 15;
  const int ldg = (l * 2 + dir) * 16 + g;
  u16* Sl = (u16*)(smem + wid * 9216);
  float* exch = (float*)(smem + 8 * 9216);
  bf16x8 bb[4], cf[4];
  const int c16 = lane & 15, kq = lane >> 4;
#pragma unroll
  for (int nt = 0; nt < 4; ++nt) bb[nt] = *reinterpret_cast<const bf16x8*>(p.bbT + ((size_t)(ldg * 2 + (nt >> 1)) * 64 + (nt & 1) * 32 + r) * 16 + 8 * h);
#pragma unroll
  for (int s = 0; s < 4; ++s) cf[s] = *reinterpret_cast<const bf16x8*>(p.cc + ((size_t)ldg * 16 + c16) * 128 + 32 * s + 8 * kq);
  float ar[2][4], ai[2][4];
  float a8r_[2], a8i_[2];
  float a32r[2], a32i[2];
#pragma unroll
  for (int st = 0; st < 2; ++st) {
    const float a_r = p.sa[((size_t)ldg * 64 + st * 32 + r) * 2], a_i = p.sa[((size_t)ldg * 64 + st * 32 + r) * 2 + 1];
    ar[st][0] = a_r; ai[st][0] = a_i;
#pragma unroll
    for (int k = 1; k < 4; ++k) { ar[st][k] = ar[st][k - 1] * a_r - ai[st][k - 1] * a_i; ai[st][k] = ar[st][k - 1] * a_i + ai[st][k - 1] * a_r; }
    const float a4r = ar[st][3], a4i = ai[st][3];
    const float a8r = a4r * a4r - a4i * a4i, a8i = 2.f * a4r * a4i;
    a8r_[st] = a8r; a8i_[st] = a8i;
    const float a16r = a8r * a8r - a8i * a8i, a16i = 2.f * a8r * a8i;
    a32r[st] = a16r * a16r - a16i * a16i; a32i[st] = 2.f * a16r * a16i;
  }
  float scr[2] = {0.f, 0.f}, sci[2] = {0.f, 0.f};
  const u16* ubase = p.pbuf + (size_t)b * SEQ * INW + C_US + g * 16 + 8 * h;
  u16* yout = p.ys + ((size_t)dir * ROWS + (size_t)b * SEQ) * 256 + g * 16 + c16;
  bf16x8 uan = *reinterpret_cast<const bf16x8*>(ubase + (size_t)smap(wid * 32 + r, dir) * INW);
  for (int st_ = 0; st_ < SEQ / 256; ++st_) {
    const int sg0 = st_ * 256 + wid * 32;
    const bf16x8 ua = uan;
    { const int sgn = (st_ + 1 < SEQ / 256) ? sg0 + 256 : sg0; uan = *reinterpret_cast<const bf16x8*>(ubase + (size_t)smap(sgn + r, dir) * INW); }
    f32x16 z16 = {};
    f32x16 sre[2], sim[2];
    sre[0] = MFMA32(ua, bb[0], z16); sre[1] = MFMA32(ua, bb[1], z16); sim[0] = MFMA32(ua, bb[2], z16); sim[1] = MFMA32(ua, bb[3], z16);
    float cinr[2][4], cini[2][4];
#pragma unroll
    for (int st = 0; st < 2; ++st) {
      const float a_r = ar[st][0], a_i = ai[st][0];
      float Er[4], Ei[4];
#pragma unroll
      for (int g4 = 0; g4 < 4; ++g4) {
#pragma unroll
        for (int j = 1; j < 4; ++j) {
          const float pr = sre[st][4 * g4 + j - 1], pi = sim[st][4 * g4 + j - 1];
          sre[st][4 * g4 + j] += a_r * pr - a_i * pi;
          sim[st][4 * g4 + j] += a_r * pi + a_i * pr;
        }
        Er[g4] = sre[st][4 * g4 + 3]; Ei[g4] = sim[st][4 * g4 + 3];
      }
      float c_r = 0.f, c_i = 0.f;
      const float a4r = ar[st][3], a4i = ai[st][3];
#pragma unroll
      for (int g4 = 0; g4 < 4; ++g4) {
        const float oEr = __shfl_xor(Er[g4], 32), oEi = __shfl_xor(Ei[g4], 32);
        const float E0r = h ? oEr : Er[g4], E0i = h ? oEi : Ei[g4], E1r = h ? Er[g4] : oEr, E1i = h ? Ei[g4] : oEi;
        const float c0r = c_r, c0i = c_i;
        float nr = a4r * c_r - a4i * c_i + E0r, ni = a4r * c_i + a4i * c_r + E0i; c_r = nr; c_i = ni;
        const float c1r = c_r, c1i = c_i;
        nr = a4r * c_r - a4i * c_i + E1r; ni = a4r * c_i + a4i * c_r + E1i; c_r = nr; c_i = ni;
        cinr[st][g4] = h ? c1r : c0r; cini[st][g4] = h ? c1i : c0i;
      }
      if (h == 0) { exch[(wid * 32 + r) * 4 + st * 2] = c_r; exch[(wid * 32 + r) * 4 + st * 2 + 1] = c_i; }
    }
    __syncthreads();
#pragma unroll
    for (int st = 0; st < 2; ++st) {
      float tr = scr[st], ti = sci[st], mr = tr, mi = ti;
#pragma unroll
      for (int j = 0; j < 8; ++j) {
        const float er = exch[(j * 32 + r) * 4 + st * 2], ei = exch[(j * 32 + r) * 4 + st * 2 + 1];
        if (j == wid) { mr = tr; mi = ti; }
        const float nr = a32r[st] * tr - a32i[st] * ti + er, ni = a32r[st] * ti + a32i[st] * tr + ei; tr = nr; ti = ni;
      }
      scr[st] = tr; sci[st] = ti;
      float qr = h ? (ar[st][3] * mr - ai[st][3] * mi) : mr, qi = h ? (ar[st][3] * mi + ai[st][3] * mr) : mi;
#pragma unroll
      for (int g4 = 0; g4 < 4; ++g4) {
        const float cr_ = cinr[st][g4] + qr, ci_ = cini[st][g4] + qi;
        { const float nq = a8r_[st] * qr - a8i_[st] * qi; qi = a8r_[st] * qi + a8i_[st] * qr; qr = nq; }
#pragma unroll
        for (int j = 0; j < 4; ++j) {
          const int i = 4 * g4 + j;
          const float vr = sre[st][i] + ar[st][j] * cr_ - ai[st][j] * ci_;
          const float vi = sim[st][i] + ar[st][j] * ci_ + ai[st][j] * cr_;
          const int m = crow(i, h);
          const unsigned w = cvtpk(vr, vi);
          Sl[m * 136 + st * 32 + r] = (u16)(w & 0xffffu);
          Sl[m * 136 + 64 + st * 32 + r] = (u16)(w >> 16);
        }
      }
    }
    WAVE_SYNC();
#pragma unroll
    for (int mt = 0; mt < 2; ++mt) {
      f32x4 y = {};
#pragma unroll
      for (int s = 0; s < 4; ++s) {
        const bf16x8 a = *reinterpret_cast<const bf16x8*>(Sl + (mt * 16 + c16) * 136 + 32 * s + 8 * kq);
        y = __builtin_amdgcn_mfma_f32_16x16x32_bf16(a, cf[s], y, 0, 0, 0);
      }
#pragma unroll
      for (int j = 0; j < 4; ++j) { const int s = smap(sg0 + mt * 16 + kq * 4 + j, dir); yout[(size_t)s * 256] = f2bf(y[j]); }
    }
    __syncthreads();
  }
}

DI void phase_mix(const int tix, const Params& p, int l, char* smem, int* s_item, int cbase = 0) {
  const int tid = tix, wid = __builtin_amdgcn_readfirstlane(tid >> 6);
#define NEXT_ITEM(cidx) if (tid == 0) *s_item = atomicAdd(&p.counters[l * 8 + cbase + (cidx)], 1); __syncthreads(); const int item = *s_item; __syncthreads();
  const int n_att = 1024 + (l == 0 ? 64 : 0);
  for (int rep = 0; rep < ((PROBE_DUP & 4) ? 2 : 1); ++rep)
  for (;;) {
    NEXT_ITEM(2 + 3 * rep); if (item >= n_att) break;
    int b, hm, q0, seq;
    if (item < 1024) { const int qb = item & 15; hm = (item >> 4) & 7; b = item >> 7; q0 = TC + qb * 256; seq = SEQ; }
    else { const int a = item - 1024; hm = a & 7; b = a >> 3; q0 = 0; seq = TC; }
    const u16* base = p.pbuf + (size_t)b * SEQ * INW;
    at::attn_body(tix, base + (size_t)q0 * INW + C_Q + hm * 64, base + C_K + hm * 64, base + C_V + (hm >> 1) * 128,
                  p.obuf + ((size_t)b * SEQ + q0) * 1024 + hm * 128, seq, smem);
  }
  for (int rep = 0; rep < ((PROBE_DUP & 1) ? 2 : 1); ++rep)
  for (;;) { NEXT_ITEM(0 + 3 * rep); if (item >= 128) break; lru_wg_item(tix, p, l, item, smem); }
  for (int rep = 0; rep < ((PROBE_DUP & 2) ? 2 : 1); ++rep)
  for (;;) { NEXT_ITEM(1 + 3 * rep); if (item >= 256) break; s5_wg_item(tix, p, l, item, smem); }
#undef NEXT_ITEM
}

DI void unpack8(const bf16x8 v, float* f) {
#pragma unroll
  for (int k = 0; k < 8; ++k) f[k] = bf2f((u16)v[k]);
}
DI bf16x8 pack8(const float* f) {
  u32x4 w = {cvtpk(f[0], f[1]), cvtpk(f[2], f[3]), cvtpk(f[4], f[5]), cvtpk(f[6], f[7])};
  return *reinterpret_cast<bf16x8*>(&w);
}
DI void phase_combine(const int tix, const Params& p, int l, char* smem) {
  const int tid = tix, wid = tid >> 6, lane = tid & 63, r = lane & 31, h = lane >> 5;
  float* zf = (float*)smem;
  u16* zb = (u16*)(smem + 32 * 260 * 4);
  const float lam = p.lamv[l], onem = 1.f - p.lamv[2 + l];
  bf16x8 wg[16];
  { const u16* wt = p.wgluT + (size_t)l * 65536 + (size_t)(wid * 32 + r) * 256 + 8 * h;
#pragma unroll
    for (int s = 0; s < 16; ++s) wg[s] = *reinterpret_cast<const bf16x8*>(wt + 16 * s); }
  const float bglu = p.s5_b_glu[l * 256 + wid * 32 + r];
  const size_t DSTRIDE = (size_t)ROWS * 256;
  for (int item = blockIdx.x; item < ROWS / 32; item += gridDim.x) {
    const int row0 = item * 32;
    if (l == 1 && (row0 % SEQ) < TC) continue;
#pragma unroll
    for (int i = 0; i < 2; ++i) {
      const int id = tid + NTHR * i, rr = id >> 5, c8 = (id & 31) * 8; const size_t row = row0 + rr;
      const u16* pr = p.pbuf + row * INW;
      float h0[8], h1[8], y0[8], y1[8], ga[8], us[8], o[8], z[8];
      unpack8(*reinterpret_cast<const bf16x8*>(p.hl + row * 256 + c8), h0);
      unpack8(*reinterpret_cast<const bf16x8*>(p.hl + DSTRIDE + row * 256 + c8), h1);
      unpack8(*reinterpret_cast<const bf16x8*>(p.ys + row * 256 + c8), y0);
      unpack8(*reinterpret_cast<const bf16x8*>(p.ys + DSTRIDE + row * 256 + c8), y1);
      unpack8(*reinterpret_cast<const bf16x8*>(pr + C_GA + c8), ga);
      unpack8(*reinterpret_cast<const bf16x8*>(pr + C_US + c8), us);
      const f32x4 d0 = *reinterpret_cast<const f32x4*>(p.s5_d + l * 256 + c8), d1 = *reinterpret_cast<const f32x4*>(p.s5_d + l * 256 + c8 + 4);
#pragma unroll
      for (int k = 0; k < 8; ++k) {
        o[k] = (h0[k] + h1[k]) * silu_f(ga[k]);
        z[k] = gelu_tanh((k < 4 ? d0[k] : d1[k - 4]) * us[k] + y0[k] + y1[k]);
      }
      *reinterpret_cast<bf16x8*>(p.nbuf + row * 1024 + c8) = pack8(o);
      *reinterpret_cast<f32x4*>(zf + rr * 260 + c8) = f32x4{z[0], z[1], z[2], z[3]};
      *reinterpret_cast<f32x4*>(zf + rr * 260 + c8 + 4) = f32x4{z[4], z[5], z[6], z[7]};
      *reinterpret_cast<bf16x8*>(zb + rr * 264 + c8) = pack8(z);
    }
    __syncthreads();
    f32x16 acc = {};
#pragma unroll
    for (int s = 0; s < 16; ++s) {
      const bf16x8 a = *reinterpret_cast<const bf16x8*>(zb + r * 264 + 16 * s + 8 * h);
      acc = MFMA32(a, wg[s], acc);
    }
#pragma unroll
    for (int i = 0; i < 16; ++i) {
      const int m = crow(i, h), col = wid * 32 + r;
      const float zz = zf[m * 260 + col];
      zf[m * 260 + col] = zz * sigmoid_f(acc[i] + bglu);
    }
    __syncthreads();
#pragma unroll
    for (int i = 0; i < 2; ++i) {
      const int id = tid + NTHR * i, rr = id >> 5, c8 = (id & 31) * 8; const size_t row = row0 + rr;
      float gs[8], o[8];
      unpack8(*reinterpret_cast<const bf16x8*>(p.pbuf + row * INW + C_GS + c8), gs);
      const f32x4 g0 = *reinterpret_cast<const f32x4*>(zf + rr * 260 + c8), g1 = *reinterpret_cast<const f32x4*>(zf + rr * 260 + c8 + 4);
#pragma unroll
      for (int k = 0; k < 8; ++k) o[k] = (k < 4 ? g0[k] : g1[k - 4]) * silu_f(gs[k]);
      *reinterpret_cast<bf16x8*>(p.nbuf + row * 1024 + 256 + c8) = pack8(o);
    }
#pragma unroll
    for (int it = 0; it < 4; ++it) {
      const int pair = (tid >> 4) + 32 * it, rr = pair >> 2, head = pair & 3, e8 = (tid & 15) * 8; const size_t row = row0 + rr;
      float o1[8], o2[8], gd[8], v[8], o[8];
      unpack8(*reinterpret_cast<const bf16x8*>(p.obuf + row * 1024 + head * 256 + e8), o1);
      unpack8(*reinterpret_cast<const bf16x8*>(p.obuf + row * 1024 + head * 256 + 128 + e8), o2);
      unpack8(*reinterpret_cast<const bf16x8*>(p.pbuf + row * INW + C_GD + head * 128 + e8), gd);
      const f32x4 n0 = *reinterpret_cast<const f32x4*>(p.da_norm_g + l * 128 + e8), n1 = *reinterpret_cast<const f32x4*>(p.da_norm_g + l * 128 + e8 + 4);
      float ss = 0.f;
#pragma unroll
      for (int k = 0; k < 8; ++k) { v[k] = o1[k] - lam * o2[k]; ss += v[k] * v[k]; }
      ss += __shfl_xor(ss, 1); ss += __shfl_xor(ss, 2); ss += __shfl_xor(ss, 4); ss += __shfl_xor(ss, 8);
      const float rinv = rsqrtf(ss * (1.f / 128.f) + EPS) * onem;
#pragma unroll
      for (int k = 0; k < 8; ++k) o[k] = v[k] * rinv * (k < 4 ? n0[k] : n1[k - 4]) * silu_f(gd[k]);
      *reinterpret_cast<bf16x8*>(p.nbuf + row * 1024 + 512 + head * 128 + e8) = pack8(o);
    }
    __syncthreads();
  }
}

DI void phase_final(const int tix, const Params& p) {
  const int wid = tix >> 6, lane = tix & 63;
  for (int row = blockIdx.x * 8 + wid; row < NB * TL; row += gridDim.x * 8) {
    float* src = p.out + (size_t)row * 1024;
    f32x4 v[4]; float ss = 0.f;
#pragma unroll
    for (int i = 0; i < 4; ++i) { v[i] = *(const f32x4*)(src + i * 256 + lane * 4); ss += v[i][0] * v[i][0] + v[i][1] * v[i][1] + v[i][2] * v[i][2] + v[i][3] * v[i][3]; }
    ss = wave_sum(ss);
    const float r = rsqrtf(ss * (1.f / 1024.f) + EPS);
#pragma unroll
    for (int i = 0; i < 4; ++i) {
      f32x4 gg = *(const f32x4*)(p.final_g + i * 256 + lane * 4);
      f32x4 o = {v[i][0] * r * gg[0], v[i][1] * r * gg[1], v[i][2] * r * gg[2], v[i][3] * r * gg[3]};
      *(f32x4*)(src + i * 256 + lane * 4) = o;
    }
  }
}


#define XB_TMO      128
#define XB_XCNT(j)  (256  + 64 * (j))
#define XB_XSUB(j)  (1280 + 64 * (j))
#define XB_XGEN(j)  (2304 + 64 * (j))
#define XB_TOP      3328
#define XB_TOPGEN   3392
#define XCD_BAR_WORDS 3456
#define XB_SPIN_CAP (1u << 18)
#define LAS __attribute__((address_space(3)))
DI unsigned xb_ld(unsigned* p)              { return __hip_atomic_load(p, __ATOMIC_RELAXED, __HIP_MEMORY_SCOPE_AGENT); }
DI unsigned xb_add(unsigned* p, unsigned v) { return __hip_atomic_fetch_add(p, v, __ATOMIC_RELAXED, __HIP_MEMORY_SCOPE_AGENT); }
DI unsigned xb_xcc_id() { return (unsigned)__builtin_amdgcn_s_getreg((3 << 11) | 20) & 0xFu; }
#define XB_SPIN(cond, bar) do { unsigned _sp = 0; while (cond) { __builtin_amdgcn_s_sleep(1); \
    if ((++_sp & 255u) == 0u) { if (xb_ld(&(bar)[XB_TMO])) break; if (_sp > XB_SPIN_CAP) { atomicAdd(&(bar)[XB_TMO], 1u); break; } } } } while (0)
struct XcdBarrier { unsigned* bar; unsigned x; volatile LAS unsigned* st; };
DI XcdBarrier xcd_barrier_post(int tid, unsigned* bar, volatile LAS unsigned* st) {
  XcdBarrier b; b.bar = bar; b.x = xb_xcc_id(); b.st = st;
  if (tid == 0) (void)xb_add(&bar[XB_XCNT(b.x)], 1u);
  return b;
}
DI void xcd_barrier_complete(unsigned* bar, unsigned x, unsigned& nloc, unsigned& nx) {
  const unsigned G = gridDim.x;
  unsigned sum, cnt, mine, sp = 0u;
  for (;;) {
    sum = 0u; cnt = 0u; mine = 0u;
#pragma unroll
    for (unsigned j = 0; j < 16; ++j) { const unsigned c = xb_ld(&bar[XB_XCNT(j)]); sum += c; cnt += (c > 0u) ? 1u : 0u; mine = (j == x) ? c : mine; }
    if (sum == G) break;
    __builtin_amdgcn_s_sleep(1);
    if ((++sp & 255u) == 0u) { if (xb_ld(&bar[XB_TMO])) break; if (sp > XB_SPIN_CAP) { atomicAdd(&bar[XB_TMO], 1u); break; } }
  }
  nloc = mine > 0u ? mine : 1u; nx = cnt > 0u ? cnt : 1u;
}
DI void xcd_barrier(int tid, const XcdBarrier& b) {
  asm volatile("s_waitcnt vmcnt(0)" ::: "memory");
  __syncthreads();
  if (tid == 0) {
    unsigned* bar = b.bar;
    __builtin_amdgcn_s_waitcnt(0);
    unsigned nloc = b.st[0], nx = b.st[1];
    if (nloc == 0u) { xcd_barrier_complete(bar, b.x, nloc, nx); b.st[0] = nloc; b.st[1] = nx; }
    const unsigned old = xb_add(&bar[XB_XSUB(b.x)], 1u);
    const unsigned gen = old / nloc;
    if (old + 1u == (gen + 1u) * nloc) {
      __builtin_amdgcn_fence(__ATOMIC_RELEASE, "agent");
      asm volatile("s_waitcnt vmcnt(0)" ::: "memory");
      const unsigned og = xb_add(&bar[XB_TOP], 1u);
      const unsigned tg = og / nx;
      if (og + 1u == (tg + 1u) * nx) xb_add(&bar[XB_TOPGEN], 1u);
      else XB_SPIN(xb_ld(&bar[XB_TOPGEN]) == tg, bar);
      __builtin_amdgcn_fence(__ATOMIC_ACQUIRE, "agent");
      xb_add(&bar[XB_XGEN(b.x)], 1u);
      asm volatile("s_waitcnt vmcnt(0)" ::: "memory");
    } else {
      XB_SPIN(xb_ld(&bar[XB_XGEN(b.x)]) == gen, bar);
      __builtin_amdgcn_fence(__ATOMIC_ACQUIRE, "agent");
      asm volatile("s_waitcnt vmcnt(0)" ::: "memory");
    }
  }
  __syncthreads();
}

#if MULTI
template <int K> __global__ void __launch_bounds__(NTHR) phase_kernel(Params p, int ph) {
  extern __shared__ __attribute__((aligned(16))) char smem[];
  __shared__ int s_item;
  const int wid_s = __builtin_amdgcn_readfirstlane((int)__builtin_amdgcn_workitem_id_x() >> 6);
  const int l = (ph - 1) / 5;
  if (K == 0) phase_prep(tid_opaque(wid_s), p, smem);
  else if (K == 6) phase_final(tid_opaque(wid_s), p);
  else if (K == 1) phase_norm(tid_opaque(wid_s), p, l);
  else if (K == 2) gm::gemm_phase<0>(tid_opaque(wid_s), p, l, p.nbuf, p.winT + (size_t)l * 3072 * 1024, 12, smem);
  else if (K == 3) phase_mix(tid_opaque(wid_s), p, l, smem, &s_item);
  else if (K == 4) phase_combine(tid_opaque(wid_s), p, l, smem);
  else gm::gemm_phase<1>(tid_opaque(wid_s), p, l, p.nbuf, p.woutT + (size_t)l * 1024 * 1024, 4, smem);
}
template <int K> static void launch_phase(const Params& p, int ph, hipStream_t stream) {
  (void)hipFuncSetAttribute((const void*)phase_kernel<K>, hipFuncAttributeMaxDynamicSharedMemorySize, LDS_BYTES);
  hipLaunchKernelGGL(phase_kernel<K>, dim3(256), dim3(NTHR), LDS_BYTES, stream, p, ph);
}
#else
__global__ void __launch_bounds__(NTHR) mega_kernel(Params p) {
  extern __shared__ __attribute__((aligned(16))) char smem[];
  __shared__ uint4 sh_words;
  int* s_item = (int*)&sh_words;
  const int wid_s = __builtin_amdgcn_readfirstlane((int)__builtin_amdgcn_workitem_id_x() >> 6);
  cg::grid_group grid = cg::this_grid();
  if (tid_opaque(wid_s) == 0) sh_words = make_uint4(0u, 0u, 0u, 0u);
  __syncthreads();
  XcdBarrier xb = xcd_barrier_post(tid_opaque(wid_s), p.xbar, (volatile LAS unsigned*)((unsigned*)&sh_words + 2));
#define GSYNC() xcd_barrier(tid_opaque(wid_s), xb)
  for (int rep = 0; rep < ((PROBE_DUP & 64) ? 2 : 1); ++rep) { phase_prep(tid_opaque(wid_s), p, smem); grid.sync(); }
  for (int l = 0; l < 2; ++l) {
    for (int rep = 0; rep < ((PROBE_DUP & 8) ? 2 : 1); ++rep) { phase_norm(tid_opaque(wid_s), p, l); GSYNC(); }
    for (int rep = 0; rep < ((PROBE_DUP & 16) ? 2 : 1); ++rep) { pg::gemm_stream(tid_opaque(wid_s), (PG_LAS unsigned char*)smem, p.nbuf, p.winT + (size_t)l * 3072 * 1024, pg::Sched{l == 0 ? 0 : 2, 12, (int)gridDim.x, (int)blockIdx.x}, pg::EpiIn{p, l}); GSYNC(); }
    for (int rep = 0; rep < ((PROBE_DUP & 128) ? 2 : 1); ++rep) { phase_mix(tid_opaque(wid_s), p, l, smem, s_item, rep * 3); GSYNC(); }
    for (int rep = 0; rep < ((PROBE_DUP & 32) ? 2 : 1); ++rep) { phase_combine(tid_opaque(wid_s), p, l, smem); GSYNC(); }
    for (int rep = 0; rep < (((PROBE_DUP & 256) && l == 0) ? 2 : 1); ++rep) { pg::gemm_stream(tid_opaque(wid_s), (PG_LAS unsigned char*)smem, p.nbuf, p.woutT + (size_t)l * 1024 * 1024, pg::Sched{l == 0 ? 0 : 1, 4, (int)gridDim.x, (int)blockIdx.x}, pg::EpiOut{p, l}); GSYNC(); }
  }
  phase_final(tid_opaque(wid_s), p);
#undef GSYNC
}
#endif

extern "C" void kernel_launch(void* const* d_in, const int* in_sizes, int n_in, void* d_out, int out_size, void* d_ws, size_t ws_size, hipStream_t stream) {
  Params p{};
  const float** pf = (const float**)&p;
  for (int i = 0; i < 29; ++i) pf[i] = (const float*)d_in[i];
  p.out = (float*)d_out;
  char* w = (char*)d_ws; size_t off = 0;
  auto take = [&](size_t bytes) { char* r = w + off; off += (bytes + 255) & ~(size_t)255; return r; };
  p.nbuf = (u16*)take((size_t)ROWS * 1024 * 2);
  p.pbuf = (u16*)take((size_t)ROWS * INW * 2);
  p.hl = (u16*)take((size_t)2 * ROWS * 256 * 2);
  p.ys = (u16*)take((size_t)2 * ROWS * 256 * 2);
  p.obuf = (u16*)take((size_t)ROWS * 1024 * 2);
  p.winT = (u16*)take((size_t)2 * 3072 * 1024 * 2);
  p.woutT = (u16*)take((size_t)2 * 1024 * 1024 * 2);
  p.wgluT = (u16*)take((size_t)2 * 65536 * 2);
  p.bbT = (u16*)take((size_t)64 * 2 * 64 * 16 * 2);
  p.cc = (u16*)take((size_t)131072 * 2);
  p.lruWT = (u16*)take((size_t)32 * 4096 * 2);
  p.hc = (float*)take((size_t)NB * TC * 1024 * 4);
  p.mod = (float*)take((size_t)2 * 9 * 3072 * 4);
  p.sa = (float*)take((size_t)4096 * 2 * 4);
  p.rope = (float*)take((size_t)2048 * 4);
  p.lamv = (float*)take(256);
  p.counters = (int*)take(256);
  p.xbar = (unsigned*)take((size_t)XCD_BAR_WORDS * 4);
  if (off > ws_size) { fprintf(stderr, "kernel_launch: workspace too small: need %zu have %zu\n", off, ws_size); return; }
#if MULTI
  launch_phase<0>(p, 0, stream);
  for (int l = 0; l < 2; ++l) {
    launch_phase<1>(p, 1 + 5 * l, stream); launch_phase<2>(p, 2 + 5 * l, stream); launch_phase<3>(p, 3 + 5 * l, stream);
    launch_phase<4>(p, 4 + 5 * l, stream); launch_phase<5>(p, 5 + 5 * l, stream);
  }
  launch_phase<6>(p, 11, stream);
#else
  static int grid_blocks = 0;
  if (!grid_blocks) {
    int dev = 0, cus = 0, per_cu = 0;
    hipGetDevice(&dev);
    hipDeviceGetAttribute(&cus, hipDeviceAttributeMultiprocessorCount, dev);
    hipFuncSetAttribute((const void*)mega_kernel, hipFuncAttributeMaxDynamicSharedMemorySize, LDS_BYTES);
    hipOccupancyMaxActiveBlocksPerMultiprocessor(&per_cu, (const void*)mega_kernel, NTHR, LDS_BYTES);
    if (per_cu < 1) per_cu = 1;
    grid_blocks = cus * per_cu;
  }
  (void)hipMemsetAsync(p.xbar, 0, (size_t)XCD_BAR_WORDS * 4, stream);
  void* args[] = {&p};
  hipError_t e = hipLaunchCooperativeKernel((const void*)mega_kernel, dim3(grid_blocks), dim3(NTHR), args, LDS_BYTES, stream);
  if (e != hipSuccess) fprintf(stderr, "cooperative launch failed: %s (grid %d)\n", hipGetErrorString(e), grid_blocks);
#endif
}
```

```cpp
#include <hip/hip_runtime.h>
#include <hip/hip_bf16.h>
#include <hip/hip_cooperative_groups.h>
#include <cstdio>
#include <cstdint>
namespace cg = cooperative_groups;

#ifndef MULTI
#define MULTI 0
#endif
#ifndef PROBE_DUP
#define PROBE_DUP 0
#endif
#ifndef STAGGER_US
#define STAGGER_US 0
#endif

#define DI __device__ __forceinline__
typedef unsigned short u16;
using bf16x8 = __attribute__((ext_vector_type(8))) short;
using s16x4  = __attribute__((ext_vector_type(4))) short;
using f32x4  = __attribute__((ext_vector_type(4))) float;
using f32x16 = __attribute__((ext_vector_type(16))) float;
using u32x4  = __attribute__((ext_vector_type(4))) unsigned;

constexpr int NB = 8, TL = 4096, DM = 1024, TC = 256, SEQ = TC + TL, ROWS = NB * SEQ;
constexpr int INW = 3072;
constexpr int C_UA = 0, C_US = 256, C_K = 512, C_V = 1024, C_GA = 1536, C_GS = 1792, C_Q = 2048, C_GD = 2560;
constexpr int NTHR = 512;
constexpr int LDS_BYTES = 131072;
constexpr float EPS = 1e-6f;

struct Params {
  const float *x, *c, *ctx, *c_ctx, *norm_g, *w_mod, *b_mod, *w_in, *w_out, *conv_w, *conv_b, *lru_wa, *lru_ba, *lru_wx, *lru_bx, *lru_lam,
      *s5_lam_re, *s5_lam_im, *s5_log_dt, *s5_b_re, *s5_b_im, *s5_c_re, *s5_c_im, *s5_d, *s5_w_glu, *s5_b_glu, *da_lam, *da_norm_g, *final_g;
  float* out;
  u16 *nbuf, *pbuf, *hl, *ys, *obuf, *winT, *woutT, *wgluT, *bbT, *cc, *lruWT;
  float *hc, *mod, *sa, *rope, *lamv;
  int* counters;
  unsigned* xbar;
};

DI float bf2f(u16 u) { return __uint_as_float(((unsigned)u) << 16); }
DI u16 f2bf(float x) { unsigned u = __float_as_uint(x); u += 0x7fffu + ((u >> 16) & 1u); return (u16)(u >> 16); }
DI float sigmoid_f(float v) { return 1.f / (1.f + __expf(-v)); }
DI float silu_f(float v) { return v / (1.f + __expf(-v)); }
DI float gelu_tanh(float y) { float u = 0.7978845608028654f * (y + 0.044715f * y * y * y); float t = 1.f - 2.f / (__expf(2.f * u) + 1.f); return 0.5f * y * (1.f + t); }
DI int crow(int r, int hi) { return (r & 3) + 8 * (r >> 2) + 4 * hi; }
DI unsigned cvtpk(float lo, float hi) { unsigned r; asm volatile("v_cvt_pk_bf16_f32 %0, %1, %2" : "=v"(r) : "v"(lo), "v"(hi)); return r; }
DI float wave_sum(float v) { for (int o = 32; o > 0; o >>= 1) v += __shfl_xor(v, o); return v; }
DI int tid_opaque(int wid_s) { int t; asm volatile("v_mbcnt_lo_u32_b32 %0, -1, 0\n\tv_mbcnt_hi_u32_b32 %0, -1, %0" : "=v"(t)); return (wid_s << 6) + t; }
#define MFMA32(a, b, c) __builtin_amdgcn_mfma_f32_32x32x16_bf16((a), (b), (c), 0, 0, 0)

DI void transpose_job(const int tix, const float* __restrict__ src, u16* __restrict__ dst, int K, int N, int kt, int nt, float* lds) {
  const int tid = tix, c = tid & 63, r0 = tid >> 6;
  for (int i = 0; i < 8; ++i) { int r = r0 + 8 * i; lds[r * 65 + c] = src[(size_t)(kt * 64 + r) * N + nt * 64 + c]; }
  __syncthreads();
  for (int i = 0; i < 8; ++i) { int r = r0 + 8 * i; dst[(size_t)(nt * 64 + r) * K + kt * 64 + c] = f2bf(lds[c * 65 + r]); }
  __syncthreads();
}

DI void mod_job(const int tix, const Params& p, int job, float* lds) {
  const int tid = tix;
  const int l = job / 96, cb = (job % 96) * 32;
  for (int i = tid; i < 9 * 1024; i += NTHR) { float v = i < 8192 ? p.c[i] : p.c_ctx[i - 8192]; lds[i] = silu_f(v); }
  __syncthreads();
  const int col = tid & 31, kg = tid >> 5;
  float acc[9];
#pragma unroll
  for (int r = 0; r < 9; ++r) acc[r] = 0.f;
#pragma unroll 16
  for (int k = kg * 64; k < kg * 64 + 64; ++k) {
    float w = p.w_mod[((size_t)l * 1024 + k) * 3072 + cb + col];
#pragma unroll
    for (int r = 0; r < 9; ++r) acc[r] += lds[r * 1024 + k] * w;
  }
  float* red = lds + 9 * 1024;
#pragma unroll
  for (int r = 0; r < 9; ++r) red[(kg * 9 + r) * 32 + col] = acc[r];
  __syncthreads();
  if (tid < 288) {
    int r = tid >> 5, c2 = tid & 31; float s = p.b_mod[l * 3072 + cb + c2];
    for (int g = 0; g < 16; ++g) s += red[(g * 9 + r) * 32 + c2];
    p.mod[(l * 9 + r) * 3072 + cb + c2] = s;
  }
  __syncthreads();
}

DI void phase_prep(const int tix, const Params& p, char* smem, int part) {
  float* lds = (float*)smem;
  constexpr int J_WIN = 2 * 16 * 48, J_WOUT = 2 * 16 * 16, J_GLU = 2 * 4 * 4, J_LRU = 32, J_MOD = 192;
  constexpr int JT = J_WIN + J_WOUT + J_GLU + J_LRU + J_MOD;
  const int jlo = part == 0 ? JT - J_MOD : 0, jhi = part == 0 ? JT : JT - J_MOD;
  for (int job = jlo + blockIdx.x; job < jhi; job += gridDim.x) {
    int j = job;
    if (j < J_WIN) { int l = j / 768, r = j % 768; transpose_job(tix, p.w_in + (size_t)l * 1024 * 3072, p.winT + (size_t)l * 3072 * 1024, 1024, 3072, r / 48, r % 48, lds); continue; }
    j -= J_WIN;
    if (j < J_WOUT) { int l = j / 256, r = j % 256; transpose_job(tix, p.w_out + (size_t)l * 1024 * 1024, p.woutT + (size_t)l * 1024 * 1024, 1024, 1024, r / 16, r % 16, lds); continue; }
    j -= J_WOUT;
    if (j < J_GLU) { int l = j / 16, r = j % 16; transpose_job(tix, p.s5_w_glu + (size_t)l * 65536, p.wgluT + (size_t)l * 65536, 256, 256, r / 4, r % 4, lds); continue; }
    j -= J_GLU;
    if (j < J_LRU) { int m = j >> 1, gate = j & 1;
      transpose_job(tix, (gate ? p.lru_wx : p.lru_wa) + (size_t)m * 4096, p.lruWT + (size_t)(m * 2 + gate) * 4096, 64, 64, 0, 0, lds); continue; }
    j -= J_LRU;
    mod_job(tix, p, j, lds);
  }
  if (part != 0) return;
  const int gtid = blockIdx.x * NTHR + tix, gsz = gridDim.x * NTHR;
  constexpr int N_S5 = 4096, N_CC = 131072, N_ROPE = 1024;
  for (int i = gtid; i < N_S5 + N_CC + N_ROPE + 4; i += gsz) {
    if (i < N_S5) {
      const int idx = i, ldg = idx >> 6, pp = idx & 63;
      float lr = p.s5_lam_re[idx], li = p.s5_lam_im[idx], dt = expf(p.s5_log_dt[ldg]);
      float mag = expf(lr * dt), ang = li * dt, sn = sinf(ang), cs = cosf(ang);
      float abr = mag * cs, abi = mag * sn, nr = abr - 1.f, ni = abi, den = lr * lr + li * li;
      float cfr = (nr * lr + ni * li) / den, cfi = (ni * lr - nr * li) / den;
      p.sa[idx * 2] = abr; p.sa[idx * 2 + 1] = abi;
      for (int h = 0; h < 16; ++h) {
        float br = p.s5_b_re[idx * 16 + h], bi = p.s5_b_im[idx * 16 + h];
        p.bbT[((size_t)(ldg * 2 + 0) * 64 + pp) * 16 + h] = f2bf(cfr * br - cfi * bi);
        p.bbT[((size_t)(ldg * 2 + 1) * 64 + pp) * 16 + h] = f2bf(cfr * bi + cfi * br);
      }
    } else if (i < N_S5 + N_CC) {
      const int e = i - N_S5, k = e & 127, lc = e >> 7;
      float v = k < 64 ? p.s5_c_re[lc * 64 + k] : -p.s5_c_im[lc * 64 + (k - 64)];
      p.cc[e] = f2bf(v);
    } else if (i < N_S5 + N_CC + N_ROPE) {
      const int e = i - N_S5 - N_CC, pos = e >> 4, f = e & 15;
      float inv = expf(-9.210340371976184f * (float)f / 16.f), ang = (float)pos * inv;
      p.rope[e] = cosf(ang); p.rope[1024 + e] = sinf(ang);
    } else {
      const int e = i - N_S5 - N_CC - N_ROPE;
      if (e < 2) {
        const int l = e; const float* dl = p.da_lam + l * 256;
        float s0 = 0.f, s1 = 0.f;
        for (int k = 0; k < 64; ++k) { s0 += dl[k] * dl[64 + k]; s1 += dl[128 + k] * dl[192 + k]; }
        float lam_init = 0.8f - 0.6f * expf(-0.3f * (float)l);
        p.lamv[l] = expf(s0) - expf(s1) + lam_init; p.lamv[2 + l] = lam_init;
      } else { for (int k = 0; k < 16; ++k) p.counters[(e - 2) * 16 + k] = 0; }
    }
  }
}

DI void phase_norm(const int tix, const Params& p, int l) {
  const int wid = tix >> 6, lane = tix & 63;
  const float* g = p.norm_g + l * 1024;
  for (int row = blockIdx.x * 8 + wid; row < ROWS; row += gridDim.x * 8) {
    const int b = row / SEQ, s = row % SEQ;
    const float* src; int mrow;
    if (s < TC) { src = (l == 0 ? p.ctx : p.hc) + ((size_t)b * TC + s) * 1024; mrow = 8; }
    else { src = (l == 0 ? p.x : p.out) + ((size_t)b * TL + (s - TC)) * 1024; mrow = b; }
    const float* md = p.mod + (l * 9 + mrow) * 3072;
    f32x4 v[4], gg[4], sh[4], sc[4]; float ss = 0.f;
#pragma unroll
    for (int i = 0; i < 4; ++i) { const int c0 = i * 256 + lane * 4; v[i] = *(const f32x4*)(src + c0); gg[i] = *(const f32x4*)(g + c0); sh[i] = *(const f32x4*)(md + c0); sc[i] = *(const f32x4*)(md + 1024 + c0); }
#pragma unroll
    for (int i = 0; i < 4; ++i) ss += v[i][0] * v[i][0] + v[i][1] * v[i][1] + v[i][2] * v[i][2] + v[i][3] * v[i][3];
    ss = wave_sum(ss);
    const float r = rsqrtf(ss * (1.f / 1024.f) + EPS);
#pragma unroll
    for (int i = 0; i < 4; ++i) {
      const int c0 = i * 256 + lane * 4;
      float o0 = v[i][0] * r * gg[i][0] * (1.f + sc[i][0]) + sh[i][0], o1 = v[i][1] * r * gg[i][1] * (1.f + sc[i][1]) + sh[i][1];
      float o2 = v[i][2] * r * gg[i][2] * (1.f + sc[i][2]) + sh[i][2], o3 = v[i][3] * r * gg[i][3] * (1.f + sc[i][3]) + sh[i][3];
      uint2 w; w.x = cvtpk(o0, o1); w.y = cvtpk(o2, o3);
      *(uint2*)(p.nbuf + (size_t)row * 1024 + c0) = w;
    }
  }
}

namespace gm {
constexpr int BM = 256, BK = 64, HALF = 128, NXCD = 8, WGM = 8, HT = HALF * BK, KD = 1024;
DI int lds_byte(int r, int c) { int st = (r >> 4) * 2 + (c >> 5), rr = r & 15, cc = c & 31, ob = rr * 64 + cc * 2; return st * 1024 + (ob ^ (((ob >> 9) & 1) << 5)); }
DI void stage_rc(int b, int& R, int& C) { int st = b / 1024, sb = b % 1024, swz = sb ^ (((sb >> 9) & 1) << 5); R = (st >> 1) * 16 + swz / 64; C = (st & 1) * 32 + (swz % 64) / 2; }

template <int MODE>
DI void gemm_tile(const int tix, const Params& p, int l, const u16* __restrict__ A, const u16* __restrict__ Bt, int brow, int bcol, u16* shm) {
  constexpr int K = KD;
#define SA(b, h) (shm + ((b) * 2 + (h)) * HT)
#define SB(b, h) (shm + (4 + (b) * 2 + (h)) * HT)
#define STAGE(P, BASE, br, kt) do { const u16* _gp = (BASE) + ((long)(br) * K + (long)(kt) * BK); \
      __builtin_amdgcn_global_load_lds((const unsigned*)(_gp + voff0), (__attribute__((address_space(3))) unsigned*)((char*)(P) + wbase), 16, 0, 0); \
      __builtin_amdgcn_global_load_lds((const unsigned*)(_gp + voff1), (__attribute__((address_space(3))) unsigned*)((char*)(P) + wbase + 8192), 16, 0, 0); } while (0)
#define LDA(dst, b, h) for (int m = 0; m < 4; ++m) for (int k = 0; k < 2; ++k) \
    dst[m][k] = *reinterpret_cast<const bf16x8*>((char*)SA(b, h) + lds_byte(wr * 64 + m * 16 + fr, k * 32 + fq * 8))
#define LDB(dst, b, h) for (int n = 0; n < 2; ++n) for (int k = 0; k < 2; ++k) \
    dst[n][k] = *reinterpret_cast<const bf16x8*>((char*)SB(b, h) + lds_byte(wc * 32 + n * 16 + fr, k * 32 + fq * 8))
#define MMA(ai, bj, At, Bt_) do { __builtin_amdgcn_s_setprio(1); \
    for (int m = 0; m < 4; ++m) for (int n = 0; n < 2; ++n) for (int k = 0; k < 2; ++k) \
      acc[ai][bj][m][n] = __builtin_amdgcn_mfma_f32_16x16x32_bf16(Bt_[n][k], At[m][k], acc[ai][bj][m][n], 0, 0, 0); \
    __builtin_amdgcn_s_setprio(0); } while (0)
#define WAIT_V(n) asm volatile("s_waitcnt vmcnt(" #n ")" ::: "memory")
#define WAIT_L(n) asm volatile("s_waitcnt lgkmcnt(" #n ")" ::: "memory")
#define BAR __builtin_amdgcn_s_barrier()
#define SCHED __builtin_amdgcn_sched_barrier(0)
  const int wid = __builtin_amdgcn_readfirstlane(tix >> 6), lane = tix & 63, wr = wid >> 2, wc = wid & 3, fr = lane & 15, fq = lane >> 4;
  const int wbase = wid * 1024;
  int voff0, voff1;
  { int _r, _c; stage_rc(tix * 16, _r, _c); voff0 = _r * K + _c; stage_rc(tix * 16 + 8192, _r, _c); voff1 = _r * K + _c; }
  f32x4 acc[2][2][4][2] = {};
  bf16x8 At[4][2], B0[2][2], B1[2][2];
  constexpr int nt = K / BK;
  STAGE(SB(0, 0), Bt, bcol, 0); STAGE(SA(0, 0), A, brow, 0);
  STAGE(SB(0, 1), Bt, bcol + HALF, 0); STAGE(SA(0, 1), A, brow + HALF, 0);
  if (wr == 1) BAR;
  WAIT_V(4); BAR;
  STAGE(SB(1, 0), Bt, bcol, 1); STAGE(SA(1, 0), A, brow, 1); STAGE(SB(1, 1), Bt, bcol + HALF, 1);
  WAIT_V(6); BAR;
  for (int t = 0; t < nt - 2; t += 2) {
    LDB(B0, 0, 0); SCHED; LDA(At, 0, 0); STAGE(SA(1, 1), A, brow + HALF, t + 1);
    WAIT_L(8); BAR; WAIT_L(0); MMA(0, 0, At, B0); BAR; SCHED;
    LDB(B1, 0, 1); STAGE(SB(0, 0), Bt, bcol, t + 2);
    BAR; WAIT_L(0); MMA(0, 1, At, B1); BAR;
    LDA(At, 0, 1); STAGE(SA(0, 0), A, brow, t + 2);
    BAR; WAIT_L(0); MMA(1, 0, At, B0); BAR; SCHED;
    STAGE(SB(0, 1), Bt, bcol + HALF, t + 2);
    WAIT_V(6); BAR; MMA(1, 1, At, B1); BAR;
    LDB(B0, 1, 0); SCHED; LDA(At, 1, 0); STAGE(SA(0, 1), A, brow + HALF, t + 2);
    WAIT_L(8); BAR; WAIT_L(0); MMA(0, 0, At, B0); BAR; SCHED;
    LDB(B1, 1, 1); STAGE(SB(1, 0), Bt, bcol, t + 3);
    BAR; WAIT_L(0); MMA(0, 1, At, B1); BAR;
    LDA(At, 1, 1); STAGE(SA(1, 0), A, brow, t + 3);
    BAR; WAIT_L(0); MMA(1, 0, At, B0); BAR; SCHED;
    STAGE(SB(1, 1), Bt, bcol + HALF, t + 3);
    WAIT_V(6); BAR; MMA(1, 1, At, B1); BAR;
  }
  { LDB(B0, 0, 0); LDA(At, 0, 0); STAGE(SA(1, 1), A, brow + HALF, nt - 1);
    BAR; WAIT_L(0); MMA(0, 0, At, B0); BAR;
    LDB(B1, 0, 1); BAR; WAIT_L(0); MMA(0, 1, At, B1); BAR;
    LDA(At, 0, 1); WAIT_V(4); BAR; WAIT_L(0); MMA(1, 0, At, B0); MMA(1, 1, At, B1); BAR; }
  { LDB(B0, 1, 0); LDA(At, 1, 0); WAIT_V(2); BAR; WAIT_L(0); MMA(0, 0, At, B0); BAR;
    LDB(B1, 1, 1); WAIT_V(0); BAR; WAIT_L(0); MMA(0, 1, At, B1); BAR;
    LDA(At, 1, 1); BAR; WAIT_L(0); MMA(1, 0, At, B0); MMA(1, 1, At, B1); BAR; }
  if (wr == 0) BAR;
  int fr_ = fr, fq_ = fq, wr_ = wr, wc_ = wc;
  asm volatile("" : "+v"(fr_), "+v"(fq_), "+s"(wr_), "+s"(wc_));
#define fr fr_
#define fq fq_
#define wr wr_
#define wc wc_
  const int b = brow / SEQ, s0 = brow % SEQ;
  if (MODE == 0) {
    const bool lat = s0 >= TC;
#pragma unroll
    for (int ai = 0; ai < 2; ++ai)
#pragma unroll
      for (int bj = 0; bj < 2; ++bj) {
        const int colbase = bcol + bj * HALF + wc * 32;
        const bool isrope = lat && ((colbase >= C_K && colbase < C_V) || (colbase >= C_Q && colbase < C_GD));
#pragma unroll
        for (int m = 0; m < 4; ++m) {
          const int lr = ai * HALF + wr * 64 + m * 16 + fr;
          f32x4 x1 = acc[ai][bj][m][0], x2 = acc[ai][bj][m][1];
          if (isrope) {
            const int t = s0 + lr - TC; const int pos = (colbase & 32) ? (t & 63) : (t >> 6);
            const f32x4 cs = *reinterpret_cast<const f32x4*>(p.rope + pos * 16 + fq * 4), sn = *reinterpret_cast<const f32x4*>(p.rope + 1024 + pos * 16 + fq * 4);
            const f32x4 o1 = x1 * cs - x2 * sn, o2 = x2 * cs + x1 * sn; x1 = o1; x2 = o2;
          }
          u16* dst = p.pbuf + (size_t)(brow + lr) * INW + colbase + fq * 4;
          uint2 w1, w2; w1.x = cvtpk(x1[0] + 0.f, x1[1] + 0.f); w1.y = cvtpk(x1[2] + 0.f, x1[3] + 0.f); w2.x = cvtpk(x2[0] + 0.f, x2[1] + 0.f); w2.y = cvtpk(x2[2] + 0.f, x2[3] + 0.f);
          *reinterpret_cast<uint2*>(dst) = w1; *reinterpret_cast<uint2*>(dst + 16) = w2;
        }
      }
  } else {
    const bool isctx = s0 < TC;
    const float* gate = p.mod + (l * 9 + (isctx ? 8 : b)) * 3072 + 2048;
    const float* srcb = isctx ? ((l == 0) ? p.ctx : p.hc) : ((l == 0) ? p.x : p.out);
    float* dstb = isctx ? p.hc : p.out;
    const size_t rbase = isctx ? (size_t)b * TC : ((size_t)b * TL - TC);
#pragma unroll
    for (int ai = 0; ai < 2; ++ai)
#pragma unroll
      for (int bj = 0; bj < 2; ++bj)
#pragma unroll
        for (int n = 0; n < 2; ++n) {
          const int col = bcol + bj * HALF + wc * 32 + n * 16 + fq * 4;
          const f32x4 gt = *reinterpret_cast<const f32x4*>(gate + col);
#pragma unroll
          for (int m = 0; m < 4; ++m) {
            const int lr = ai * HALF + wr * 64 + m * 16 + fr; const int s = s0 + lr;
            const size_t off = (rbase + s) * 1024 + col;
            const f32x4 sv = *reinterpret_cast<const f32x4*>(srcb + off);
            *reinterpret_cast<f32x4*>(dstb + off) = sv + gt * acc[ai][bj][m][n];
          }
        }
  }
  __syncthreads();
#undef fr
#undef fq
#undef wr
#undef wc
#undef SA
#undef SB
#undef STAGE
#undef LDA
#undef LDB
#undef MMA
}

template <int MODE>
DI void gemm_phase(const int tix, const Params& p, int l, const u16* A, const u16* Bt, int nN, char* smem) {
  constexpr int nM = ROWS / BM;
  const int nwg = nM * nN; const bool last = (l == 1);
  for (int T = blockIdx.x; T < nwg; T += gridDim.x) {
    int wgid = T;
    { int q = nwg / NXCD, r = nwg % NXCD, xcd = wgid % NXCD, off = wgid / NXCD; wgid = (xcd < r ? xcd * (q + 1) : r * (q + 1) + (xcd - r) * q) + off; }
    int nig = WGM * nN, gid = wgid / nig, fm = gid * WGM, gsz = min(nM - fm, WGM);
    int pm = fm + ((wgid % nig) % gsz), pn = (wgid % nig) / gsz;
    const bool isctx = (pm % 17) == 0;
    if (last && isctx && (MODE == 1 || pn >= 6)) continue;
    gemm_tile<MODE>(tix, p, l, A, Bt, pm * BM, pn * BM, (u16*)smem);
  }
}
}


namespace pg {
#define PG_LAS __attribute__((address_space(3)))
constexpr int BM = 256, BK = 64, HALF = 128, HTB = HALF * BK * 2, NXCD = 8, WGM = 8, KD = 1024;
struct Unit { int pm, pn; };
struct Sched {
  int kind, nN, G, c;
  DI bool next(int i, Unit& u) const {
    const int nMv = (kind == 0) ? 136 : 128, main = nMv * nN, total = main + (kind == 2 ? 48 : 0);
    if (kind == 3) { if (i != 0 || c >= 32) return false; u.pm = (c >> 2) * 17; u.pn = c & 3; return true; }
    const int L = i * G + c; if (L >= total) return false;
    if (L >= main) { const int e = L - main; u.pm = (e / 6) * 17; u.pn = e % 6; return true; }
    int wgid = L; { const int q = main / NXCD, r = main % NXCD, xcd = wgid % NXCD, off = wgid / NXCD; wgid = (xcd < r ? xcd * (q + 1) : r * (q + 1) + (xcd - r) * q) + off; }
    const int nig = WGM * nN, gid = wgid / nig, fm = gid * WGM, gsz = (nMv - fm) < WGM ? (nMv - fm) : WGM;
    const int v = fm + ((wgid % nig) % gsz); u.pn = (wgid % nig) / gsz;
    u.pm = (kind == 0) ? v : (v + v / 16 + 1);
    return true;
  }
};
struct EpiIn {
  const Params& p; int l;
  static DI bool perm_unit(const Unit& u) { return !(u.pn == 2 || u.pn == 3 || u.pn == 8 || u.pn == 9); }
  DI void operator()(const f32x4 (&acc)[2][2][4][2], const Unit& u, int wr, int wc, int fr, int fq, bool perm) const {
    const int brow = u.pm * BM, bcol = u.pn * BM;
    const int s0 = brow % SEQ; const bool lat = s0 >= TC;
    if (perm) {
#pragma unroll
      for (int ai = 0; ai < 2; ++ai)
#pragma unroll
        for (int bj = 0; bj < 2; ++bj)
#pragma unroll
          for (int m = 0; m < 4; ++m) {
            const int lr = ai * HALF + wr * 64 + m * 16 + fr;
            const f32x4 x1 = acc[ai][bj][m][0], x2 = acc[ai][bj][m][1];
            u32x4 w = {cvtpk(x1[0] + 0.f, x1[1] + 0.f), cvtpk(x1[2] + 0.f, x1[3] + 0.f), cvtpk(x2[0] + 0.f, x2[1] + 0.f), cvtpk(x2[2] + 0.f, x2[3] + 0.f)};
            *reinterpret_cast<u32x4*>(p.pbuf + (size_t)(brow + lr) * INW + bcol + bj * HALF + wc * 32 + fq * 8) = w;
          }
      return;
    }
#pragma unroll
    for (int ai = 0; ai < 2; ++ai)
#pragma unroll
      for (int bj = 0; bj < 2; ++bj) {
        const int colbase = bcol + bj * HALF + wc * 32;
        const bool isrope = lat && ((colbase >= C_K && colbase < C_V) || (colbase >= C_Q && colbase < C_GD));
        f32x4 cs[4], sn[4];
        if (isrope) {
#pragma unroll
          for (int m = 0; m < 4; ++m) {
            const int t = s0 + ai * HALF + wr * 64 + m * 16 + fr - TC; const int pos = (colbase & 32) ? (t & 63) : (t >> 6);
            cs[m] = *reinterpret_cast<const f32x4*>(p.rope + pos * 16 + fq * 4); sn[m] = *reinterpret_cast<const f32x4*>(p.rope + 1024 + pos * 16 + fq * 4);
          }
          asm volatile("" ::: "memory");
        }
#pragma unroll
        for (int m = 0; m < 4; ++m) {
          const int lr = ai * HALF + wr * 64 + m * 16 + fr;
          f32x4 x1 = acc[ai][bj][m][0], x2 = acc[ai][bj][m][1];
          if (isrope) { const f32x4 o1 = x1 * cs[m] - x2 * sn[m], o2 = x2 * cs[m] + x1 * sn[m]; x1 = o1; x2 = o2; }
          u16* dst = p.pbuf + (size_t)(brow + lr) * INW + colbase + fq * 4;
          uint2 w1, w2; w1.x = cvtpk(x1[0] + 0.f, x1[1] + 0.f); w1.y = cvtpk(x1[2] + 0.f, x1[3] + 0.f); w2.x = cvtpk(x2[0] + 0.f, x2[1] + 0.f); w2.y = cvtpk(x2[2] + 0.f, x2[3] + 0.f);
          *reinterpret_cast<uint2*>(dst) = w1; *reinterpret_cast<uint2*>(dst + 16) = w2;
        }
      }
  }
};
struct EpiOut {
  const Params& p; int l;
  static DI bool perm_unit(const Unit&) { return false; }
  DI void operator()(const f32x4 (&acc)[2][2][4][2], const Unit& u, int wr, int wc, int fr, int fq, bool) const {
    const int brow = u.pm * BM, bcol = u.pn * BM;
    const int b = brow / SEQ, s0 = brow % SEQ; const bool isctx = s0 < TC;
    const float* gate = p.mod + (l * 9 + (isctx ? 8 : b)) * 3072 + 2048;
    const float* __restrict__ srcb = isctx ? ((l == 0) ? p.ctx : p.hc) : ((l == 0) ? p.x : p.out);
    float* dstb = isctx ? p.hc : p.out;
    const size_t rbase = isctx ? (size_t)b * TC : ((size_t)b * TL - TC);
#pragma unroll
    for (int ai = 0; ai < 2; ++ai)
#pragma unroll
      for (int bj = 0; bj < 2; ++bj) {
        f32x4 sv[2][4], gt[2]; size_t off[2][4];
#pragma unroll
        for (int n = 0; n < 2; ++n) {
          const int col = bcol + bj * HALF + wc * 32 + n * 16 + fq * 4;
          gt[n] = *reinterpret_cast<const f32x4*>(gate + col);
#pragma unroll
          for (int m = 0; m < 4; ++m) {
            const int lr = ai * HALF + wr * 64 + m * 16 + fr;
            off[n][m] = (rbase + s0 + lr) * 1024 + col;
            sv[n][m] = *reinterpret_cast<const f32x4*>(srcb + off[n][m]);
          }
        }
        asm volatile("" ::: "memory");
#pragma unroll
        for (int n = 0; n < 2; ++n)
#pragma unroll
          for (int m = 0; m < 4; ++m) *reinterpret_cast<f32x4*>(dstb + off[n][m]) = sv[n][m] + gt[n] * acc[ai][bj][m][n];
        asm volatile("" ::: "memory");
      }
  }
};

template <class Epi>
DI void gemm_stream(const int tix, PG_LAS unsigned char* lds, const u16* Ab, const u16* Btb, const Sched& S, const Epi& E) {
  const int tid = tix, wid = __builtin_amdgcn_readfirstlane(tid >> 6), lane = tid & 63, wr = wid >> 2, wc = wid & 3, fr = lane & 15, fq = lane >> 4;
  constexpr int K = KD, nt = K / BK;
  unsigned voffA[2], voffP[2];
#pragma unroll
  for (int i = 0; i < 2; ++i) { int R, C; gm::stage_rc(tid * 16 + i * 8192, R, C); voffA[i] = (unsigned)(R * K + C) * 2u;
    const int rho = R & 31, Rp = (R & ~31) + 8 * ((rho & 15) >> 2) + 4 * (rho >> 4) + (rho & 3); voffP[i] = (unsigned)(Rp * K + C) * 2u; }
  const size_t kstep = (size_t)(BK * 2);
  const size_t hstep = (size_t)HALF * K * 2;
  const size_t tstep = 2 * hstep;
  const unsigned ldsw = (unsigned)wid * 1024u;
  const int aoff = gm::lds_byte(wr * 64 + fr, fq * 8), boff = gm::lds_byte(wc * 32 + fr, fq * 8);
#define PG_SA(b, h) (((b) * 2 + (h)) * HTB)
#define PG_SB(b, h) ((4 + (b) * 2 + (h)) * HTB)
#define PG_STAGE2(bufoff, gbase, v0, v1) do { \
    __builtin_amdgcn_global_load_lds((const unsigned*)((const char*)(gbase) + (v0)), (PG_LAS unsigned*)(lds + (bufoff) + ldsw), 16, 0, 0); \
    __builtin_amdgcn_global_load_lds((const unsigned*)((const char*)(gbase) + (v1)), (PG_LAS unsigned*)(lds + (bufoff) + ldsw + 8192), 16, 0, 0); } while (0)
#define PG_STAGE(bufoff, gbase) PG_STAGE2(bufoff, gbase, voffA[0], voffA[1])
#define PG_STAGEB(bufoff, gbase, nx) PG_STAGE2(bufoff, gbase, (nx) ? vbN0 : vbC0, (nx) ? vbN1 : vbC1)
#define PG_LDA(dst, b, h) do { _Pragma("unroll") for (int m = 0; m < 4; ++m) _Pragma("unroll") for (int k = 0; k < 2; ++k) dst[m][k] = *(const PG_LAS bf16x8*)(lds + PG_SA(b, h) + aoff + m * 2048 + k * 1024); } while (0)
#define PG_LDB(dst, b, h) do { _Pragma("unroll") for (int n = 0; n < 2; ++n) _Pragma("unroll") for (int k = 0; k < 2; ++k) dst[n][k] = *(const PG_LAS bf16x8*)(lds + PG_SB(b, h) + boff + n * 2048 + k * 1024); } while (0)
#define PG_MMA(ai, bj, At, Bt) do { __builtin_amdgcn_s_setprio(1); _Pragma("unroll") for (int m = 0; m < 4; ++m) _Pragma("unroll") for (int n = 0; n < 2; ++n) _Pragma("unroll") for (int k = 0; k < 2; ++k) \
    acc[ai][bj][m][n] = __builtin_amdgcn_mfma_f32_16x16x32_bf16(Bt[n][k], At[m][k], acc[ai][bj][m][n], 0, 0, 0); __builtin_amdgcn_s_setprio(0); } while (0)
#define PG_WAIT_V(n) asm volatile("s_waitcnt vmcnt(" #n ")" ::: "memory")
#define PG_WAIT_L(n) asm volatile("s_waitcnt lgkmcnt(" #n ")" ::: "memory")
#define PG_BAR __builtin_amdgcn_s_barrier()
#define PG_SCHED __builtin_amdgcn_sched_barrier(0)
  Unit cur, nxt; int ui = 0;
  if (!S.next(0, cur)) return;
  if (STAGGER_US > 0 && (blockIdx.x & 8)) {
    const unsigned long long t0 = __builtin_amdgcn_s_memrealtime();
    while (__builtin_amdgcn_s_memrealtime() - t0 < (unsigned long long)(STAGGER_US * 100)) __builtin_amdgcn_s_sleep(16);
  }
  f32x4 acc[2][2][4][2];
#pragma unroll
  for (int a = 0; a < 2; ++a)
#pragma unroll
    for (int b = 0; b < 2; ++b)
#pragma unroll
      for (int m = 0; m < 4; ++m)
#pragma unroll
        for (int n = 0; n < 2; ++n) acc[a][b][m][n] = (f32x4){0.f, 0.f, 0.f, 0.f};
  bf16x8 At[4][2], B0[2][2], B1[2][2];
  const char* cA = (const char*)Ab + (size_t)cur.pm * tstep; const char* cB = (const char*)Btb + (size_t)cur.pn * tstep;
  bool cperm = Epi::perm_unit(cur);
  unsigned vbC0 = cperm ? voffP[0] : voffA[0], vbC1 = cperm ? voffP[1] : voffA[1], vbN0 = vbC0, vbN1 = vbC1;
  PG_STAGEB(PG_SB(0, 0), cB, false); PG_STAGE(PG_SA(0, 0), cA); PG_STAGEB(PG_SB(0, 1), cB + hstep, false); PG_STAGE(PG_SA(0, 1), cA + hstep);
  if (wr == 1) PG_BAR;
  PG_WAIT_V(4); PG_BAR;
  PG_STAGEB(PG_SB(1, 0), cB + kstep, false); PG_STAGE(PG_SA(1, 0), cA + kstep); PG_STAGEB(PG_SB(1, 1), cB + hstep + kstep, false);
  PG_WAIT_V(6); PG_BAR;
  for (;;) {
    const bool has_next = S.next(ui + 1, nxt);
    const char* nA = has_next ? (const char*)Ab + (size_t)nxt.pm * tstep : cA; const char* nB = has_next ? (const char*)Btb + (size_t)nxt.pn * tstep : cB;
    const bool nperm = has_next ? Epi::perm_unit(nxt) : cperm;
    vbN0 = nperm ? voffP[0] : voffA[0]; vbN1 = nperm ? voffP[1] : voffA[1];
    for (int t = 0; t < nt; t += 2) {
      const bool last = (t == nt - 2);
      const char* a1 = cA + (size_t)(t + 1) * kstep;
      const char* a2 = last ? nA : cA + (size_t)(t + 2) * kstep; const char* b2 = last ? nB : cB + (size_t)(t + 2) * kstep;
      const char* a3 = a2 + kstep; const char* b3 = b2 + kstep;
      PG_LDB(B0, 0, 0); PG_SCHED; PG_LDA(At, 0, 0); PG_STAGE(PG_SA(1, 1), a1 + hstep);
      PG_WAIT_L(8); PG_BAR; PG_WAIT_L(0); PG_MMA(0, 0, At, B0); PG_BAR; PG_SCHED;
      PG_LDB(B1, 0, 1); PG_STAGEB(PG_SB(0, 0), b2, last);
      PG_BAR; PG_WAIT_L(0); PG_MMA(0, 1, At, B1); PG_BAR;
      PG_LDA(At, 0, 1); PG_STAGE(PG_SA(0, 0), a2);
      PG_BAR; PG_WAIT_L(0); PG_MMA(1, 0, At, B0); PG_BAR; PG_SCHED;
      PG_STAGEB(PG_SB(0, 1), b2 + hstep, last);
      PG_WAIT_V(6); PG_BAR; PG_MMA(1, 1, At, B1); PG_BAR;
      PG_LDB(B0, 1, 0); PG_SCHED; PG_LDA(At, 1, 0); PG_STAGE(PG_SA(0, 1), a2 + hstep);
      PG_WAIT_L(8); PG_BAR; PG_WAIT_L(0); PG_MMA(0, 0, At, B0); PG_BAR; PG_SCHED;
      PG_LDB(B1, 1, 1); PG_STAGEB(PG_SB(1, 0), b3, last);
      PG_BAR; PG_WAIT_L(0); PG_MMA(0, 1, At, B1); PG_BAR;
      PG_LDA(At, 1, 1); PG_STAGE(PG_SA(1, 0), a3);
      PG_BAR; PG_WAIT_L(0); PG_MMA(1, 0, At, B0); PG_BAR; PG_SCHED;
      PG_STAGEB(PG_SB(1, 1), b3 + hstep, last);
      PG_WAIT_V(6); PG_BAR; PG_MMA(1, 1, At, B1); PG_BAR;
    }
    E(acc, cur, wr, wc, fr, fq, cperm);
    if (!has_next) break;
#pragma unroll
    for (int a = 0; a < 2; ++a)
#pragma unroll
      for (int b = 0; b < 2; ++b)
#pragma unroll
        for (int m = 0; m < 4; ++m)
#pragma unroll
          for (int n = 0; n < 2; ++n) acc[a][b][m][n] = (f32x4){0.f, 0.f, 0.f, 0.f};
    cur = nxt; cA = nA; cB = nB; cperm = nperm; vbC0 = vbN0; vbC1 = vbN1; ++ui;
  }
  PG_WAIT_V(0);
  if (wr == 0) PG_BAR;
  PG_BAR;
#undef PG_SA
#undef PG_SB
#undef PG_STAGE
#undef PG_STAGE2
#undef PG_STAGEB
#undef PG_LDA
#undef PG_LDB
#undef PG_MMA
#undef PG_WAIT_V
#undef PG_WAIT_L
#undef PG_BAR
#undef PG_SCHED
}
}

namespace at {
constexpr int NW = 8, QBLK = 32, KVBLK = 64;
constexpr float SCALE = 0.125f, THR = 8.f;
constexpr int LDQ = INW, LDK = INW, LDO = 1024;
constexpr int SHM_V = KVBLK * 128 * 2, SHM_K = KVBLK * 64 * 2;
#define KSWZ(row, colB) ((row) * 128 + ((colB) ^ (((row) & 7) << 4)))
#define SBAR() __builtin_amdgcn_sched_barrier(0)

DI void partialSM(f32x16& p0, f32x16& p1, float& m_reg, float& mn, float& alpha) {
  constexpr float C = SCALE * 1.4426950408889634f;
  float pmax = p0[0];
  for (int r = 1; r < 16; ++r) pmax = fmaxf(pmax, p0[r]);
  for (int r = 0; r < 16; ++r) pmax = fmaxf(pmax, p1[r]);
  { auto rr = __builtin_amdgcn_permlane32_swap(__float_as_uint(pmax), __float_as_uint(pmax), false, false);
    pmax = fmaxf(__uint_as_float(rr[0]), __uint_as_float(rr[1])); }
  if (__builtin_expect(__all(pmax - m_reg <= THR / SCALE), 1)) { mn = m_reg; alpha = 1.f; }
  else { mn = fmaxf(m_reg, pmax); alpha = __builtin_amdgcn_exp2f((m_reg - mn) * C); m_reg = mn; }
  float mnC = -mn * C;
  for (int r = 0; r < 16; ++r) p0[r] = fmaf(p0[r], C, mnC);
  for (int r = 0; r < 16; ++r) p1[r] = fmaf(p1[r], C, mnC);
  for (int r = 0; r < 16; ++r) p0[r] = __builtin_amdgcn_exp2f(p0[r]);
}
DI void finishSM(f32x16& p0, f32x16& p1, float alpha, float& l_reg, bf16x8& pa0, bf16x8& pa1, bf16x8& pa2, bf16x8& pa3) {
  for (int r = 0; r < 16; ++r) p1[r] = __builtin_amdgcn_exp2f(p1[r]);
  float ps = 0;
  for (int r = 0; r < 16; ++r) ps += p0[r];
  for (int r = 0; r < 16; ++r) ps += p1[r];
  { auto rr = __builtin_amdgcn_permlane32_swap(__float_as_uint(ps), __float_as_uint(ps), false, false);
    ps = __uint_as_float(rr[0]) + __uint_as_float(rr[1]); }
  l_reg = l_reg * alpha + ps;
#define PK4(P, BASE, OUT) do { unsigned a0 = cvtpk(P[BASE + 0], P[BASE + 1]), a1 = cvtpk(P[BASE + 2], P[BASE + 3]);   \
    unsigned b0 = cvtpk(P[BASE + 4], P[BASE + 5]), b1 = cvtpk(P[BASE + 6], P[BASE + 7]);                              \
    auto r0 = __builtin_amdgcn_permlane32_swap(a0, b0, false, false); auto r1 = __builtin_amdgcn_permlane32_swap(a1, b1, false, false); \
    u32x4 w = {r0[0], r1[0], r0[1], r1[1]}; OUT = *reinterpret_cast<bf16x8*>(&w); } while (0)
  PK4(p0, 0, pa0); PK4(p0, 8, pa1); PK4(p1, 0, pa2); PK4(p1, 8, pa3);
#undef PK4
}
DI void qkt(f32x16& p0, f32x16& p1, const char* Ks, const bf16x8* qr, int r32, int hi) {
  p0 = f32x16{}; p1 = f32x16{};
#pragma unroll
  for (int d0 = 0; d0 < 4; ++d0) { int cb = (d0 * 16 + hi * 8) * 2;
    bf16x8 b0 = *reinterpret_cast<const bf16x8*>(Ks + KSWZ(r32, cb));
    bf16x8 b1 = *reinterpret_cast<const bf16x8*>(Ks + KSWZ(32 + r32, cb));
    p0 = MFMA32(b0, qr[d0], p0);
    p1 = MFMA32(b1, qr[d0], p1); }
}
DI int v_st(int k, int c) { const int kk = (k & ~0xC) | ((k & 4) << 1) | ((k & 8) >> 1); return ((kk >> 3) * 4 + (c >> 5)) * 512 + ((kk & 7) * 32 + (c & 31)) * 2; }
DI int v_rd_base(int lane) { return ((lane & 3) << 3) | (((lane >> 2) & 3) << 6) | (((lane >> 4) & 1) << 5) | (((lane >> 5) & 1) << 8); }
constexpr int v_rd_off(int d0, int ks, int half) { return d0 * 512 + ks * 4096 + half * 2048; }
template <int OFF> DI s16x4 tr_read(int vb) {
  s16x4 r; asm volatile("ds_read_b64_tr_b16 %0, %1 offset:%2" : "=&v"(r) : "v"(vb), "i"(OFF) : "memory"); return r;
}
template <int D0> DI void pv_one(f32x16& od, int vb, bf16x8 pa0, bf16x8 pa1, bf16x8 pa2, bf16x8 pa3) {
  const s16x4 l0 = tr_read<v_rd_off(D0, 0, 0)>(vb), h0 = tr_read<v_rd_off(D0, 0, 1)>(vb), l1 = tr_read<v_rd_off(D0, 1, 0)>(vb), h1 = tr_read<v_rd_off(D0, 1, 1)>(vb);
  const s16x4 l2 = tr_read<v_rd_off(D0, 2, 0)>(vb), h2 = tr_read<v_rd_off(D0, 2, 1)>(vb), l3 = tr_read<v_rd_off(D0, 3, 0)>(vb), h3 = tr_read<v_rd_off(D0, 3, 1)>(vb);
  asm volatile("s_waitcnt lgkmcnt(0)" ::: "memory"); SBAR();
#define PK(L, H) (bf16x8){L[0], L[1], L[2], L[3], H[0], H[1], H[2], H[3]}
  od = MFMA32(pa0, PK(l0, h0), od);
  od = MFMA32(pa1, PK(l1, h1), od);
  od = MFMA32(pa2, PK(l2, h2), od);
  od = MFMA32(pa3, PK(l3, h3), od);
#undef PK
}
DI void pv_d0(f32x16* o, int vb, bf16x8 pa0, bf16x8 pa1, bf16x8 pa2, bf16x8 pa3) {
  pv_one<0>(o[0], vb, pa0, pa1, pa2, pa3); pv_one<1>(o[1], vb, pa0, pa1, pa2, pa3); pv_one<2>(o[2], vb, pa0, pa1, pa2, pa3); pv_one<3>(o[3], vb, pa0, pa1, pa2, pa3);
}

DI void attn_body(const int tix, const u16* __restrict__ Qb, const u16* __restrict__ Kh, const u16* __restrict__ Vh, u16* __restrict__ Ob, int seq, char* lds) {
  const int tid = tix, wid = tid >> 6, lane = tid & 63, r32 = lane & 31, hi = lane >> 5;
  char* V_lds = lds; char* K_lds = lds + 2 * SHM_V;
  float* ws = (float*)(lds + 2 * SHM_V + 2 * SHM_K) + wid * 64; float* li_l = ws; float* al_l = ws + 32;
  float m_reg = -1e30f, l_reg = 0; f32x16 o[4] = {}; bf16x8 qr[4];
  const u16* Qw = Qb + (long)(wid * QBLK + r32) * LDQ + hi * 8;
#pragma unroll
  for (int d0 = 0; d0 < 4; ++d0) qr[d0] = *reinterpret_cast<const bf16x8*>(Qw + d0 * 16);
  const int sr = tid >> 4, sc = (tid & 15) * 8, vst0 = v_st(sr, sc), vst1 = v_st(32 + sr, sc);
  const int ksr = tid >> 3, ksc = (tid & 7) * 8, kst = KSWZ(ksr, ksc * 2);
  const int vb0 = (int)(uintptr_t)V_lds + v_rd_base(lane);
  struct { bf16x8 vs0, vs1, ks0; } sr_[2];
#define SLOAD(i, k0) do { sr_[i].vs0 = *reinterpret_cast<const bf16x8*>(&Vh[(long)((k0) + sr) * LDK + sc]); sr_[i].vs1 = *reinterpret_cast<const bf16x8*>(&Vh[(long)((k0) + 32 + sr) * LDK + sc]); \
    sr_[i].ks0 = *reinterpret_cast<const bf16x8*>(&Kh[(long)((k0) + ksr) * LDK + ksc]); } while (0)
#define SWRITE(b, i) do { *(bf16x8*)(V_lds + (b) * SHM_V + vst0) = sr_[i].vs0;          \
    *(bf16x8*)(V_lds + (b) * SHM_V + vst1) = sr_[i].vs1;               \
    *(bf16x8*)(K_lds + (b) * SHM_K + kst) = sr_[i].ks0; } while (0)
#define SWAIT() asm volatile("s_waitcnt vmcnt(3)" ::: "memory")
#define RESC(a) do { if (__any((a) < 1.f)) { if (hi == 0) al_l[r32] = (a); asm volatile("s_waitcnt lgkmcnt(0)" ::: "memory"); \
    for (int d = 0; d < 4; ++d) for (int r = 0; r < 16; ++r) o[d][r] *= al_l[crow(r, hi)]; } } while (0)
  f32x16 pA0, pA1, pB0, pB1; float mnA, mnB, alA, alB; bf16x8 pa0, pa1, pa2, pa3; const int NT = seq / KVBLK;
  constexpr int SE = 0, SO = 1;
  SLOAD(SE, 0); asm volatile("s_waitcnt vmcnt(0)" ::: "memory"); SWRITE(0, SE); __syncthreads();
  qkt(pA0, pA1, K_lds, qr, r32, hi); partialSM(pA0, pA1, m_reg, mnA, alA);
  SLOAD(SO, KVBLK); if (2 < NT) SLOAD(SE, 2 * KVBLK);
  SWAIT(); SWRITE(1, SO); __syncthreads();
  for (int j = 1; j + 1 < NT; j += 2) {
    SBAR(); qkt(pB0, pB1, K_lds + SHM_K, qr, r32, hi);
    finishSM(pA0, pA1, alA, l_reg, pa0, pa1, pa2, pa3); SBAR();
    SLOAD(SO, (j + 2) * KVBLK); SBAR();
    pv_d0(o, vb0, pa0, pa1, pa2, pa3); partialSM(pB0, pB1, m_reg, mnB, alB);
    __syncthreads(); SWAIT(); SWRITE(0, SE);
    RESC(alB); __syncthreads();
    SBAR(); qkt(pA0, pA1, K_lds, qr, r32, hi);
    finishSM(pB0, pB1, alB, l_reg, pa0, pa1, pa2, pa3); SBAR();
    if (j + 3 < NT) SLOAD(SE, (j + 3) * KVBLK); SBAR();
    pv_d0(o, vb0 + (int)SHM_V, pa0, pa1, pa2, pa3); partialSM(pA0, pA1, m_reg, mnA, alA);
    __syncthreads(); SWAIT(); SWRITE(1, SO);
    RESC(alA); __syncthreads();
  }
  SBAR(); qkt(pB0, pB1, K_lds + SHM_K, qr, r32, hi);
  finishSM(pA0, pA1, alA, l_reg, pa0, pa1, pa2, pa3); SBAR();
  pv_d0(o, vb0, pa0, pa1, pa2, pa3); partialSM(pB0, pB1, m_reg, mnB, alB);
  __syncthreads(); RESC(alB);
  finishSM(pB0, pB1, alB, l_reg, pa0, pa1, pa2, pa3); SBAR();
  pv_d0(o, vb0 + (int)SHM_V, pa0, pa1, pa2, pa3);
  if (hi == 0) li_l[r32] = l_reg; asm volatile("s_waitcnt lgkmcnt(0)" ::: "memory");
  float rli[16];
#pragma unroll
  for (int r = 0; r < 16; ++r) rli[r] = __builtin_amdgcn_rcpf(li_l[crow(r, hi)]);
  u16* Ow = Ob + (long)(wid * QBLK) * LDO;
#pragma unroll
  for (int r = 0; r < 16; ++r) { int orow = crow(r, hi);
#pragma unroll
    for (int d0 = 0; d0 < 4; ++d0) Ow[(long)orow * LDO + d0 * 32 + r32] = f2bf(o[d0][r] * rli[r]); }
  __syncthreads();
#undef SLOAD
#undef SWRITE
#undef SWAIT
#undef RESC
}

template <int OFF> DI s16x4 tr_read2(int vb) { s16x4 r; asm volatile("ds_read_b64_tr_b16 %0, %1 offset:%2" : "=&v"(r) : "v"(vb), "i"(OFF) : "memory"); return r; }
template <int BUF, int D0> DI void pv_one_b(f32x16& od, int vb, bf16x8 pa0, bf16x8 pa1, bf16x8 pa2, bf16x8 pa3) {
  constexpr int BO = BUF * 16384;
  const s16x4 l0 = tr_read2<BO + v_rd_off(D0, 0, 0)>(vb), h0 = tr_read2<BO + v_rd_off(D0, 0, 1)>(vb), l1 = tr_read2<BO + v_rd_off(D0, 1, 0)>(vb), h1 = tr_read2<BO + v_rd_off(D0, 1, 1)>(vb);
  const s16x4 l2 = tr_read2<BO + v_rd_off(D0, 2, 0)>(vb), h2 = tr_read2<BO + v_rd_off(D0, 2, 1)>(vb), l3 = tr_read2<BO + v_rd_off(D0, 3, 0)>(vb), h3 = tr_read2<BO + v_rd_off(D0, 3, 1)>(vb);
  asm volatile("s_waitcnt lgkmcnt(0)" ::: "memory"); SBAR();
#define PK(L, H) (bf16x8){L[0], L[1], L[2], L[3], H[0], H[1], H[2], H[3]}
  od = MFMA32(pa0, PK(l0, h0), od);
  od = MFMA32(pa1, PK(l1, h1), od);
  od = MFMA32(pa2, PK(l2, h2), od);
  od = MFMA32(pa3, PK(l3, h3), od);
#undef PK
}
template <int BUF> DI void pv_b(f32x16* o, int vb, bf16x8 pa0, bf16x8 pa1, bf16x8 pa2, bf16x8 pa3) {
  constexpr int BO = BUF * 16384;
#define PK(L, H) (bf16x8){L[0], L[1], L[2], L[3], H[0], H[1], H[2], H[3]}
#define PV_RD(G, R) do { R[0] = tr_read2<BO + v_rd_off((G) >> 1, 2 * ((G) & 1), 0)>(vb); R[1] = tr_read2<BO + v_rd_off((G) >> 1, 2 * ((G) & 1), 1)>(vb); \
    R[2] = tr_read2<BO + v_rd_off((G) >> 1, 2 * ((G) & 1) + 1, 0)>(vb); R[3] = tr_read2<BO + v_rd_off((G) >> 1, 2 * ((G) & 1) + 1, 1)>(vb); } while (0)
#define PV_MM(G, R) do { if ((G) & 1) { o[(G) >> 1] = MFMA32(pa2, PK(R[0], R[1]), o[(G) >> 1]); o[(G) >> 1] = MFMA32(pa3, PK(R[2], R[3]), o[(G) >> 1]); } \
    else { o[(G) >> 1] = MFMA32(pa0, PK(R[0], R[1]), o[(G) >> 1]); o[(G) >> 1] = MFMA32(pa1, PK(R[2], R[3]), o[(G) >> 1]); } } while (0)
#define PV_WAIT(N) do { asm volatile("s_waitcnt lgkmcnt(" #N ")" ::: "memory"); SBAR(); } while (0)
  s16x4 ra[4], rb[4], rc[4];
  PV_RD(0, ra); PV_RD(1, rb); PV_RD(2, rc);
  PV_WAIT(8); PV_MM(0, ra); PV_RD(3, ra);
  PV_WAIT(8); PV_MM(1, rb); PV_RD(4, rb);
  PV_WAIT(8); PV_MM(2, rc); PV_RD(5, rc);
  PV_WAIT(8); PV_MM(3, ra); PV_RD(6, ra);
  PV_WAIT(8); PV_MM(4, rb); PV_RD(7, rb);
  PV_WAIT(8); PV_MM(5, rc);
  PV_WAIT(4); PV_MM(6, ra);
  PV_WAIT(0); PV_MM(7, rb);
#undef PK
#undef PV_RD
#undef PV_MM
#undef PV_WAIT
}
#define KSWZ2(row, colB) ((((row) >> 1) << 8) + ((((((row) & 1) << 3) | ((colB) >> 4)) ^ (((row) >> 1) & 15)) << 4))
DI void qkt2(f32x16& p0, f32x16& p1, const char* Ks, const bf16x8* qr, int r32, int hi) {
  p0 = f32x16{}; p1 = f32x16{};
#pragma unroll
  for (int d0 = 0; d0 < 4; ++d0) { const int cb = (d0 * 16 + hi * 8) * 2;
    bf16x8 b0 = *reinterpret_cast<const bf16x8*>(Ks + KSWZ2(r32, cb));
    bf16x8 b1 = *reinterpret_cast<const bf16x8*>(Ks + KSWZ2(32 + r32, cb));
    p0 = MFMA32(b0, qr[d0], p0);
    p1 = MFMA32(b1, qr[d0], p1); }
}
constexpr int DMA_K0 = 65536, DMA_WS = 98304;
DI void attn_body_dma(const int tix, const u16* __restrict__ Qb, const u16* __restrict__ Kh, const u16* __restrict__ Vh, u16* __restrict__ Ob, int seq, char* lds) {
  const int tid = tix, wid = __builtin_amdgcn_readfirstlane(tid >> 6), lane = tid & 63, r32 = lane & 31, hi = lane >> 5;
  float* ws = (float*)(lds + DMA_WS) + wid * 64; float* li_l = ws; float* al_l = ws + 32;
  float m_reg = -1e30f, l_reg = 0; f32x16 o[4] = {}; bf16x8 qr[4];
  const u16* Qw = Qb + (long)(wid * QBLK + r32) * LDQ + hi * 8;
#pragma unroll
  for (int d0 = 0; d0 < 4; ++d0) qr[d0] = *reinterpret_cast<const bf16x8*>(Qw + d0 * 16);
  int koff, voff0, voff1;
  { const int oo = tid * 16, sr = oo >> 8, x = ((oo >> 4) & 15) ^ (sr & 15), row = sr * 2 + (x >> 3), colB = (x & 7) * 16; koff = row * LDK + (colB >> 1); }
  { const int oo = tid * 16, S = oo >> 9, w = (oo & 511) >> 1, kk = (S >> 2) * 8 + (w >> 5), k = (kk & ~0xC) | ((kk & 4) << 1) | ((kk & 8) >> 1); voff0 = k * LDK + (S & 3) * 32 + (w & 31); }
  { const int oo = tid * 16 + 8192, S = oo >> 9, w = (oo & 511) >> 1, kk = (S >> 2) * 8 + (w >> 5), k = (kk & ~0xC) | ((kk & 4) << 1) | ((kk & 8) >> 1); voff1 = k * LDK + (S & 3) * 32 + (w & 31); }
  const int wb = wid * 1024;
  const int vb0 = (int)(uintptr_t)lds + v_rd_base(lane);
#define LASP(x) ((__attribute__((address_space(3))) unsigned*)(x))
#define ISSUE(T, B) do { const u16* kt_ = Kh + (long)(T) * (KVBLK * LDK); const u16* vt_ = Vh + (long)(T) * (KVBLK * LDK); \
    __builtin_amdgcn_global_load_lds((const unsigned*)(kt_ + koff), LASP(lds + DMA_K0 + (B) * 8192 + wb), 16, 0, 0); \
    __builtin_amdgcn_global_load_lds((const unsigned*)(vt_ + voff0), LASP(lds + (B) * 16384 + wb), 16, 0, 0); \
    __builtin_amdgcn_global_load_lds((const unsigned*)(vt_ + voff1), LASP(lds + (B) * 16384 + 8192 + wb), 16, 0, 0); } while (0)
#define WAITV(n) asm volatile("s_waitcnt vmcnt(" #n ")" ::: "memory")
#define BARX() do { asm volatile("s_waitcnt lgkmcnt(0)" ::: "memory"); __builtin_amdgcn_s_barrier(); asm volatile("" ::: "memory"); } while (0)
#define RESC(a) do { if (__any((a) < 1.f)) { if (hi == 0) al_l[r32] = (a); asm volatile("s_waitcnt lgkmcnt(0)" ::: "memory"); \
    for (int d = 0; d < 4; ++d) for (int r = 0; r < 16; ++r) o[d][r] *= al_l[crow(r, hi)]; } } while (0)
  f32x16 pA0, pA1, pB0, pB1; float mnA, mnB, alA, alB; bf16x8 pa0, pa1, pa2, pa3; const int NT = seq / KVBLK;
#define BAR_EVEN(u) do { if ((u) + 1 < NT) WAITV(3); else WAITV(0); BARX(); } while (0)
#define BAR_ODD(t, B) do { BARX(); if ((t) + 2 < NT) ISSUE((t) + 2, ((B) + 2) & 3); } while (0)
#define SEG1(B, PC0, PC1, PP0, PP1, alP) do { SBAR(); qkt2(PC0, PC1, lds + DMA_K0 + (B) * 8192, qr, r32, hi); finishSM(PP0, PP1, alP, l_reg, pa0, pa1, pa2, pa3); SBAR(); } while (0)
#define SEG2(VBUF, PC0, PC1, mnC, alC) do { pv_b<(VBUF) & 3>(o, vb0, pa0, pa1, pa2, pa3); partialSM(PC0, PC1, m_reg, mnC, alC); RESC(alC); } while (0)
  ISSUE(0, 0); ISSUE(1, 1);
  if (wid < 4) {
#define IT_A(t, B, PC0, PC1, mnC, alC, PP0, PP1, alP) do { BAR_EVEN(t); SEG1(B, PC0, PC1, PP0, PP1, alP); BAR_ODD(t, B); SEG2((B) + 3, PC0, PC1, mnC, alC); } while (0)
    BAR_EVEN(0); qkt2(pA0, pA1, lds + DMA_K0, qr, r32, hi);
    BAR_ODD(0, 0); partialSM(pA0, pA1, m_reg, mnA, alA);
    int t = 1;
    for (; t + 3 < NT; t += 4) {
      IT_A(t, 1, pB0, pB1, mnB, alB, pA0, pA1, alA);
      IT_A(t + 1, 2, pA0, pA1, mnA, alA, pB0, pB1, alB);
      IT_A(t + 2, 3, pB0, pB1, mnB, alB, pA0, pA1, alA);
      IT_A(t + 3, 0, pA0, pA1, mnA, alA, pB0, pB1, alB);
    }
    IT_A(t, 1, pB0, pB1, mnB, alB, pA0, pA1, alA);
    IT_A(t + 1, 2, pA0, pA1, mnA, alA, pB0, pB1, alB);
    IT_A(t + 2, 3, pB0, pB1, mnB, alB, pA0, pA1, alA);
    finishSM(pB0, pB1, alB, l_reg, pa0, pa1, pa2, pa3); SBAR();
    pv_b<3>(o, vb0, pa0, pa1, pa2, pa3);
    WAITV(0); BARX();
#undef IT_A
  } else {
#define IT_B(t, B, PC0, PC1, PQ0, PQ1, mnQ, alQ) do { BAR_EVEN(t); \
      if ((t) > 1) { SEG2((B) + 2, PQ0, PQ1, mnQ, alQ); } else { partialSM(PQ0, PQ1, m_reg, mnQ, alQ); } \
      BAR_ODD(t, B); SEG1(B, PC0, PC1, PQ0, PQ1, alQ); } while (0)
    BAR_EVEN(0);
    BAR_ODD(0, 0); qkt2(pA0, pA1, lds + DMA_K0, qr, r32, hi);
    int t = 1;
    for (; t + 3 < NT; t += 4) {
      IT_B(t, 1, pB0, pB1, pA0, pA1, mnA, alA);
      IT_B(t + 1, 2, pA0, pA1, pB0, pB1, mnB, alB);
      IT_B(t + 2, 3, pB0, pB1, pA0, pA1, mnA, alA);
      IT_B(t + 3, 0, pA0, pA1, pB0, pB1, mnB, alB);
    }
    IT_B(t, 1, pB0, pB1, pA0, pA1, mnA, alA);
    IT_B(t + 1, 2, pA0, pA1, pB0, pB1, mnB, alB);
    IT_B(t + 2, 3, pB0, pB1, pA0, pA1, mnA, alA);
    WAITV(0); BARX();
    SEG2(2, pB0, pB1, mnB, alB);
    finishSM(pB0, pB1, alB, l_reg, pa0, pa1, pa2, pa3); SBAR();
    pv_b<3>(o, vb0, pa0, pa1, pa2, pa3);
#undef IT_B
  }
#undef BAR_EVEN
#undef BAR_ODD
#undef SEG1
#undef SEG2
  if (hi == 0) li_l[r32] = l_reg; asm volatile("s_waitcnt lgkmcnt(0)" ::: "memory");
  float rli[16];
#pragma unroll
  for (int r = 0; r < 16; ++r) rli[r] = __builtin_amdgcn_rcpf(li_l[crow(r, hi)]);
  u16* Ow = Ob + (long)(wid * QBLK) * LDO;
#pragma unroll
  for (int r = 0; r < 16; ++r) { int orow = crow(r, hi);
#pragma unroll
    for (int d0 = 0; d0 < 4; ++d0) Ow[(long)orow * LDO + d0 * 32 + r32] = f2bf(o[d0][r] * rli[r]); }
  asm volatile("s_waitcnt vmcnt(0)" ::: "memory");
  __syncthreads();
#undef LASP
#undef ISSUE
#undef WAITV
#undef BARX
#undef RESC
#undef HALF_IT
}
}

DI int smap(int sigma, int dir) { return dir == 0 ? sigma : (sigma < TC ? (TC - 1 - sigma) : (SEQ + TC - 1 - sigma)); }

DI float fsig(float v) { return __builtin_amdgcn_rcpf(1.f + __builtin_amdgcn_exp2f(-1.4426950408889634f * v)); }
DI u16 bfr(float x) { return (u16)(cvtpk(x, x) & 0xffffu); }
#define WAVE_SYNC() do { __builtin_amdgcn_fence(__ATOMIC_RELEASE, "wavefront"); __builtin_amdgcn_wave_barrier(); __builtin_amdgcn_fence(__ATOMIC_ACQUIRE, "wavefront"); } while (0)

DI void lru_wg_item(const int tix, const Params& p, int l, int item, char* smem) {
  const int wid = __builtin_amdgcn_readfirstlane(tix >> 6), lane = tix & 63, r = lane & 31, h = lane >> 5;
  const int b = item >> 4, dir = (item >> 3) & 1, n = (item >> 1) & 3, half = item & 1;
  char* wlds = smem + wid * 9216;
  u16* xcb = (u16*)wlds;
  float* xcf = (float*)(wlds + 32 * 144);
  float* exch = (float*)(smem + 8 * 9216);
  const int ld = l * 2 + dir;
  bf16x8 wa[4], wx[4];
  { const u16* wt = p.lruWT + (size_t)(((ld * 4 + n) * 2) * 4096) + (half * 32 + r) * 64 + 8 * h;
#pragma unroll
    for (int s = 0; s < 4; ++s) { wa[s] = *reinterpret_cast<const bf16x8*>(wt + 16 * s); wx[s] = *reinterpret_cast<const bf16x8*>(wt + 4096 + 16 * s); } }
  const int ch = n * 64 + half * 32 + r;
  const float ba = p.lru_ba[ld * 256 + ch], bx = p.lru_bx[ld * 256 + ch];
  const float sp8l = 8.f * 1.4426950408889634f * log1pf(expf(-p.lru_lam[ld * 256 + ch]));
  const int cch = n * 64 + lane;
  const float cw0 = p.conv_w[(l * 4 + 0) * 256 + cch], cw1 = p.conv_w[(l * 4 + 1) * 256 + cch], cw2 = p.conv_w[(l * 4 + 2) * 256 + cch], cw3 = p.conv_w[(l * 4 + 3) * 256 + cch];
  const float cbias = p.conv_b[l * 256 + cch];
  const u16* ubase = p.pbuf + (size_t)b * SEQ * INW + C_UA + cch;
  u16* hout = p.hl + ((size_t)dir * ROWS + (size_t)b * SEQ) * 256 + ch;
  float sc = 0.f;
  u16 un[35];
  { const int sg = wid * 32; const int smin0 = dir == 0 ? sg : smap(sg + 31, 1);
#pragma unroll
    for (int k = 0; k < 35; ++k) { int s = smin0 - 2 + k; s = s < 0 ? 0 : (s > SEQ - 1 ? SEQ - 1 : s); un[k] = ubase[(size_t)s * INW]; } }
  for (int st = 0; st < SEQ / 256; ++st) {
    const int sg0 = st * 256 + wid * 32;
    const int smin = dir == 0 ? sg0 : smap(sg0 + 31, 1);
    const int seg_lo = smin < TC ? 0 : TC, seg_hi = smin < TC ? TC : SEQ;
    float uw[35];
#pragma unroll
    for (int k = 0; k < 35; ++k) { const int s = smin - 2 + k; uw[k] = (s >= seg_lo && s < seg_hi) ? bf2f(un[k]) : 0.f; }
    if (st + 1 < SEQ / 256) {
      const int smin1 = dir == 0 ? sg0 + 256 : smap(sg0 + 256 + 31, 1);
#pragma unroll
      for (int k = 0; k < 35; ++k) { int s = smin1 - 2 + k; s = s < 0 ? 0 : (s > SEQ - 1 ? SEQ - 1 : s); un[k] = ubase[(size_t)s * INW]; }
    }
#pragma unroll
    for (int i = 0; i < 32; ++i) {
      const float xc = cbias + cw0 * uw[i] + cw1 * uw[i + 1] + cw2 * uw[i + 2] + cw3 * uw[i + 3];
      const int m = dir ? 31 - i : i;
      xcb[m * 72 + lane] = bfr(xc);
      if ((lane >> 5) == half) xcf[m * 33 + (lane & 31)] = xc;
    }
    WAVE_SYNC();
    f32x16 ga = {}, gx = {};
#pragma unroll
    for (int s = 0; s < 4; ++s) {
      const bf16x8 a = *reinterpret_cast<const bf16x8*>(xcb + r * 72 + 16 * s + 8 * h);
      ga = MFMA32(a, wa[s], ga); gx = MFMA32(a, wx[s], gx);
    }
    float av[16], hv[16], cum[16];
#pragma unroll
    for (int i = 0; i < 16; ++i) {
      const int m = crow(i, h);
      const float xv = xcf[m * 33 + r];
      const float rr = fsig(ga[i] + ba), ii = fsig(gx[i] + bx);
      const float a = __builtin_amdgcn_exp2f(-sp8l * rr);
      av[i] = a;
      hv[i] = __builtin_amdgcn_sqrtf(fmaxf(1.f - a * a, 0.f)) * (ii * xv);
    }
    float Ag[4], Bg[4];
#pragma unroll
    for (int g = 0; g < 4; ++g) {
      cum[4 * g] = av[4 * g];
#pragma unroll
      for (int j = 1; j < 4; ++j) { hv[4 * g + j] = av[4 * g + j] * hv[4 * g + j - 1] + hv[4 * g + j]; cum[4 * g + j] = cum[4 * g + j - 1] * av[4 * g + j]; }
      Ag[g] = cum[4 * g + 3]; Bg[g] = hv[4 * g + 3];
    }
    float cin0[4], pre[4];
    float cc = 0.f, pp = 1.f;
#pragma unroll
    for (int g = 0; g < 4; ++g) {
      const float oA = __shfl_xor(Ag[g], 32), oB = __shfl_xor(Bg[g], 32);
      const float A0 = h ? oA : Ag[g], B0 = h ? oB : Bg[g], A1 = h ? Ag[g] : oA, B1 = h ? Bg[g] : oB;
      const float c0 = cc, p0 = pp; cc = A0 * cc + B0; pp = A0 * pp;
      const float c1 = cc, p1 = pp; cc = A1 * cc + B1; pp = A1 * pp;
      cin0[g] = h ? c1 : c0; pre[g] = h ? p1 : p0;
    }
    if (h == 0) { exch[(wid * 32 + r) * 2] = pp; exch[(wid * 32 + r) * 2 + 1] = cc; }
    __syncthreads();
    float tc = sc, mycin = sc;
#pragma unroll
    for (int j = 0; j < 8; ++j) { const float Aj = exch[(j * 32 + r) * 2], Bj = exch[(j * 32 + r) * 2 + 1]; if (j == wid) mycin = tc; tc = Aj * tc + Bj; }
    sc = tc;
#pragma unroll
    for (int i = 0; i < 16; ++i) {
      const float hf = hv[i] + cum[i] * (cin0[i >> 2] + pre[i >> 2] * mycin);
      const int s = smap(sg0 + crow(i, h), dir);
      hout[(size_t)s * 256] = bfr(hf);
    }
    __syncthreads();
  }
}

DI void s5_wg_item(const int tix, const Params& p, int l, int item, char* smem) {
  const int wid = __builtin_amdgcn_readfirstlane(tix >> 6), lane = tix & 63, r = lane & 31, h = lane >> 5;
  const int b = item >> 5, dir = (item >> 4) & 1, g = item & 15;
  const int ldg = (l * 2 + dir) * 16 + g;
  u16* Sl = (u16*)(smem + wid * 9216);
  float* exch = (float*)(smem + 8 * 9216);
  bf16x8 bb[4], cf[4];
  const int c16 = lane & 15, kq = lane >> 4;
#pragma unroll
  for (int nt = 0; nt < 4; ++nt) bb[nt] = *reinterpret_cast<const bf16x8*>(p.bbT + ((size_t)(ldg * 2 + (nt >> 1)) * 64 + (nt & 1) * 32 + r) * 16 + 8 * h);
#pragma unroll
  for (int s = 0; s < 4; ++s) cf[s] = *reinterpret_cast<const bf16x8*>(p.cc + ((size_t)ldg * 16 + c16) * 128 + 32 * s + 8 * kq);
  float ar[2][4], ai[2][4];
  float a8r_[2], a8i_[2];
  float a32r[2], a32i[2];
#pragma unroll
  for (int st = 0; st < 2; ++st) {
    const float a_r = p.sa[((size_t)ldg * 64 + st * 32 + r) * 2], a_i = p.sa[((size_t)ldg * 64 + st * 32 + r) * 2 + 1];
    ar[st][0] = a_r; ai[st][0] = a_i;
#pragma unroll
    for (int k = 1; k < 4; ++k) { ar[st][k] = ar[st][k - 1] * a_r - ai[st][k - 1] * a_i; ai[st][k] = ar[st][k - 1] * a_i + ai[st][k - 1] * a_r; }
    const float a4r = ar[st][3], a4i = ai[st][3];
    const float a8r = a4r * a4r - a4i * a4i, a8i = 2.f * a4r * a4i;
    a8r_[st] = a8r; a8i_[st] = a8i;
    const float a16r = a8r * a8r - a8i * a8i, a16i = 2.f * a8r * a8i;
    a32r[st] = a16r * a16r - a16i * a16i; a32i[st] = 2.f * a16r * a16i;
  }
  float scr[2] = {0.f, 0.f}, sci[2] = {0.f, 0.f};
  const u16* ubase = p.pbuf + (size_t)b * SEQ * INW + C_US + g * 16 + 8 * h;
  u16* yout = p.ys + ((size_t)dir * ROWS + (size_t)b * SEQ) * 256 + g * 16 + c16;
  bf16x8 uan = *reinterpret_cast<const bf16x8*>(ubase + (size_t)smap(wid * 32 + r, dir) * INW);
  for (int st_ = 0; st_ < SEQ / 256; ++st_) {
    const int sg0 = st_ * 256 + wid * 32;
    const bf16x8 ua = uan;
    { const int sgn = (st_ + 1 < SEQ / 256) ? sg0 + 256 : sg0; uan = *reinterpret_cast<const bf16x8*>(ubase + (size_t)smap(sgn + r, dir) * INW); }
    f32x16 z16 = {};
    f32x16 sre[2], sim[2];
    sre[0] = MFMA32(ua, bb[0], z16); sre[1] = MFMA32(ua, bb[1], z16); sim[0] = MFMA32(ua, bb[2], z16); sim[1] = MFMA32(ua, bb[3], z16);
    float cinr[2][4], cini[2][4];
#pragma unroll
    for (int st = 0; st < 2; ++st) {
      const float a_r = ar[st][0], a_i = ai[st][0];
      float Er[4], Ei[4];
#pragma unroll
      for (int g4 = 0; g4 < 4; ++g4) {
#pragma unroll
        for (int j = 1; j < 4; ++j) {
          const float pr = sre[st][4 * g4 + j - 1], pi = sim[st][4 * g4 + j - 1];
          sre[st][4 * g4 + j] += a_r * pr - a_i * pi;
          sim[st][4 * g4 + j] += a_r * pi + a_i * pr;
        }
        Er[g4] = sre[st][4 * g4 + 3]; Ei[g4] = sim[st][4 * g4 + 3];
      }
      float c_r = 0.f, c_i = 0.f;
      const float a4r = ar[st][3], a4i = ai[st][3];
#pragma unroll
      for (int g4 = 0; g4 < 4; ++g4) {
        const float oEr = __shfl_xor(Er[g4], 32), oEi = __shfl_xor(Ei[g4], 32);
        const float E0r = h ? oEr : Er[g4], E0i = h ? oEi : Ei[g4], E1r = h ? Er[g4] : oEr, E1i = h ? Ei[g4] : oEi;
        const float c0r = c_r, c0i = c_i;
        float nr = a4r * c_r - a4i * c_i + E0r, ni = a4r * c_i + a4i * c_r + E0i; c_r = nr; c_i = ni;
        const float c1r = c_r, c1i = c_i;
        nr = a4r * c_r - a4i * c_i + E1r; ni = a4r * c_i + a4i * c_r + E1i; c_r = nr; c_i = ni;
        cinr[st][g4] = h ? c1r : c0r; cini[st][g4] = h ? c1i : c0i;
      }
      if (h == 0) { exch[(wid * 32 + r) * 4 + st * 2] = c_r; exch[(wid * 32 + r) * 4 + st * 2 + 1] = c_i; }
    }
    __syncthreads();
#pragma unroll
    for (int st = 0; st < 2; ++st) {
      float tr = scr[st], ti = sci[st], mr = tr, mi = ti;
#pragma unroll
      for (int j = 0; j < 8; ++j) {
        const float er = exch[(j * 32 + r) * 4 + st * 2], ei = exch[(j * 32 + r) * 4 + st * 2 + 1];
        if (j == wid) { mr = tr; mi = ti; }
        const float nr = a32r[st] * tr - a32i[st] * ti + er, ni = a32r[st] * ti + a32i[st] * tr + ei; tr = nr; ti = ni;
      }
      scr[st] = tr; sci[st] = ti;
      float qr = h ? (ar[st][3] * mr - ai[st][3] * mi) : mr, qi = h ? (ar[st][3] * mi + ai[st][3] * mr) : mi;
#pragma unroll
      for (int g4 = 0; g4 < 4; ++g4) {
        const float cr_ = cinr[st][g4] + qr, ci_ = cini[st][g4] + qi;
        { const float nq = a8r_[st] * qr - a8i_[st] * qi; qi = a8r_[st] * qi + a8i_[st] * qr; qr = nq; }
#pragma unroll
        for (int j = 0; j < 4; ++j) {
          const int i = 4 * g4 + j;
          const float vr = sre[st][i] + ar[st][j] * cr_ - ai[st][j] * ci_;
          const float vi = sim[st][i] + ar[st][j] * ci_ + ai[st][j] * cr_;
          const int m = crow(i, h);
          const unsigned w = cvtpk(vr, vi);
          Sl[m * 136 + st * 32 + r] = (u16)(w & 0xffffu);
          Sl[m * 136 + 64 + st * 32 + r] = (u16)(w >> 16);
        }
      }
    }
    WAVE_SYNC();
#pragma unroll
    for (int mt = 0; mt < 2; ++mt) {
      f32x4 y = {};
#pragma unroll
      for (int s = 0; s < 4; ++s) {
        const bf16x8 a = *reinterpret_cast<const bf16x8*>(Sl + (mt * 16 + c16) * 136 + 32 * s + 8 * kq);
        y = __builtin_amdgcn_mfma_f32_16x16x32_bf16(a, cf[s], y, 0, 0, 0);
      }
#pragma unroll
      for (int j = 0; j < 4; ++j) { const int s = smap(sg0 + mt * 16 + kq * 4 + j, dir); yout[(size_t)s * 256] = f2bf(y[j]); }
    }
    __syncthreads();
  }
}

DI void phase_mix(const int tix, const Params& p, int l, char* smem, int* s_item, int cbase = 0) {
  const int tid = tix, wid = __builtin_amdgcn_readfirstlane(tid >> 6);
#define NEXT_ITEM(cidx) if (tid == 0) *s_item = atomicAdd(&p.counters[l * 16 + cbase + (cidx)], 1); __syncthreads(); const int item = *s_item; __syncthreads();
  const int n_att = 1024 + (l == 0 ? 64 : 0);
  for (int rep = 0; rep < ((PROBE_DUP & 4) ? 2 : 1); ++rep)
  for (;;) {
    NEXT_ITEM(2 + 3 * rep); if (item >= n_att) break;
    int b, hm, q0, seq;
    if (item < 1024) { const int qb = item & 15; hm = (item >> 4) & 7; b = item >> 7; q0 = TC + qb * 256; seq = SEQ; }
    else { const int a = item - 1024; hm = a & 7; b = a >> 3; q0 = 0; seq = TC; }
    const u16* base = p.pbuf + (size_t)b * SEQ * INW;
    at::attn_body_dma(tix, base + (size_t)q0 * INW + C_Q + hm * 64, base + C_K + hm * 64, base + C_V + (hm >> 1) * 128,
                  p.obuf + ((size_t)b * SEQ + q0) * 1024 + hm * 128, seq, smem);
  }
  for (int rep = 0; rep < ((PROBE_DUP & 1) ? 2 : 1); ++rep)
  for (;;) { NEXT_ITEM(0 + 3 * rep); if (item >= 128) break; lru_wg_item(tix, p, l, item, smem); }
  for (int rep = 0; rep < ((PROBE_DUP & 2) ? 2 : 1); ++rep)
  for (;;) { NEXT_ITEM(1 + 3 * rep); if (item >= 256) break; s5_wg_item(tix, p, l, item, smem); }
#undef NEXT_ITEM
}

DI void unpack8(const bf16x8 v, float* f) {
#pragma unroll
  for (int k = 0; k < 8; ++k) f[k] = bf2f((u16)v[k]);
}
DI bf16x8 pack8(const float* f) {
  u32x4 w = {cvtpk(f[0], f[1]), cvtpk(f[2], f[3]), cvtpk(f[4], f[5]), cvtpk(f[6], f[7])};
  return *reinterpret_cast<bf16x8*>(&w);
}
DI void phase_combine(const int tix, const Params& p, int l, char* smem, int* s_item) {
  const int tid = tix, wid = tid >> 6, lane = tid & 63, r = lane & 31, h = lane >> 5;
  const bool dyn = (l == 0);
  int* ctr = p.counters + l * 16 + 8;
  if (dyn && blockIdx.x < 32) {
    if (tid == 0) {
      unsigned sp = 0;
      while (__hip_atomic_load(&ctr[1], __ATOMIC_RELAXED, __HIP_MEMORY_SCOPE_AGENT) < 64) { __builtin_amdgcn_s_sleep(4); if (++sp > (1u << 22)) break; }
      __threadfence();
    }
    __syncthreads();
    pg::gemm_stream(tix, (PG_LAS unsigned char*)smem, p.nbuf, p.woutT, pg::Sched{3, 4, (int)gridDim.x, (int)blockIdx.x}, pg::EpiOut{p, 0});
    __syncthreads();
  }
  float* zf = (float*)smem;
  u16* zb = (u16*)(smem + 32 * 260 * 4);
  const float lam = p.lamv[l], onem = 1.f - p.lamv[2 + l];
  bf16x8 wg[16];
  { const u16* wt = p.wgluT + (size_t)l * 65536 + (size_t)(wid * 32 + r) * 256 + 8 * h;
#pragma unroll
    for (int s = 0; s < 16; ++s) wg[s] = *reinterpret_cast<const bf16x8*>(wt + 16 * s); }
  const float bglu = p.s5_b_glu[l * 256 + wid * 32 + r];
  const size_t DSTRIDE = (size_t)ROWS * 256;
  for (int it = 0;; ++it) {
    int item, q = 0;
    if (dyn) {
      if (tid == 0) *s_item = atomicAdd(&ctr[0], 1);
      __syncthreads(); q = *s_item; __syncthreads();
      if (q >= ROWS / 32) break;
      if (q < 64) item = (q >> 3) * 136 + (q & 7); else { const int e = q - 64; item = (e >> 7) * 136 + 8 + (e & 127); }
    } else { item = blockIdx.x + it * gridDim.x; if (item >= ROWS / 32) break; }
    const int row0 = item * 32;
    if (l == 1 && (row0 % SEQ) < TC) continue;
    bf16x8 lh0[2], lh1[2], ly0[2], ly1[2], lga[2], lus[2]; f32x4 ld0[2], ld1[2];
#pragma unroll
    for (int i = 0; i < 2; ++i) {
      const int id = tid + NTHR * i, rr = id >> 5, c8 = (id & 31) * 8; const size_t row = row0 + rr;
      const u16* pr = p.pbuf + row * INW;
      lh0[i] = *reinterpret_cast<const bf16x8*>(p.hl + row * 256 + c8); lh1[i] = *reinterpret_cast<const bf16x8*>(p.hl + DSTRIDE + row * 256 + c8);
      ly0[i] = *reinterpret_cast<const bf16x8*>(p.ys + row * 256 + c8); ly1[i] = *reinterpret_cast<const bf16x8*>(p.ys + DSTRIDE + row * 256 + c8);
      lga[i] = *reinterpret_cast<const bf16x8*>(pr + C_GA + c8); lus[i] = *reinterpret_cast<const bf16x8*>(pr + C_US + c8);
      ld0[i] = *reinterpret_cast<const f32x4*>(p.s5_d + l * 256 + c8); ld1[i] = *reinterpret_cast<const f32x4*>(p.s5_d + l * 256 + c8 + 4);
    }
    asm volatile("" ::: "memory");
#pragma unroll
    for (int i = 0; i < 2; ++i) {
      const int id = tid + NTHR * i, rr = id >> 5, c8 = (id & 31) * 8; const size_t row = row0 + rr;
      float h0[8], h1[8], y0[8], y1[8], ga[8], us[8], o[8], z[8];
      unpack8(lh0[i], h0); unpack8(lh1[i], h1); unpack8(ly0[i], y0); unpack8(ly1[i], y1); unpack8(lga[i], ga); unpack8(lus[i], us);
      const f32x4 d0 = ld0[i], d1 = ld1[i];
#pragma unroll
      for (int k = 0; k < 8; ++k) {
        o[k] = (h0[k] + h1[k]) * silu_f(ga[k]);
        z[k] = gelu_tanh((k < 4 ? d0[k] : d1[k - 4]) * us[k] + y0[k] + y1[k]);
      }
      *reinterpret_cast<bf16x8*>(p.nbuf + row * 1024 + c8) = pack8(o);
      *reinterpret_cast<f32x4*>(zf + rr * 260 + c8) = f32x4{z[0], z[1], z[2], z[3]};
      *reinterpret_cast<f32x4*>(zf + rr * 260 + c8 + 4) = f32x4{z[4], z[5], z[6], z[7]};
      *reinterpret_cast<bf16x8*>(zb + rr * 264 + c8) = pack8(z);
    }
    bf16x8 lgs[2], lo1[4], lo2[4], lgd[4];
#pragma unroll
    for (int i = 0; i < 2; ++i) { const int id = tid + NTHR * i, rr = id >> 5, c8 = (id & 31) * 8; lgs[i] = *reinterpret_cast<const bf16x8*>(p.pbuf + (size_t)(row0 + rr) * INW + C_GS + c8); }
#pragma unroll
    for (int it = 0; it < 4; ++it) {
      const int pair = (tid >> 4) + 32 * it, rr = pair >> 2, head = pair & 3, e8 = (tid & 15) * 8; const size_t row = row0 + rr;
      lo1[it] = *reinterpret_cast<const bf16x8*>(p.obuf + row * 1024 + head * 256 + e8);
      lo2[it] = *reinterpret_cast<const bf16x8*>(p.obuf + row * 1024 + head * 256 + 128 + e8);
      lgd[it] = *reinterpret_cast<const bf16x8*>(p.pbuf + row * INW + C_GD + head * 128 + e8);
    }
    const f32x4 nn0 = *reinterpret_cast<const f32x4*>(p.da_norm_g + l * 128 + (tid & 15) * 8), nn1 = *reinterpret_cast<const f32x4*>(p.da_norm_g + l * 128 + (tid & 15) * 8 + 4);
    asm volatile("" ::: "memory");
    __syncthreads();
    f32x16 acc = {};
#pragma unroll
    for (int s = 0; s < 16; ++s) {
      const bf16x8 a = *reinterpret_cast<const bf16x8*>(zb + r * 264 + 16 * s + 8 * h);
      acc = MFMA32(a, wg[s], acc);
    }
#pragma unroll
    for (int i = 0; i < 16; ++i) {
      const int m = crow(i, h), col = wid * 32 + r;
      const float zz = zf[m * 260 + col];
      zf[m * 260 + col] = zz * sigmoid_f(acc[i] + bglu);
    }
    __syncthreads();
#pragma unroll
    for (int i = 0; i < 2; ++i) {
      const int id = tid + NTHR * i, rr = id >> 5, c8 = (id & 31) * 8; const size_t row = row0 + rr;
      float gs[8], o[8];
      unpack8(lgs[i], gs);
      const f32x4 g0 = *reinterpret_cast<const f32x4*>(zf + rr * 260 + c8), g1 = *reinterpret_cast<const f32x4*>(zf + rr * 260 + c8 + 4);
#pragma unroll
      for (int k = 0; k < 8; ++k) o[k] = (k < 4 ? g0[k] : g1[k - 4]) * silu_f(gs[k]);
      *reinterpret_cast<bf16x8*>(p.nbuf + row * 1024 + 256 + c8) = pack8(o);
    }
#pragma unroll
    for (int it = 0; it < 4; ++it) {
      const int pair = (tid >> 4) + 32 * it, rr = pair >> 2, head = pair & 3, e8 = (tid & 15) * 8; const size_t row = row0 + rr;
      float o1[8], o2[8], gd[8], v[8], o[8];
      unpack8(lo1[it], o1); unpack8(lo2[it], o2); unpack8(lgd[it], gd);
      const f32x4 n0 = nn0, n1 = nn1;
      float ss = 0.f;
#pragma unroll
      for (int k = 0; k < 8; ++k) { v[k] = o1[k] - lam * o2[k]; ss += v[k] * v[k]; }
      ss += __shfl_xor(ss, 1); ss += __shfl_xor(ss, 2); ss += __shfl_xor(ss, 4); ss += __shfl_xor(ss, 8);
      const float rinv = rsqrtf(ss * (1.f / 128.f) + EPS) * onem;
#pragma unroll
      for (int k = 0; k < 8; ++k) o[k] = v[k] * rinv * (k < 4 ? n0[k] : n1[k - 4]) * silu_f(gd[k]);
      *reinterpret_cast<bf16x8*>(p.nbuf + row * 1024 + 512 + head * 128 + e8) = pack8(o);
    }
    if (dyn && q < 64) asm volatile("s_waitcnt vmcnt(0)" ::: "memory");
    __syncthreads();
    if (dyn && q < 64 && tid == 0) { __threadfence(); __hip_atomic_fetch_add(&ctr[1], 1, __ATOMIC_RELAXED, __HIP_MEMORY_SCOPE_AGENT); }
  }
}

DI void phase_final(const int tix, const Params& p) {
  const int wid = tix >> 6, lane = tix & 63;
  f32x4 gg[4];
#pragma unroll
  for (int i = 0; i < 4; ++i) gg[i] = *(const f32x4*)(p.final_g + i * 256 + lane * 4);
  for (int row = blockIdx.x * 8 + wid; row < NB * TL; row += gridDim.x * 8) {
    float* src = p.out + (size_t)row * 1024;
    f32x4 v[4]; float ss = 0.f;
#pragma unroll
    for (int i = 0; i < 4; ++i) v[i] = *(const f32x4*)(src + i * 256 + lane * 4);
#pragma unroll
    for (int i = 0; i < 4; ++i) ss += v[i][0] * v[i][0] + v[i][1] * v[i][1] + v[i][2] * v[i][2] + v[i][3] * v[i][3];
    ss = wave_sum(ss);
    const float r = rsqrtf(ss * (1.f / 1024.f) + EPS);
#pragma unroll
    for (int i = 0; i < 4; ++i) {
      f32x4 o = {v[i][0] * r * gg[i][0], v[i][1] * r * gg[i][1], v[i][2] * r * gg[i][2], v[i][3] * r * gg[i][3]};
      *(f32x4*)(src + i * 256 + lane * 4) = o;
    }
  }
}

#define XB_TMO      128
#define XB_XCNT(j)  (256  + 64 * (j))
#define XB_XSUB(j)  (1280 + 64 * (j))
#define XB_XGEN(j)  (2304 + 64 * (j))
#define XB_TOP      3328
#define XB_TOPGEN   3392
#define XCD_BAR_WORDS 3456
#define XB_SPIN_CAP (1u << 18)
#define LAS __attribute__((address_space(3)))
DI unsigned xb_ld(unsigned* p)              { return __hip_atomic_load(p, __ATOMIC_RELAXED, __HIP_MEMORY_SCOPE_AGENT); }
DI unsigned xb_add(unsigned* p, unsigned v) { return __hip_atomic_fetch_add(p, v, __ATOMIC_RELAXED, __HIP_MEMORY_SCOPE_AGENT); }
DI unsigned xb_xcc_id() { return (unsigned)__builtin_amdgcn_s_getreg((3 << 11) | 20) & 0xFu; }
#define XB_SPIN(cond, bar) do { unsigned _sp = 0; while (cond) { __builtin_amdgcn_s_sleep(1); \
    if ((++_sp & 255u) == 0u) { if (xb_ld(&(bar)[XB_TMO])) break; if (_sp > XB_SPIN_CAP) { atomicAdd(&(bar)[XB_TMO], 1u); break; } } } } while (0)
struct XcdBarrier { unsigned* bar; unsigned x; volatile LAS unsigned* st; };
DI XcdBarrier xcd_barrier_post(int tid, unsigned* bar, volatile LAS unsigned* st) {
  XcdBarrier b; b.bar = bar; b.x = xb_xcc_id(); b.st = st;
  if (tid == 0) (void)xb_add(&bar[XB_XCNT(b.x)], 1u);
  return b;
}
DI void xcd_barrier_complete(unsigned* bar, unsigned x, unsigned& nloc, unsigned& nx) {
  const unsigned G = gridDim.x;
  unsigned sum, cnt, mine, sp = 0u;
  for (;;) {
    sum = 0u; cnt = 0u; mine = 0u;
#pragma unroll
    for (unsigned j = 0; j < 16; ++j) { const unsigned c = xb_ld(&bar[XB_XCNT(j)]); sum += c; cnt += (c > 0u) ? 1u : 0u; mine = (j == x) ? c : mine; }
    if (sum == G) break;
    __builtin_amdgcn_s_sleep(1);
    if ((++sp & 255u) == 0u) { if (xb_ld(&bar[XB_TMO])) break; if (sp > XB_SPIN_CAP) { atomicAdd(&bar[XB_TMO], 1u); break; } }
  }
  nloc = mine > 0u ? mine : 1u; nx = cnt > 0u ? cnt : 1u;
}
DI void xcd_barrier(int tid, const XcdBarrier& b) {
  asm volatile("s_waitcnt vmcnt(0)" ::: "memory");
  __syncthreads();
  if (tid == 0) {
    unsigned* bar = b.bar;
    __builtin_amdgcn_s_waitcnt(0);
    unsigned nloc = b.st[0], nx = b.st[1];
    if (nloc == 0u) { xcd_barrier_complete(bar, b.x, nloc, nx); b.st[0] = nloc; b.st[1] = nx; }
    const unsigned old = xb_add(&bar[XB_XSUB(b.x)], 1u);
    const unsigned gen = old / nloc;
    if (old + 1u == (gen + 1u) * nloc) {
      __builtin_amdgcn_fence(__ATOMIC_RELEASE, "agent");
      asm volatile("s_waitcnt vmcnt(0)" ::: "memory");
      const unsigned og = xb_add(&bar[XB_TOP], 1u);
      const unsigned tg = og / nx;
      if (og + 1u == (tg + 1u) * nx) xb_add(&bar[XB_TOPGEN], 1u);
      else XB_SPIN(xb_ld(&bar[XB_TOPGEN]) == tg, bar);
      __builtin_amdgcn_fence(__ATOMIC_ACQUIRE, "agent");
      xb_add(&bar[XB_XGEN(b.x)], 1u);
      asm volatile("s_waitcnt vmcnt(0)" ::: "memory");
    } else {
      XB_SPIN(xb_ld(&bar[XB_XGEN(b.x)]) == gen, bar);
      __builtin_amdgcn_fence(__ATOMIC_ACQUIRE, "agent");
      asm volatile("s_waitcnt vmcnt(0)" ::: "memory");
    }
  }
  __syncthreads();
}

#if MULTI
template <int K> __global__ void __launch_bounds__(NTHR) phase_kernel(Params p, int ph) {
  extern __shared__ __attribute__((aligned(16))) char smem[];
  __shared__ int s_item;
  const int wid_s = __builtin_amdgcn_readfirstlane((int)__builtin_amdgcn_workitem_id_x() >> 6);
  const int l = (ph - 1) / 5;
  if (K == 0) { phase_prep(tid_opaque(wid_s), p, smem, 0); phase_prep(tid_opaque(wid_s), p, smem, 1); }
  else if (K == 6) phase_final(tid_opaque(wid_s), p);
  else if (K == 1) phase_norm(tid_opaque(wid_s), p, l);
  else if (K == 2) gm::gemm_phase<0>(tid_opaque(wid_s), p, l, p.nbuf, p.winT + (size_t)l * 3072 * 1024, 12, smem);
  else if (K == 3) phase_mix(tid_opaque(wid_s), p, l, smem, &s_item);
  else if (K == 4) phase_combine(tid_opaque(wid_s), p, l, smem, &s_item);
  else gm::gemm_phase<1>(tid_opaque(wid_s), p, l, p.nbuf, p.woutT + (size_t)l * 1024 * 1024, 4, smem);
}
template <int K> static void launch_phase(const Params& p, int ph, hipStream_t stream) {
  (void)hipFuncSetAttribute((const void*)phase_kernel<K>, hipFuncAttributeMaxDynamicSharedMemorySize, LDS_BYTES);
  hipLaunchKernelGGL(phase_kernel<K>, dim3(256), dim3(NTHR), LDS_BYTES, stream, p, ph);
}
#else
__global__ void __launch_bounds__(NTHR) mega_kernel(Params p) {
  extern __shared__ __attribute__((aligned(16))) char smem[];
  __shared__ uint4 sh_words;
  int* s_item = (int*)&sh_words;
  const int wid_s = __builtin_amdgcn_readfirstlane((int)__builtin_amdgcn_workitem_id_x() >> 6);
  cg::grid_group grid = cg::this_grid();
  if (tid_opaque(wid_s) == 0) sh_words = make_uint4(0u, 0u, 0u, 0u);
  __syncthreads();
  XcdBarrier xb = xcd_barrier_post(tid_opaque(wid_s), p.xbar, (volatile LAS unsigned*)((unsigned*)&sh_words + 2));
#define GSYNC() xcd_barrier(tid_opaque(wid_s), xb)
  for (int rep = 0; rep < ((PROBE_DUP & 64) ? 2 : 1); ++rep) { phase_prep(tid_opaque(wid_s), p, smem, 0); grid.sync(); phase_prep(tid_opaque(wid_s), p, smem, 1); }
  for (int l = 0; l < 2; ++l) {
    for (int rep = 0; rep < ((PROBE_DUP & 8) ? 2 : 1); ++rep) { phase_norm(tid_opaque(wid_s), p, l); GSYNC(); }
    for (int rep = 0; rep < ((PROBE_DUP & 16) ? 2 : 1); ++rep) { pg::gemm_stream(tid_opaque(wid_s), (PG_LAS unsigned char*)smem, p.nbuf, p.winT + (size_t)l * 3072 * 1024, pg::Sched{l == 0 ? 0 : 2, 12, (int)gridDim.x, (int)blockIdx.x}, pg::EpiIn{p, l}); GSYNC(); }
    for (int rep = 0; rep < ((PROBE_DUP & 128) ? 2 : 1); ++rep) { phase_mix(tid_opaque(wid_s), p, l, smem, s_item, rep * 3); GSYNC(); }
    for (int rep = 0; rep < ((PROBE_DUP & 32) ? 2 : 1); ++rep) { phase_combine(tid_opaque(wid_s), p, l, smem, s_item); GSYNC(); }
    for (int rep = 0; rep < (((PROBE_DUP & 256) && l == 0) ? 2 : 1); ++rep) { pg::gemm_stream(tid_opaque(wid_s), (PG_LAS unsigned char*)smem, p.nbuf, p.woutT + (size_t)l * 1024 * 1024, pg::Sched{1, 4, (int)gridDim.x, (int)blockIdx.x}, pg::EpiOut{p, l}); GSYNC(); }
  }
  phase_final(tid_opaque(wid_s), p);
#undef GSYNC
}
#endif

extern "C" void kernel_launch(void* const* d_in, const int* in_sizes, int n_in, void* d_out, int out_size, void* d_ws, size_t ws_size, hipStream_t stream) {
  Params p{};
  const float** pf = (const float**)&p;
  for (int i = 0; i < 29; ++i) pf[i] = (const float*)d_in[i];
  p.out = (float*)d_out;
  char* w = (char*)d_ws; size_t off = 0;
  auto take = [&](size_t bytes) { char* r = w + off; off += (bytes + 255) & ~(size_t)255; return r; };
  p.nbuf = (u16*)take((size_t)ROWS * 1024 * 2);
  p.pbuf = (u16*)take((size_t)ROWS * INW * 2);
  p.hl = (u16*)take((size_t)2 * ROWS * 256 * 2);
  p.ys = (u16*)take((size_t)2 * ROWS * 256 * 2);
  p.obuf = (u16*)take((size_t)ROWS * 1024 * 2);
  p.winT = (u16*)take((size_t)2 * 3072 * 1024 * 2);
  p.woutT = (u16*)take((size_t)2 * 1024 * 1024 * 2);
  p.wgluT = (u16*)take((size_t)2 * 65536 * 2);
  p.bbT = (u16*)take((size_t)64 * 2 * 64 * 16 * 2);
  p.cc = (u16*)take((size_t)131072 * 2);
  p.lruWT = (u16*)take((size_t)32 * 4096 * 2);
  p.hc = (float*)take((size_t)NB * TC * 1024 * 4);
  p.mod = (float*)take((size_t)2 * 9 * 3072 * 4);
  p.sa = (float*)take((size_t)4096 * 2 * 4);
  p.rope = (float*)take((size_t)2048 * 4);
  p.lamv = (float*)take(256);
  p.counters = (int*)take(256);
  p.xbar = (unsigned*)take((size_t)XCD_BAR_WORDS * 4);
  if (off > ws_size) { fprintf(stderr, "kernel_launch: workspace too small: need %zu have %zu\n", off, ws_size); return; }
#if MULTI
  launch_phase<0>(p, 0, stream);
  for (int l = 0; l < 2; ++l) {
    launch_phase<1>(p, 1 + 5 * l, stream); launch_phase<2>(p, 2 + 5 * l, stream); launch_phase<3>(p, 3 + 5 * l, stream);
    launch_phase<4>(p, 4 + 5 * l, stream); launch_phase<5>(p, 5 + 5 * l, stream);
  }
  launch_phase<6>(p, 11, stream);
#else
  static int grid_blocks = 0;
  if (!grid_blocks) {
    int dev = 0, cus = 0, per_cu = 0;
    hipGetDevice(&dev);
    hipDeviceGetAttribute(&cus, hipDeviceAttributeMultiprocessorCount, dev);
    hipFuncSetAttribute((const void*)mega_kernel, hipFuncAttributeMaxDynamicSharedMemorySize, LDS_BYTES);
    hipOccupancyMaxActiveBlocksPerMultiprocessor(&per_cu, (const void*)mega_kernel, NTHR, LDS_BYTES);
    if (per_cu < 1) per_cu = 1;
    grid_blocks = cus * per_cu;
  }
  (void)hipMemsetAsync(p.xbar, 0, (size_t)XCD_BAR_WORDS * 4, stream);
  void* args[] = {&p};
  hipError_t e = hipLaunchCooperativeKernel((const void*)mega_kernel, dim3(grid_blocks), dim3(NTHR), args, LDS_BYTES, stream);
  if (e != hipSuccess) fprintf(stderr, "cooperative launch failed: %s (grid %d)\n", hipGetErrorString(e), grid_blocks);
#endif
}
```

```cpp
#include <hip/hip_runtime.h>
#include <hip/hip_bf16.h>
#include <hip/hip_cooperative_groups.h>
#include <cstdio>
#include <cstdint>
namespace cg = cooperative_groups;

#ifndef MULTI
#define MULTI 0
#endif
#ifndef PROBE_DUP
#define PROBE_DUP 0
#endif
#ifndef STAGGER_US
#define STAGGER_US 0
#endif

#define DI __device__ __forceinline__
typedef unsigned short u16;
using bf16x8 = __attribute__((ext_vector_type(8))) short;
using s16x4  = __attribute__((ext_vector_type(4))) short;
using f32x4  = __attribute__((ext_vector_type(4))) float;
using f32x16 = __attribute__((ext_vector_type(16))) float;
using u32x4  = __attribute__((ext_vector_type(4))) unsigned;

constexpr int NB = 8, TL = 4096, DM = 1024, TC = 256, SEQ = TC + TL, ROWS = NB * SEQ;
constexpr int INW = 3072;
constexpr int C_UA = 0, C_US = 256, C_K = 512, C_V = 1024, C_GA = 1536, C_GS = 1792, C_Q = 2048, C_GD = 2560;
constexpr int NTHR = 512;
constexpr int LDS_BYTES = 131072;
constexpr float EPS = 1e-6f;

struct Params {
  const float *x, *c, *ctx, *c_ctx, *norm_g, *w_mod, *b_mod, *w_in, *w_out, *conv_w, *conv_b, *lru_wa, *lru_ba, *lru_wx, *lru_bx, *lru_lam,
      *s5_lam_re, *s5_lam_im, *s5_log_dt, *s5_b_re, *s5_b_im, *s5_c_re, *s5_c_im, *s5_d, *s5_w_glu, *s5_b_glu, *da_lam, *da_norm_g, *final_g;
  float* out;
  u16 *nbuf, *pbuf, *hl, *ys, *obuf, *winT, *woutT, *wgluT, *bbT, *cc, *lruWT;
  float *hc, *mod, *sa, *rope, *lamv;
  int* counters;
  unsigned* xbar;
};

DI float bf2f(u16 u) { return __uint_as_float(((unsigned)u) << 16); }
DI u16 f2bf(float x) { unsigned u = __float_as_uint(x); u += 0x7fffu + ((u >> 16) & 1u); return (u16)(u >> 16); }
DI float sigmoid_f(float v) { return 1.f / (1.f + __expf(-v)); }
DI float silu_f(float v) { return v / (1.f + __expf(-v)); }
DI float gelu_tanh(float y) { float u = 0.7978845608028654f * (y + 0.044715f * y * y * y); float t = 1.f - 2.f / (__expf(2.f * u) + 1.f); return 0.5f * y * (1.f + t); }
DI int crow(int r, int hi) { return (r & 3) + 8 * (r >> 2) + 4 * hi; }
DI unsigned cvtpk(float lo, float hi) { unsigned r; asm volatile("v_cvt_pk_bf16_f32 %0, %1, %2" : "=v"(r) : "v"(lo), "v"(hi)); return r; }
DI float wave_sum(float v) { for (int o = 32; o > 0; o >>= 1) v += __shfl_xor(v, o); return v; }
DI int tid_opaque(int wid_s) { int t; asm volatile("v_mbcnt_lo_u32_b32 %0, -1, 0\n\tv_mbcnt_hi_u32_b32 %0, -1, %0" : "=v"(t)); return (wid_s << 6) + t; }
#define MFMA32(a, b, c) __builtin_amdgcn_mfma_f32_32x32x16_bf16((a), (b), (c), 0, 0, 0)

DI void transpose_job(const int tix, const float* __restrict__ src, u16* __restrict__ dst, int K, int N, int kt, int nt, float* lds) {
  const int tid = tix, c = tid & 63, r0 = tid >> 6;
  for (int i = 0; i < 8; ++i) { int r = r0 + 8 * i; lds[r * 65 + c] = src[(size_t)(kt * 64 + r) * N + nt * 64 + c]; }
  __syncthreads();
  for (int i = 0; i < 8; ++i) { int r = r0 + 8 * i; dst[(size_t)(nt * 64 + r) * K + kt * 64 + c] = f2bf(lds[c * 65 + r]); }
  __syncthreads();
}

DI void mod_job(const int tix, const Params& p, int job, float* lds) {
  const int tid = tix;
  const int l = job / 96, cb = (job % 96) * 32;
  for (int i = tid; i < 9 * 1024; i += NTHR) { float v = i < 8192 ? p.c[i] : p.c_ctx[i - 8192]; lds[i] = silu_f(v); }
  __syncthreads();
  const int col = tid & 31, kg = tid >> 5;
  float acc[9];
#pragma unroll
  for (int r = 0; r < 9; ++r) acc[r] = 0.f;
#pragma unroll 16
  for (int k = kg * 64; k < kg * 64 + 64; ++k) {
    float w = p.w_mod[((size_t)l * 1024 + k) * 3072 + cb + col];
#pragma unroll
    for (int r = 0; r < 9; ++r) acc[r] += lds[r * 1024 + k] * w;
  }
  float* red = lds + 9 * 1024;
#pragma unroll
  for (int r = 0; r < 9; ++r) red[(kg * 9 + r) * 32 + col] = acc[r];
  __syncthreads();
  if (tid < 288) {
    int r = tid >> 5, c2 = tid & 31; float s = p.b_mod[l * 3072 + cb + c2];
    for (int g = 0; g < 16; ++g) s += red[(g * 9 + r) * 32 + c2];
    p.mod[(l * 9 + r) * 3072 + cb + c2] = s;
  }
  __syncthreads();
}

DI void phase_prep(const int tix, const Params& p, char* smem, int part) {
  float* lds = (float*)smem;
  constexpr int J_WIN = 2 * 16 * 48, J_WOUT = 2 * 16 * 16, J_GLU = 2 * 4 * 4, J_LRU = 32, J_MOD = 192;
  constexpr int JT = J_WIN + J_WOUT + J_GLU + J_LRU + J_MOD;
  const int jlo = part == 0 ? JT - J_MOD : 0, jhi = part == 0 ? JT : JT - J_MOD;
  for (int job = jlo + blockIdx.x; job < jhi; job += gridDim.x) {
    int j = job;
    if (j < J_WIN) { int l = j / 768, r = j % 768; transpose_job(tix, p.w_in + (size_t)l * 1024 * 3072, p.winT + (size_t)l * 3072 * 1024, 1024, 3072, r / 48, r % 48, lds); continue; }
    j -= J_WIN;
    if (j < J_WOUT) { int l = j / 256, r = j % 256; transpose_job(tix, p.w_out + (size_t)l * 1024 * 1024, p.woutT + (size_t)l * 1024 * 1024, 1024, 1024, r / 16, r % 16, lds); continue; }
    j -= J_WOUT;
    if (j < J_GLU) { int l = j / 16, r = j % 16; transpose_job(tix, p.s5_w_glu + (size_t)l * 65536, p.wgluT + (size_t)l * 65536, 256, 256, r / 4, r % 4, lds); continue; }
    j -= J_GLU;
    if (j < J_LRU) { int m = j >> 1, gate = j & 1;
      transpose_job(tix, (gate ? p.lru_wx : p.lru_wa) + (size_t)m * 4096, p.lruWT + (size_t)(m * 2 + gate) * 4096, 64, 64, 0, 0, lds); continue; }
    j -= J_LRU;
    mod_job(tix, p, j, lds);
  }
  if (part != 0) return;
  const int gtid = blockIdx.x * NTHR + tix, gsz = gridDim.x * NTHR;
  constexpr int N_S5 = 4096, N_CC = 131072, N_ROPE = 1024;
  for (int i = gtid; i < N_S5 + N_CC + N_ROPE + 4; i += gsz) {
    if (i < N_S5) {
      const int idx = i, ldg = idx >> 6, pp = idx & 63;
      float lr = p.s5_lam_re[idx], li = p.s5_lam_im[idx], dt = expf(p.s5_log_dt[ldg]);
      float mag = expf(lr * dt), ang = li * dt, sn = sinf(ang), cs = cosf(ang);
      float abr = mag * cs, abi = mag * sn, nr = abr - 1.f, ni = abi, den = lr * lr + li * li;
      float cfr = (nr * lr + ni * li) / den, cfi = (ni * lr - nr * li) / den;
      p.sa[idx * 2] = abr; p.sa[idx * 2 + 1] = abi;
      for (int h = 0; h < 16; ++h) {
        float br = p.s5_b_re[idx * 16 + h], bi = p.s5_b_im[idx * 16 + h];
        p.bbT[((size_t)(ldg * 2 + 0) * 64 + pp) * 16 + h] = f2bf(cfr * br - cfi * bi);
        p.bbT[((size_t)(ldg * 2 + 1) * 64 + pp) * 16 + h] = f2bf(cfr * bi + cfi * br);
      }
    } else if (i < N_S5 + N_CC) {
      const int e = i - N_S5, k = e & 127, lc = e >> 7;
      float v = k < 64 ? p.s5_c_re[lc * 64 + k] : -p.s5_c_im[lc * 64 + (k - 64)];
      p.cc[e] = f2bf(v);
    } else if (i < N_S5 + N_CC + N_ROPE) {
      const int e = i - N_S5 - N_CC, pos = e >> 4, f = e & 15;
      float inv = expf(-9.210340371976184f * (float)f / 16.f), ang = (float)pos * inv;
      p.rope[e] = cosf(ang); p.rope[1024 + e] = sinf(ang);
    } else {
      const int e = i - N_S5 - N_CC - N_ROPE;
      if (e < 2) {
        const int l = e; const float* dl = p.da_lam + l * 256;
        float s0 = 0.f, s1 = 0.f;
        for (int k = 0; k < 64; ++k) { s0 += dl[k] * dl[64 + k]; s1 += dl[128 + k] * dl[192 + k]; }
        float lam_init = 0.8f - 0.6f * expf(-0.3f * (float)l);
        p.lamv[l] = expf(s0) - expf(s1) + lam_init; p.lamv[2 + l] = lam_init;
      } else { for (int k = 0; k < 16; ++k) p.counters[(e - 2) * 16 + k] = 0; }
    }
  }
}

DI void phase_norm(const int tix, const Params& p, int l) {
  const int wid = tix >> 6, lane = tix & 63;
  const float* g = p.norm_g + l * 1024;
  for (int row = blockIdx.x * 8 + wid; row < ROWS; row += gridDim.x * 8) {
    const int b = row / SEQ, s = row % SEQ;
    const float* src; int mrow;
    if (s < TC) { src = (l == 0 ? p.ctx : p.hc) + ((size_t)b * TC + s) * 1024; mrow = 8; }
    else { src = (l == 0 ? p.x : p.out) + ((size_t)b * TL + (s - TC)) * 1024; mrow = b; }
    const float* md = p.mod + (l * 9 + mrow) * 3072;
    f32x4 v[4], gg[4], sh[4], sc[4]; float ss = 0.f;
#pragma unroll
    for (int i = 0; i < 4; ++i) { const int c0 = i * 256 + lane * 4; v[i] = *(const f32x4*)(src + c0); gg[i] = *(const f32x4*)(g + c0); sh[i] = *(const f32x4*)(md + c0); sc[i] = *(const f32x4*)(md + 1024 + c0); }
#pragma unroll
    for (int i = 0; i < 4; ++i) ss += v[i][0] * v[i][0] + v[i][1] * v[i][1] + v[i][2] * v[i][2] + v[i][3] * v[i][3];
    ss = wave_sum(ss);
    const float r = rsqrtf(ss * (1.f / 1024.f) + EPS);
#pragma unroll
    for (int i = 0; i < 4; ++i) {
      const int c0 = i * 256 + lane * 4;
      float o0 = v[i][0] * r * gg[i][0] * (1.f + sc[i][0]) + sh[i][0], o1 = v[i][1] * r * gg[i][1] * (1.f + sc[i][1]) + sh[i][1];
      float o2 = v[i][2] * r * gg[i][2] * (1.f + sc[i][2]) + sh[i][2], o3 = v[i][3] * r * gg[i][3] * (1.f + sc[i][3]) + sh[i][3];
      uint2 w; w.x = cvtpk(o0, o1); w.y = cvtpk(o2, o3);
      *(uint2*)(p.nbuf + (size_t)row * 1024 + c0) = w;
    }
  }
}

namespace gm {
constexpr int BM = 256, BK = 64, HALF = 128, NXCD = 8, WGM = 8, HT = HALF * BK, KD = 1024;
DI int lds_byte(int r, int c) { int st = (r >> 4) * 2 + (c >> 5), rr = r & 15, cc = c & 31, ob = rr * 64 + cc * 2; return st * 1024 + (ob ^ (((ob >> 9) & 1) << 5)); }
DI void stage_rc(int b, int& R, int& C) { int st = b / 1024, sb = b % 1024, swz = sb ^ (((sb >> 9) & 1) << 5); R = (st >> 1) * 16 + swz / 64; C = (st & 1) * 32 + (swz % 64) / 2; }

template <int MODE>
DI void gemm_tile(const int tix, const Params& p, int l, const u16* __restrict__ A, const u16* __restrict__ Bt, int brow, int bcol, u16* shm) {
  constexpr int K = KD;
#define SA(b, h) (shm + ((b) * 2 + (h)) * HT)
#define SB(b, h) (shm + (4 + (b) * 2 + (h)) * HT)
#define STAGE(P, BASE, br, kt) do { const u16* _gp = (BASE) + ((long)(br) * K + (long)(kt) * BK); \
      __builtin_amdgcn_global_load_lds((const unsigned*)(_gp + voff0), (__attribute__((address_space(3))) unsigned*)((char*)(P) + wbase), 16, 0, 0); \
      __builtin_amdgcn_global_load_lds((const unsigned*)(_gp + voff1), (__attribute__((address_space(3))) unsigned*)((char*)(P) + wbase + 8192), 16, 0, 0); } while (0)
#define LDA(dst, b, h) for (int m = 0; m < 4; ++m) for (int k = 0; k < 2; ++k) \
    dst[m][k] = *reinterpret_cast<const bf16x8*>((char*)SA(b, h) + lds_byte(wr * 64 + m * 16 + fr, k * 32 + fq * 8))
#define LDB(dst, b, h) for (int n = 0; n < 2; ++n) for (int k = 0; k < 2; ++k) \
    dst[n][k] = *reinterpret_cast<const bf16x8*>((char*)SB(b, h) + lds_byte(wc * 32 + n * 16 + fr, k * 32 + fq * 8))
#define MMA(ai, bj, At, Bt_) do { __builtin_amdgcn_s_setprio(1); \
    for (int m = 0; m < 4; ++m) for (int n = 0; n < 2; ++n) for (int k = 0; k < 2; ++k) \
      acc[ai][bj][m][n] = __builtin_amdgcn_mfma_f32_16x16x32_bf16(Bt_[n][k], At[m][k], acc[ai][bj][m][n], 0, 0, 0); \
    __builtin_amdgcn_s_setprio(0); } while (0)
#define WAIT_V(n) asm volatile("s_waitcnt vmcnt(" #n ")" ::: "memory")
#define WAIT_L(n) asm volatile("s_waitcnt lgkmcnt(" #n ")" ::: "memory")
#define BAR __builtin_amdgcn_s_barrier()
#define SCHED __builtin_amdgcn_sched_barrier(0)
  const int wid = __builtin_amdgcn_readfirstlane(tix >> 6), lane = tix & 63, wr = wid >> 2, wc = wid & 3, fr = lane & 15, fq = lane >> 4;
  const int wbase = wid * 1024;
  int voff0, voff1;
  { int _r, _c; stage_rc(tix * 16, _r, _c); voff0 = _r * K + _c; stage_rc(tix * 16 + 8192, _r, _c); voff1 = _r * K + _c; }
  f32x4 acc[2][2][4][2] = {};
  bf16x8 At[4][2], B0[2][2], B1[2][2];
  constexpr int nt = K / BK;
  STAGE(SB(0, 0), Bt, bcol, 0); STAGE(SA(0, 0), A, brow, 0);
  STAGE(SB(0, 1), Bt, bcol + HALF, 0); STAGE(SA(0, 1), A, brow + HALF, 0);
  if (wr == 1) BAR;
  WAIT_V(4); BAR;
  STAGE(SB(1, 0), Bt, bcol, 1); STAGE(SA(1, 0), A, brow, 1); STAGE(SB(1, 1), Bt, bcol + HALF, 1);
  WAIT_V(6); BAR;
  for (int t = 0; t < nt - 2; t += 2) {
    LDB(B0, 0, 0); SCHED; LDA(At, 0, 0); STAGE(SA(1, 1), A, brow + HALF, t + 1);
    WAIT_L(8); BAR; WAIT_L(0); MMA(0, 0, At, B0); BAR; SCHED;
    LDB(B1, 0, 1); STAGE(SB(0, 0), Bt, bcol, t + 2);
    BAR; WAIT_L(0); MMA(0, 1, At, B1); BAR;
    LDA(At, 0, 1); STAGE(SA(0, 0), A, brow, t + 2);
    BAR; WAIT_L(0); MMA(1, 0, At, B0); BAR; SCHED;
    STAGE(SB(0, 1), Bt, bcol + HALF, t + 2);
    WAIT_V(6); BAR; MMA(1, 1, At, B1); BAR;
    LDB(B0, 1, 0); SCHED; LDA(At, 1, 0); STAGE(SA(0, 1), A, brow + HALF, t + 2);
    WAIT_L(8); BAR; WAIT_L(0); MMA(0, 0, At, B0); BAR; SCHED;
    LDB(B1, 1, 1); STAGE(SB(1, 0), Bt, bcol, t + 3);
    BAR; WAIT_L(0); MMA(0, 1, At, B1); BAR;
    LDA(At, 1, 1); STAGE(SA(1, 0), A, brow, t + 3);
    BAR; WAIT_L(0); MMA(1, 0, At, B0); BAR; SCHED;
    STAGE(SB(1, 1), Bt, bcol + HALF, t + 3);
    WAIT_V(6); BAR; MMA(1, 1, At, B1); BAR;
  }
  { LDB(B0, 0, 0); LDA(At, 0, 0); STAGE(SA(1, 1), A, brow + HALF, nt - 1);
    BAR; WAIT_L(0); MMA(0, 0, At, B0); BAR;
    LDB(B1, 0, 1); BAR; WAIT_L(0); MMA(0, 1, At, B1); BAR;
    LDA(At, 0, 1); WAIT_V(4); BAR; WAIT_L(0); MMA(1, 0, At, B0); MMA(1, 1, At, B1); BAR; }
  { LDB(B0, 1, 0); LDA(At, 1, 0); WAIT_V(2); BAR; WAIT_L(0); MMA(0, 0, At, B0); BAR;
    LDB(B1, 1, 1); WAIT_V(0); BAR; WAIT_L(0); MMA(0, 1, At, B1); BAR;
    LDA(At, 1, 1); BAR; WAIT_L(0); MMA(1, 0, At, B0); MMA(1, 1, At, B1); BAR; }
  if (wr == 0) BAR;
  int fr_ = fr, fq_ = fq, wr_ = wr, wc_ = wc;
  asm volatile("" : "+v"(fr_), "+v"(fq_), "+s"(wr_), "+s"(wc_));
#define fr fr_
#define fq fq_
#define wr wr_
#define wc wc_
  const int b = brow / SEQ, s0 = brow % SEQ;
  if (MODE == 0) {
    const bool lat = s0 >= TC;
#pragma unroll
    for (int ai = 0; ai < 2; ++ai)
#pragma unroll
      for (int bj = 0; bj < 2; ++bj) {
        const int colbase = bcol + bj * HALF + wc * 32;
        const bool isrope = lat && ((colbase >= C_K && colbase < C_V) || (colbase >= C_Q && colbase < C_GD));
#pragma unroll
        for (int m = 0; m < 4; ++m) {
          const int lr = ai * HALF + wr * 64 + m * 16 + fr;
          f32x4 x1 = acc[ai][bj][m][0], x2 = acc[ai][bj][m][1];
          if (isrope) {
            const int t = s0 + lr - TC; const int pos = (colbase & 32) ? (t & 63) : (t >> 6);
            const f32x4 cs = *reinterpret_cast<const f32x4*>(p.rope + pos * 16 + fq * 4), sn = *reinterpret_cast<const f32x4*>(p.rope + 1024 + pos * 16 + fq * 4);
            const f32x4 o1 = x1 * cs - x2 * sn, o2 = x2 * cs + x1 * sn; x1 = o1; x2 = o2;
          }
          u16* dst = p.pbuf + (size_t)(brow + lr) * INW + colbase + fq * 4;
          uint2 w1, w2; w1.x = cvtpk(x1[0] + 0.f, x1[1] + 0.f); w1.y = cvtpk(x1[2] + 0.f, x1[3] + 0.f); w2.x = cvtpk(x2[0] + 0.f, x2[1] + 0.f); w2.y = cvtpk(x2[2] + 0.f, x2[3] + 0.f);
          *reinterpret_cast<uint2*>(dst) = w1; *reinterpret_cast<uint2*>(dst + 16) = w2;
        }
      }
  } else {
    const bool isctx = s0 < TC;
    const float* gate = p.mod + (l * 9 + (isctx ? 8 : b)) * 3072 + 2048;
    const float* srcb = isctx ? ((l == 0) ? p.ctx : p.hc) : ((l == 0) ? p.x : p.out);
    float* dstb = isctx ? p.hc : p.out;
    const size_t rbase = isctx ? (size_t)b * TC : ((size_t)b * TL - TC);
#pragma unroll
    for (int ai = 0; ai < 2; ++ai)
#pragma unroll
      for (int bj = 0; bj < 2; ++bj)
#pragma unroll
        for (int n = 0; n < 2; ++n) {
          const int col = bcol + bj * HALF + wc * 32 + n * 16 + fq * 4;
          const f32x4 gt = *reinterpret_cast<const f32x4*>(gate + col);
#pragma unroll
          for (int m = 0; m < 4; ++m) {
            const int lr = ai * HALF + wr * 64 + m * 16 + fr; const int s = s0 + lr;
            const size_t off = (rbase + s) * 1024 + col;
            const f32x4 sv = *reinterpret_cast<const f32x4*>(srcb + off);
            *reinterpret_cast<f32x4*>(dstb + off) = sv + gt * acc[ai][bj][m][n];
          }
        }
  }
  __syncthreads();
#undef fr
#undef fq
#undef wr
#undef wc
#undef SA
#undef SB
#undef STAGE
#undef LDA
#undef LDB
#undef MMA
}

template <int MODE>
DI void gemm_phase(const int tix, const Params& p, int l, const u16* A, const u16* Bt, int nN, char* smem) {
  constexpr int nM = ROWS / BM;
  const int nwg = nM * nN; const bool last = (l == 1);
  for (int T = blockIdx.x; T < nwg; T += gridDim.x) {
    int wgid = T;
    { int q = nwg / NXCD, r = nwg % NXCD, xcd = wgid % NXCD, off = wgid / NXCD; wgid = (xcd < r ? xcd * (q + 1) : r * (q + 1) + (xcd - r) * q) + off; }
    int nig = WGM * nN, gid = wgid / nig, fm = gid * WGM, gsz = min(nM - fm, WGM);
    int pm = fm + ((wgid % nig) % gsz), pn = (wgid % nig) / gsz;
    const bool isctx = (pm % 17) == 0;
    if (last && isctx && (MODE == 1 || pn >= 6)) continue;
    gemm_tile<MODE>(tix, p, l, A, Bt, pm * BM, pn * BM, (u16*)smem);
  }
}
}


namespace pg {
#define PG_LAS __attribute__((address_space(3)))
constexpr int BM = 256, BK = 64, HALF = 128, HTB = HALF * BK * 2, NXCD = 8, WGM = 4, KD = 1024;
struct Unit { int pm, pn; };
struct Sched {
  int kind, nN, G, c;
  DI bool next(int i, Unit& u) const {
    const int nMv = (kind == 0) ? 136 : 128, main = nMv * nN, total = main + (kind == 2 ? 48 : 0);
    if (kind == 3) { if (i != 0 || c >= 32) return false; u.pm = (c >> 2) * 17; u.pn = c & 3; return true; }
    const int L = i * G + c; if (L >= total) return false;
    if (L >= main) { const int e = L - main; u.pm = (e / 6) * 17; u.pn = e % 6; return true; }
    int wgid = L; { const int q = main / NXCD, r = main % NXCD, xcd = wgid % NXCD, off = wgid / NXCD; wgid = (xcd < r ? xcd * (q + 1) : r * (q + 1) + (xcd - r) * q) + off; }
    const int nig = WGM * nN, gid = wgid / nig, fm = gid * WGM, gsz = (nMv - fm) < WGM ? (nMv - fm) : WGM;
    const int v = fm + ((wgid % nig) % gsz); u.pn = (wgid % nig) / gsz;
    u.pm = (kind == 0) ? v : (v + v / 16 + 1);
    return true;
  }
};
struct EpiIn {
  const Params& p; int l;
  static DI bool perm_unit(const Unit& u) { return !(u.pn == 2 || u.pn == 3 || u.pn == 8 || u.pn == 9); }
  DI void operator()(const f32x4 (&acc)[2][2][4][2], const Unit& u, int wr, int wc, int fr, int fq, bool perm) const {
    const int brow = u.pm * BM, bcol = u.pn * BM;
    const int s0 = brow % SEQ; const bool lat = s0 >= TC;
    if (perm) {
#pragma unroll
      for (int ai = 0; ai < 2; ++ai)
#pragma unroll
        for (int bj = 0; bj < 2; ++bj)
#pragma unroll
          for (int m = 0; m < 4; ++m) {
            const int lr = ai * HALF + wr * 64 + m * 16 + fr;
            const f32x4 x1 = acc[ai][bj][m][0], x2 = acc[ai][bj][m][1];
            u32x4 w = {cvtpk(x1[0] + 0.f, x1[1] + 0.f), cvtpk(x1[2] + 0.f, x1[3] + 0.f), cvtpk(x2[0] + 0.f, x2[1] + 0.f), cvtpk(x2[2] + 0.f, x2[3] + 0.f)};
            *reinterpret_cast<u32x4*>(p.pbuf + (size_t)(brow + lr) * INW + bcol + bj * HALF + wc * 32 + fq * 8) = w;
          }
      return;
    }
#pragma unroll
    for (int ai = 0; ai < 2; ++ai)
#pragma unroll
      for (int bj = 0; bj < 2; ++bj) {
        const int colbase = bcol + bj * HALF + wc * 32;
        const bool isrope = lat && ((colbase >= C_K && colbase < C_V) || (colbase >= C_Q && colbase < C_GD));
        f32x4 cs[4], sn[4];
        if (isrope) {
#pragma unroll
          for (int m = 0; m < 4; ++m) {
            const int t = s0 + ai * HALF + wr * 64 + m * 16 + fr - TC; const int pos = (colbase & 32) ? (t & 63) : (t >> 6);
            cs[m] = *reinterpret_cast<const f32x4*>(p.rope + pos * 16 + fq * 4); sn[m] = *reinterpret_cast<const f32x4*>(p.rope + 1024 + pos * 16 + fq * 4);
          }
          asm volatile("" ::: "memory");
        }
#pragma unroll
        for (int m = 0; m < 4; ++m) {
          const int lr = ai * HALF + wr * 64 + m * 16 + fr;
          f32x4 x1 = acc[ai][bj][m][0], x2 = acc[ai][bj][m][1];
          if (isrope) { const f32x4 o1 = x1 * cs[m] - x2 * sn[m], o2 = x2 * cs[m] + x1 * sn[m]; x1 = o1; x2 = o2; }
          u16* dst = p.pbuf + (size_t)(brow + lr) * INW + colbase + fq * 4;
          uint2 w1, w2; w1.x = cvtpk(x1[0] + 0.f, x1[1] + 0.f); w1.y = cvtpk(x1[2] + 0.f, x1[3] + 0.f); w2.x = cvtpk(x2[0] + 0.f, x2[1] + 0.f); w2.y = cvtpk(x2[2] + 0.f, x2[3] + 0.f);
          *reinterpret_cast<uint2*>(dst) = w1; *reinterpret_cast<uint2*>(dst + 16) = w2;
        }
      }
  }
};
struct EpiOut {
  const Params& p; int l;
  static DI bool perm_unit(const Unit&) { return false; }
  DI void operator()(const f32x4 (&acc)[2][2][4][2], const Unit& u, int wr, int wc, int fr, int fq, bool) const {
    const int brow = u.pm * BM, bcol = u.pn * BM;
    const int b = brow / SEQ, s0 = brow % SEQ; const bool isctx = s0 < TC;
    const float* gate = p.mod + (l * 9 + (isctx ? 8 : b)) * 3072 + 2048;
    const float* __restrict__ srcb = isctx ? ((l == 0) ? p.ctx : p.hc) : ((l == 0) ? p.x : p.out);
    float* dstb = isctx ? p.hc : p.out;
    const size_t rbase = isctx ? (size_t)b * TC : ((size_t)b * TL - TC);
#pragma unroll
    for (int ai = 0; ai < 2; ++ai)
#pragma unroll
      for (int bj = 0; bj < 2; ++bj) {
        f32x4 sv[2][4], gt[2]; size_t off[2][4];
#pragma unroll
        for (int n = 0; n < 2; ++n) {
          const int col = bcol + bj * HALF + wc * 32 + n * 16 + fq * 4;
          gt[n] = *reinterpret_cast<const f32x4*>(gate + col);
#pragma unroll
          for (int m = 0; m < 4; ++m) {
            const int lr = ai * HALF + wr * 64 + m * 16 + fr;
            off[n][m] = (rbase + s0 + lr) * 1024 + col;
            sv[n][m] = *reinterpret_cast<const f32x4*>(srcb + off[n][m]);
          }
        }
        asm volatile("" ::: "memory");
#pragma unroll
        for (int n = 0; n < 2; ++n)
#pragma unroll
          for (int m = 0; m < 4; ++m) *reinterpret_cast<f32x4*>(dstb + off[n][m]) = sv[n][m] + gt[n] * acc[ai][bj][m][n];
        asm volatile("" ::: "memory");
      }
  }
};

template <class Epi>
DI void gemm_stream(const int tix, PG_LAS unsigned char* lds, const u16* Ab, const u16* Btb, const Sched& S, const Epi& E) {
  const int tid = tix, wid = __builtin_amdgcn_readfirstlane(tid >> 6), lane = tid & 63, wr = wid >> 2, wc = wid & 3, fr = lane & 15, fq = lane >> 4;
  constexpr int K = KD, nt = K / BK;
  unsigned voffA[2], voffP[2];
#pragma unroll
  for (int i = 0; i < 2; ++i) { int R, C; gm::stage_rc(tid * 16 + i * 8192, R, C); voffA[i] = (unsigned)(R * K + C) * 2u;
    const int rho = R & 31, Rp = (R & ~31) + 8 * ((rho & 15) >> 2) + 4 * (rho >> 4) + (rho & 3); voffP[i] = (unsigned)(Rp * K + C) * 2u; }
  const size_t kstep = (size_t)(BK * 2);
  const size_t hstep = (size_t)HALF * K * 2;
  const size_t tstep = 2 * hstep;
  const unsigned ldsw = (unsigned)wid * 1024u;
  const int aoff = gm::lds_byte(wr * 64 + fr, fq * 8), boff = gm::lds_byte(wc * 32 + fr, fq * 8);
#define PG_SA(b, h) (((b) * 2 + (h)) * HTB)
#define PG_SB(b, h) ((4 + (b) * 2 + (h)) * HTB)
#define PG_STAGE2(bufoff, gbase, v0, v1) do { \
    __builtin_amdgcn_global_load_lds((const unsigned*)((const char*)(gbase) + (v0)), (PG_LAS unsigned*)(lds + (bufoff) + ldsw), 16, 0, 0); \
    __builtin_amdgcn_global_load_lds((const unsigned*)((const char*)(gbase) + (v1)), (PG_LAS unsigned*)(lds + (bufoff) + ldsw + 8192), 16, 0, 0); } while (0)
#define PG_STAGE(bufoff, gbase) PG_STAGE2(bufoff, gbase, voffA[0], voffA[1])
#define PG_STAGEB(bufoff, gbase, nx) PG_STAGE2(bufoff, gbase, (nx) ? vbN0 : vbC0, (nx) ? vbN1 : vbC1)
#define PG_LDA(dst, b, h) do { _Pragma("unroll") for (int m = 0; m < 4; ++m) _Pragma("unroll") for (int k = 0; k < 2; ++k) dst[m][k] = *(const PG_LAS bf16x8*)(lds + PG_SA(b, h) + aoff + m * 2048 + k * 1024); } while (0)
#define PG_LDB(dst, b, h) do { _Pragma("unroll") for (int n = 0; n < 2; ++n) _Pragma("unroll") for (int k = 0; k < 2; ++k) dst[n][k] = *(const PG_LAS bf16x8*)(lds + PG_SB(b, h) + boff + n * 2048 + k * 1024); } while (0)
#define PG_MMA(ai, bj, At, Bt) do { __builtin_amdgcn_s_setprio(1); _Pragma("unroll") for (int m = 0; m < 4; ++m) _Pragma("unroll") for (int n = 0; n < 2; ++n) _Pragma("unroll") for (int k = 0; k < 2; ++k) \
    acc[ai][bj][m][n] = __builtin_amdgcn_mfma_f32_16x16x32_bf16(Bt[n][k], At[m][k], acc[ai][bj][m][n], 0, 0, 0); __builtin_amdgcn_s_setprio(0); } while (0)
#define PG_WAIT_V(n) asm volatile("s_waitcnt vmcnt(" #n ")" ::: "memory")
#define PG_WAIT_L(n) asm volatile("s_waitcnt lgkmcnt(" #n ")" ::: "memory")
#define PG_BAR __builtin_amdgcn_s_barrier()
#define PG_SCHED __builtin_amdgcn_sched_barrier(0)
  Unit cur, nxt; int ui = 0;
  if (!S.next(0, cur)) return;
  if (STAGGER_US > 0 && (blockIdx.x & 8)) {
    const unsigned long long t0 = __builtin_amdgcn_s_memrealtime();
    while (__builtin_amdgcn_s_memrealtime() - t0 < (unsigned long long)(STAGGER_US * 100)) __builtin_amdgcn_s_sleep(16);
  }
  f32x4 acc[2][2][4][2];
#pragma unroll
  for (int a = 0; a < 2; ++a)
#pragma unroll
    for (int b = 0; b < 2; ++b)
#pragma unroll
      for (int m = 0; m < 4; ++m)
#pragma unroll
        for (int n = 0; n < 2; ++n) acc[a][b][m][n] = (f32x4){0.f, 0.f, 0.f, 0.f};
  bf16x8 At[4][2], B0[2][2], B1[2][2];
  const char* cA = (const char*)Ab + (size_t)cur.pm * tstep; const char* cB = (const char*)Btb + (size_t)cur.pn * tstep;
  bool cperm = Epi::perm_unit(cur);
  unsigned vbC0 = cperm ? voffP[0] : voffA[0], vbC1 = cperm ? voffP[1] : voffA[1], vbN0 = vbC0, vbN1 = vbC1;
  PG_STAGEB(PG_SB(0, 0), cB, false); PG_STAGE(PG_SA(0, 0), cA); PG_STAGEB(PG_SB(0, 1), cB + hstep, false); PG_STAGE(PG_SA(0, 1), cA + hstep);
  if (wr == 1) PG_BAR;
  PG_WAIT_V(4); PG_BAR;
  PG_STAGEB(PG_SB(1, 0), cB + kstep, false); PG_STAGE(PG_SA(1, 0), cA + kstep); PG_STAGEB(PG_SB(1, 1), cB + hstep + kstep, false);
  PG_WAIT_V(6); PG_BAR;
  for (;;) {
    const bool has_next = S.next(ui + 1, nxt);
    const char* nA = has_next ? (const char*)Ab + (size_t)nxt.pm * tstep : cA; const char* nB = has_next ? (const char*)Btb + (size_t)nxt.pn * tstep : cB;
    const bool nperm = has_next ? Epi::perm_unit(nxt) : cperm;
    vbN0 = nperm ? voffP[0] : voffA[0]; vbN1 = nperm ? voffP[1] : voffA[1];
    for (int t = 0; t < nt; t += 2) {
      const bool last = (t == nt - 2);
      const char* a1 = cA + (size_t)(t + 1) * kstep;
      const char* a2 = last ? nA : cA + (size_t)(t + 2) * kstep; const char* b2 = last ? nB : cB + (size_t)(t + 2) * kstep;
      const char* a3 = a2 + kstep; const char* b3 = b2 + kstep;
      PG_LDB(B0, 0, 0); PG_SCHED; PG_LDA(At, 0, 0); PG_STAGE(PG_SA(1, 1), a1 + hstep);
      PG_WAIT_L(8); PG_BAR; PG_WAIT_L(0); PG_MMA(0, 0, At, B0); PG_BAR; PG_SCHED;
      PG_LDB(B1, 0, 1); PG_STAGEB(PG_SB(0, 0), b2, last);
      PG_BAR; PG_WAIT_L(0); PG_MMA(0, 1, At, B1); PG_BAR;
      PG_LDA(At, 0, 1); PG_STAGE(PG_SA(0, 0), a2);
      PG_BAR; PG_WAIT_L(0); PG_MMA(1, 0, At, B0); PG_BAR; PG_SCHED;
      PG_STAGEB(PG_SB(0, 1), b2 + hstep, last);
      PG_WAIT_V(6); PG_BAR; PG_MMA(1, 1, At, B1); PG_BAR;
      PG_LDB(B0, 1, 0); PG_SCHED; PG_LDA(At, 1, 0); PG_STAGE(PG_SA(0, 1), a2 + hstep);
      PG_WAIT_L(8); PG_BAR; PG_WAIT_L(0); PG_MMA(0, 0, At, B0); PG_BAR; PG_SCHED;
      PG_LDB(B1, 1, 1); PG_STAGEB(PG_SB(1, 0), b3, last);
      PG_BAR; PG_WAIT_L(0); PG_MMA(0, 1, At, B1); PG_BAR;
      PG_LDA(At, 1, 1); PG_STAGE(PG_SA(1, 0), a3);
      PG_BAR; PG_WAIT_L(0); PG_MMA(1, 0, At, B0); PG_BAR; PG_SCHED;
      PG_STAGEB(PG_SB(1, 1), b3 + hstep, last);
      PG_WAIT_V(6); PG_BAR; PG_MMA(1, 1, At, B1); PG_BAR;
    }
    E(acc, cur, wr, wc, fr, fq, cperm);
    if (!has_next) break;
#pragma unroll
    for (int a = 0; a < 2; ++a)
#pragma unroll
      for (int b = 0; b < 2; ++b)
#pragma unroll
        for (int m = 0; m < 4; ++m)
#pragma unroll
          for (int n = 0; n < 2; ++n) acc[a][b][m][n] = (f32x4){0.f, 0.f, 0.f, 0.f};
    cur = nxt; cA = nA; cB = nB; cperm = nperm; vbC0 = vbN0; vbC1 = vbN1; ++ui;
  }
  PG_WAIT_V(0);
  if (wr == 0) PG_BAR;
  PG_BAR;
#undef PG_SA
#undef PG_SB
#undef PG_STAGE
#undef PG_STAGE2
#undef PG_STAGEB
#undef PG_LDA
#undef PG_LDB
#undef PG_MMA
#undef PG_WAIT_V
#undef PG_WAIT_L
#undef PG_BAR
#undef PG_SCHED
}
}

namespace at {
constexpr int NW = 8, QBLK = 32, KVBLK = 64;
constexpr float SCALE = 0.125f, THR = 8.f;
constexpr int LDQ = INW, LDK = INW, LDO = 1024;
constexpr int SHM_V = KVBLK * 128 * 2, SHM_K = KVBLK * 64 * 2;
#define KSWZ(row, colB) ((row) * 128 + ((colB) ^ (((row) & 7) << 4)))
#define SBAR() __builtin_amdgcn_sched_barrier(0)

DI void partialSM(f32x16& p0, f32x16& p1, float& m_reg, float& mn, float& alpha) {
  constexpr float C = SCALE * 1.4426950408889634f;
  float pmax = p0[0];
  for (int r = 1; r < 16; ++r) pmax = fmaxf(pmax, p0[r]);
  for (int r = 0; r < 16; ++r) pmax = fmaxf(pmax, p1[r]);
  { auto rr = __builtin_amdgcn_permlane32_swap(__float_as_uint(pmax), __float_as_uint(pmax), false, false);
    pmax = fmaxf(__uint_as_float(rr[0]), __uint_as_float(rr[1])); }
  if (__builtin_expect(__all(pmax - m_reg <= THR / SCALE), 1)) { mn = m_reg; alpha = 1.f; }
  else { mn = fmaxf(m_reg, pmax); alpha = __builtin_amdgcn_exp2f((m_reg - mn) * C); m_reg = mn; }
  float mnC = -mn * C;
  for (int r = 0; r < 16; ++r) p0[r] = fmaf(p0[r], C, mnC);
  for (int r = 0; r < 16; ++r) p1[r] = fmaf(p1[r], C, mnC);
  for (int r = 0; r < 16; ++r) p0[r] = __builtin_amdgcn_exp2f(p0[r]);
}
DI void finishSM(f32x16& p0, f32x16& p1, float alpha, float& l_reg, bf16x8& pa0, bf16x8& pa1, bf16x8& pa2, bf16x8& pa3) {
  for (int r = 0; r < 16; ++r) p1[r] = __builtin_amdgcn_exp2f(p1[r]);
  float ps = 0;
  for (int r = 0; r < 16; ++r) ps += p0[r];
  for (int r = 0; r < 16; ++r) ps += p1[r];
  { auto rr = __builtin_amdgcn_permlane32_swap(__float_as_uint(ps), __float_as_uint(ps), false, false);
    ps = __uint_as_float(rr[0]) + __uint_as_float(rr[1]); }
  l_reg = l_reg * alpha + ps;
#define PK4(P, BASE, OUT) do { unsigned a0 = cvtpk(P[BASE + 0], P[BASE + 1]), a1 = cvtpk(P[BASE + 2], P[BASE + 3]);   \
    unsigned b0 = cvtpk(P[BASE + 4], P[BASE + 5]), b1 = cvtpk(P[BASE + 6], P[BASE + 7]);                              \
    auto r0 = __builtin_amdgcn_permlane32_swap(a0, b0, false, false); auto r1 = __builtin_amdgcn_permlane32_swap(a1, b1, false, false); \
    u32x4 w = {r0[0], r1[0], r0[1], r1[1]}; OUT = *reinterpret_cast<bf16x8*>(&w); } while (0)
  PK4(p0, 0, pa0); PK4(p0, 8, pa1); PK4(p1, 0, pa2); PK4(p1, 8, pa3);
#undef PK4
}
DI void qkt(f32x16& p0, f32x16& p1, const char* Ks, const bf16x8* qr, int r32, int hi) {
  p0 = f32x16{}; p1 = f32x16{};
#pragma unroll
  for (int d0 = 0; d0 < 4; ++d0) { int cb = (d0 * 16 + hi * 8) * 2;
    bf16x8 b0 = *reinterpret_cast<const bf16x8*>(Ks + KSWZ(r32, cb));
    bf16x8 b1 = *reinterpret_cast<const bf16x8*>(Ks + KSWZ(32 + r32, cb));
    p0 = MFMA32(b0, qr[d0], p0);
    p1 = MFMA32(b1, qr[d0], p1); }
}
DI int v_st(int k, int c) { const int kk = (k & ~0xC) | ((k & 4) << 1) | ((k & 8) >> 1); return ((kk >> 3) * 4 + (c >> 5)) * 512 + ((kk & 7) * 32 + (c & 31)) * 2; }
DI int v_rd_base(int lane) { return ((lane & 3) << 3) | (((lane >> 2) & 3) << 6) | (((lane >> 4) & 1) << 5) | (((lane >> 5) & 1) << 8); }
constexpr int v_rd_off(int d0, int ks, int half) { return d0 * 512 + ks * 4096 + half * 2048; }
template <int OFF> DI s16x4 tr_read(int vb) {
  s16x4 r; asm volatile("ds_read_b64_tr_b16 %0, %1 offset:%2" : "=&v"(r) : "v"(vb), "i"(OFF) : "memory"); return r;
}
template <int D0> DI void pv_one(f32x16& od, int vb, bf16x8 pa0, bf16x8 pa1, bf16x8 pa2, bf16x8 pa3) {
  const s16x4 l0 = tr_read<v_rd_off(D0, 0, 0)>(vb), h0 = tr_read<v_rd_off(D0, 0, 1)>(vb), l1 = tr_read<v_rd_off(D0, 1, 0)>(vb), h1 = tr_read<v_rd_off(D0, 1, 1)>(vb);
  const s16x4 l2 = tr_read<v_rd_off(D0, 2, 0)>(vb), h2 = tr_read<v_rd_off(D0, 2, 1)>(vb), l3 = tr_read<v_rd_off(D0, 3, 0)>(vb), h3 = tr_read<v_rd_off(D0, 3, 1)>(vb);
  asm volatile("s_waitcnt lgkmcnt(0)" ::: "memory"); SBAR();
#define PK(L, H) (bf16x8){L[0], L[1], L[2], L[3], H[0], H[1], H[2], H[3]}
  od = MFMA32(pa0, PK(l0, h0), od);
  od = MFMA32(pa1, PK(l1, h1), od);
  od = MFMA32(pa2, PK(l2, h2), od);
  od = MFMA32(pa3, PK(l3, h3), od);
#undef PK
}
DI void pv_d0(f32x16* o, int vb, bf16x8 pa0, bf16x8 pa1, bf16x8 pa2, bf16x8 pa3) {
  pv_one<0>(o[0], vb, pa0, pa1, pa2, pa3); pv_one<1>(o[1], vb, pa0, pa1, pa2, pa3); pv_one<2>(o[2], vb, pa0, pa1, pa2, pa3); pv_one<3>(o[3], vb, pa0, pa1, pa2, pa3);
}

DI void attn_body(const int tix, const u16* __restrict__ Qb, const u16* __restrict__ Kh, const u16* __restrict__ Vh, u16* __restrict__ Ob, int seq, char* lds) {
  const int tid = tix, wid = tid >> 6, lane = tid & 63, r32 = lane & 31, hi = lane >> 5;
  char* V_lds = lds; char* K_lds = lds + 2 * SHM_V;
  float* ws = (float*)(lds + 2 * SHM_V + 2 * SHM_K) + wid * 64; float* li_l = ws; float* al_l = ws + 32;
  float m_reg = -1e30f, l_reg = 0; f32x16 o[4] = {}; bf16x8 qr[4];
  const u16* Qw = Qb + (long)(wid * QBLK + r32) * LDQ + hi * 8;
#pragma unroll
  for (int d0 = 0; d0 < 4; ++d0) qr[d0] = *reinterpret_cast<const bf16x8*>(Qw + d0 * 16);
  const int sr = tid >> 4, sc = (tid & 15) * 8, vst0 = v_st(sr, sc), vst1 = v_st(32 + sr, sc);
  const int ksr = tid >> 3, ksc = (tid & 7) * 8, kst = KSWZ(ksr, ksc * 2);
  const int vb0 = (int)(uintptr_t)V_lds + v_rd_base(lane);
  struct { bf16x8 vs0, vs1, ks0; } sr_[2];
#define SLOAD(i, k0) do { sr_[i].vs0 = *reinterpret_cast<const bf16x8*>(&Vh[(long)((k0) + sr) * LDK + sc]); sr_[i].vs1 = *reinterpret_cast<const bf16x8*>(&Vh[(long)((k0) + 32 + sr) * LDK + sc]); \
    sr_[i].ks0 = *reinterpret_cast<const bf16x8*>(&Kh[(long)((k0) + ksr) * LDK + ksc]); } while (0)
#define SWRITE(b, i) do { *(bf16x8*)(V_lds + (b) * SHM_V + vst0) = sr_[i].vs0;          \
    *(bf16x8*)(V_lds + (b) * SHM_V + vst1) = sr_[i].vs1;               \
    *(bf16x8*)(K_lds + (b) * SHM_K + kst) = sr_[i].ks0; } while (0)
#define SWAIT() asm volatile("s_waitcnt vmcnt(3)" ::: "memory")
#define RESC(a) do { if (__any((a) < 1.f)) { if (hi == 0) al_l[r32] = (a); asm volatile("s_waitcnt lgkmcnt(0)" ::: "memory"); \
    for (int d = 0; d < 4; ++d) for (int r = 0; r < 16; ++r) o[d][r] *= al_l[crow(r, hi)]; } } while (0)
  f32x16 pA0, pA1, pB0, pB1; float mnA, mnB, alA, alB; bf16x8 pa0, pa1, pa2, pa3; const int NT = seq / KVBLK;
  constexpr int SE = 0, SO = 1;
  SLOAD(SE, 0); asm volatile("s_waitcnt vmcnt(0)" ::: "memory"); SWRITE(0, SE); __syncthreads();
  qkt(pA0, pA1, K_lds, qr, r32, hi); partialSM(pA0, pA1, m_reg, mnA, alA);
  SLOAD(SO, KVBLK); if (2 < NT) SLOAD(SE, 2 * KVBLK);
  SWAIT(); SWRITE(1, SO); __syncthreads();
  for (int j = 1; j + 1 < NT; j += 2) {
    SBAR(); qkt(pB0, pB1, K_lds + SHM_K, qr, r32, hi);
    finishSM(pA0, pA1, alA, l_reg, pa0, pa1, pa2, pa3); SBAR();
    SLOAD(SO, (j + 2) * KVBLK); SBAR();
    pv_d0(o, vb0, pa0, pa1, pa2, pa3); partialSM(pB0, pB1, m_reg, mnB, alB);
    __syncthreads(); SWAIT(); SWRITE(0, SE);
    RESC(alB); __syncthreads();
    SBAR(); qkt(pA0, pA1, K_lds, qr, r32, hi);
    finishSM(pB0, pB1, alB, l_reg, pa0, pa1, pa2, pa3); SBAR();
    if (j + 3 < NT) SLOAD(SE, (j + 3) * KVBLK); SBAR();
    pv_d0(o, vb0 + (int)SHM_V, pa0, pa1, pa2, pa3); partialSM(pA0, pA1, m_reg, mnA, alA);
    __syncthreads(); SWAIT(); SWRITE(1, SO);
    RESC(alA); __syncthreads();
  }
  SBAR(); qkt(pB0, pB1, K_lds + SHM_K, qr, r32, hi);
  finishSM(pA0, pA1, alA, l_reg, pa0, pa1, pa2, pa3); SBAR();
  pv_d0(o, vb0, pa0, pa1, pa2, pa3); partialSM(pB0, pB1, m_reg, mnB, alB);
  __syncthreads(); RESC(alB);
  finishSM(pB0, pB1, alB, l_reg, pa0, pa1, pa2, pa3); SBAR();
  pv_d0(o, vb0 + (int)SHM_V, pa0, pa1, pa2, pa3);
  if (hi == 0) li_l[r32] = l_reg; asm volatile("s_waitcnt lgkmcnt(0)" ::: "memory");
  float rli[16];
#pragma unroll
  for (int r = 0; r < 16; ++r) rli[r] = __builtin_amdgcn_rcpf(li_l[crow(r, hi)]);
  u16* Ow = Ob + (long)(wid * QBLK) * LDO;
#pragma unroll
  for (int r = 0; r < 16; ++r) { int orow = crow(r, hi);
#pragma unroll
    for (int d0 = 0; d0 < 4; ++d0) Ow[(long)orow * LDO + d0 * 32 + r32] = f2bf(o[d0][r] * rli[r]); }
  __syncthreads();
#undef SLOAD
#undef SWRITE
#undef SWAIT
#undef RESC
}

template <int OFF> DI s16x4 tr_read2(int vb) { s16x4 r; asm volatile("ds_read_b64_tr_b16 %0, %1 offset:%2" : "=&v"(r) : "v"(vb), "i"(OFF) : "memory"); return r; }
template <int BUF, int D0> DI void pv_one_b(f32x16& od, int vb, bf16x8 pa0, bf16x8 pa1, bf16x8 pa2, bf16x8 pa3) {
  constexpr int BO = BUF * 16384;
  const s16x4 l0 = tr_read2<BO + v_rd_off(D0, 0, 0)>(vb), h0 = tr_read2<BO + v_rd_off(D0, 0, 1)>(vb), l1 = tr_read2<BO + v_rd_off(D0, 1, 0)>(vb), h1 = tr_read2<BO + v_rd_off(D0, 1, 1)>(vb);
  const s16x4 l2 = tr_read2<BO + v_rd_off(D0, 2, 0)>(vb), h2 = tr_read2<BO + v_rd_off(D0, 2, 1)>(vb), l3 = tr_read2<BO + v_rd_off(D0, 3, 0)>(vb), h3 = tr_read2<BO + v_rd_off(D0, 3, 1)>(vb);
  asm volatile("s_waitcnt lgkmcnt(0)" ::: "memory"); SBAR();
#define PK(L, H) (bf16x8){L[0], L[1], L[2], L[3], H[0], H[1], H[2], H[3]}
  od = MFMA32(pa0, PK(l0, h0), od);
  od = MFMA32(pa1, PK(l1, h1), od);
  od = MFMA32(pa2, PK(l2, h2), od);
  od = MFMA32(pa3, PK(l3, h3), od);
#undef PK
}
template <int BUF> DI void pv_b(f32x16* o, int vb, bf16x8 pa0, bf16x8 pa1, bf16x8 pa2, bf16x8 pa3) {
  constexpr int BO = BUF * 16384;
#define PK(L, H) (bf16x8){L[0], L[1], L[2], L[3], H[0], H[1], H[2], H[3]}
#define PV_RD(G, R) do { R[0] = tr_read2<BO + v_rd_off((G) >> 1, 2 * ((G) & 1), 0)>(vb); R[1] = tr_read2<BO + v_rd_off((G) >> 1, 2 * ((G) & 1), 1)>(vb); \
    R[2] = tr_read2<BO + v_rd_off((G) >> 1, 2 * ((G) & 1) + 1, 0)>(vb); R[3] = tr_read2<BO + v_rd_off((G) >> 1, 2 * ((G) & 1) + 1, 1)>(vb); } while (0)
#define PV_MM(G, R) do { if ((G) & 1) { o[(G) >> 1] = MFMA32(pa2, PK(R[0], R[1]), o[(G) >> 1]); o[(G) >> 1] = MFMA32(pa3, PK(R[2], R[3]), o[(G) >> 1]); } \
    else { o[(G) >> 1] = MFMA32(pa0, PK(R[0], R[1]), o[(G) >> 1]); o[(G) >> 1] = MFMA32(pa1, PK(R[2], R[3]), o[(G) >> 1]); } } while (0)
#define PV_WAIT(N) do { asm volatile("s_waitcnt lgkmcnt(" #N ")" ::: "memory"); SBAR(); } while (0)
  s16x4 ra[4], rb[4], rc[4];
  PV_RD(0, ra); PV_RD(1, rb); PV_RD(2, rc);
  PV_WAIT(8); PV_MM(0, ra); PV_RD(3, ra);
  PV_WAIT(8); PV_MM(1, rb); PV_RD(4, rb);
  PV_WAIT(8); PV_MM(2, rc); PV_RD(5, rc);
  PV_WAIT(8); PV_MM(3, ra); PV_RD(6, ra);
  PV_WAIT(8); PV_MM(4, rb); PV_RD(7, rb);
  PV_WAIT(8); PV_MM(5, rc);
  PV_WAIT(4); PV_MM(6, ra);
  PV_WAIT(0); PV_MM(7, rb);
#undef PK
#undef PV_RD
#undef PV_MM
#undef PV_WAIT
}
#define KSWZ2(row, colB) ((((row) >> 1) << 8) + ((((((row) & 1) << 3) | ((colB) >> 4)) ^ (((row) >> 1) & 15)) << 4))
DI void qkt2(f32x16& p0, f32x16& p1, const char* Ks, const bf16x8* qr, int r32, int hi) {
  p0 = f32x16{}; p1 = f32x16{};
#pragma unroll
  for (int d0 = 0; d0 < 4; ++d0) { const int cb = (d0 * 16 + hi * 8) * 2;
    bf16x8 b0 = *reinterpret_cast<const bf16x8*>(Ks + KSWZ2(r32, cb));
    bf16x8 b1 = *reinterpret_cast<const bf16x8*>(Ks + KSWZ2(32 + r32, cb));
    p0 = MFMA32(b0, qr[d0], p0);
    p1 = MFMA32(b1, qr[d0], p1); }
}
constexpr int DMA_K0 = 65536, DMA_WS = 98304;
DI void attn_body_dma(const int tix, const u16* __restrict__ Qb, const u16* __restrict__ Kh, const u16* __restrict__ Vh, u16* __restrict__ Ob, int seq, char* lds) {
  const int tid = tix, wid = __builtin_amdgcn_readfirstlane(tid >> 6), lane = tid & 63, r32 = lane & 31, hi = lane >> 5;
  float* ws = (float*)(lds + DMA_WS) + wid * 64; float* li_l = ws; float* al_l = ws + 32;
  float m_reg = -1e30f, l_reg = 0; f32x16 o[4] = {}; bf16x8 qr[4];
  const u16* Qw = Qb + (long)(wid * QBLK + r32) * LDQ + hi * 8;
#pragma unroll
  for (int d0 = 0; d0 < 4; ++d0) qr[d0] = *reinterpret_cast<const bf16x8*>(Qw + d0 * 16);
  int koff, voff0, voff1;
  { const int oo = tid * 16, sr = oo >> 8, x = ((oo >> 4) & 15) ^ (sr & 15), row = sr * 2 + (x >> 3), colB = (x & 7) * 16; koff = row * LDK + (colB >> 1); }
  { const int oo = tid * 16, S = oo >> 9, w = (oo & 511) >> 1, kk = (S >> 2) * 8 + (w >> 5), k = (kk & ~0xC) | ((kk & 4) << 1) | ((kk & 8) >> 1); voff0 = k * LDK + (S & 3) * 32 + (w & 31); }
  { const int oo = tid * 16 + 8192, S = oo >> 9, w = (oo & 511) >> 1, kk = (S >> 2) * 8 + (w >> 5), k = (kk & ~0xC) | ((kk & 4) << 1) | ((kk & 8) >> 1); voff1 = k * LDK + (S & 3) * 32 + (w & 31); }
  const int wb = wid * 1024;
  const int vb0 = (int)(uintptr_t)lds + v_rd_base(lane);
#define LASP(x) ((__attribute__((address_space(3))) unsigned*)(x))
#define ISSUE(T, B) do { const u16* kt_ = Kh + (long)(T) * (KVBLK * LDK); const u16* vt_ = Vh + (long)(T) * (KVBLK * LDK); \
    __builtin_amdgcn_global_load_lds((const unsigned*)(kt_ + koff), LASP(lds + DMA_K0 + (B) * 8192 + wb), 16, 0, 0); \
    __builtin_amdgcn_global_load_lds((const unsigned*)(vt_ + voff0), LASP(lds + (B) * 16384 + wb), 16, 0, 0); \
    __builtin_amdgcn_global_load_lds((const unsigned*)(vt_ + voff1), LASP(lds + (B) * 16384 + 8192 + wb), 16, 0, 0); } while (0)
#define WAITV(n) asm volatile("s_waitcnt vmcnt(" #n ")" ::: "memory")
#define BARX() do { asm volatile("s_waitcnt lgkmcnt(0)" ::: "memory"); __builtin_amdgcn_s_barrier(); asm volatile("" ::: "memory"); } while (0)
#define RESC(a) do { if (__any((a) < 1.f)) { if (hi == 0) al_l[r32] = (a); asm volatile("s_waitcnt lgkmcnt(0)" ::: "memory"); \
    for (int d = 0; d < 4; ++d) for (int r = 0; r < 16; ++r) o[d][r] *= al_l[crow(r, hi)]; } } while (0)
  f32x16 pA0, pA1, pB0, pB1; float mnA, mnB, alA, alB; bf16x8 pa0, pa1, pa2, pa3; const int NT = seq / KVBLK;
#define BAR_EVEN(u) do { if ((u) + 1 < NT) WAITV(3); else WAITV(0); BARX(); } while (0)
#define BAR_ODD(t, B) do { BARX(); if ((t) + 2 < NT) ISSUE((t) + 2, ((B) + 2) & 3); } while (0)
#define SEG1(B, PC0, PC1, PP0, PP1, alP) do { SBAR(); qkt2(PC0, PC1, lds + DMA_K0 + (B) * 8192, qr, r32, hi); finishSM(PP0, PP1, alP, l_reg, pa0, pa1, pa2, pa3); SBAR(); } while (0)
#define SEG2(VBUF, PC0, PC1, mnC, alC) do { pv_b<(VBUF) & 3>(o, vb0, pa0, pa1, pa2, pa3); partialSM(PC0, PC1, m_reg, mnC, alC); RESC(alC); } while (0)
  ISSUE(0, 0); ISSUE(1, 1);
  if (wid < 4) {
#define IT_A(t, B, PC0, PC1, mnC, alC, PP0, PP1, alP) do { BAR_EVEN(t); SEG1(B, PC0, PC1, PP0, PP1, alP); BAR_ODD(t, B); SEG2((B) + 3, PC0, PC1, mnC, alC); } while (0)
    BAR_EVEN(0); qkt2(pA0, pA1, lds + DMA_K0, qr, r32, hi);
    BAR_ODD(0, 0); partialSM(pA0, pA1, m_reg, mnA, alA);
    int t = 1;
    for (; t + 3 < NT; t += 4) {
      IT_A(t, 1, pB0, pB1, mnB, alB, pA0, pA1, alA);
      IT_A(t + 1, 2, pA0, pA1, mnA, alA, pB0, pB1, alB);
      IT_A(t + 2, 3, pB0, pB1, mnB, alB, pA0, pA1, alA);
      IT_A(t + 3, 0, pA0, pA1, mnA, alA, pB0, pB1, alB);
    }
    IT_A(t, 1, pB0, pB1, mnB, alB, pA0, pA1, alA);
    IT_A(t + 1, 2, pA0, pA1, mnA, alA, pB0, pB1, alB);
    IT_A(t + 2, 3, pB0, pB1, mnB, alB, pA0, pA1, alA);
    finishSM(pB0, pB1, alB, l_reg, pa0, pa1, pa2, pa3); SBAR();
    pv_b<3>(o, vb0, pa0, pa1, pa2, pa3);
    WAITV(0); BARX();
#undef IT_A
  } else {
#define IT_B(t, B, PC0, PC1, PQ0, PQ1, mnQ, alQ) do { BAR_EVEN(t); \
      if ((t) > 1) { SEG2((B) + 2, PQ0, PQ1, mnQ, alQ); } else { partialSM(PQ0, PQ1, m_reg, mnQ, alQ); } \
      BAR_ODD(t, B); SEG1(B, PC0, PC1, PQ0, PQ1, alQ); } while (0)
    BAR_EVEN(0);
    BAR_ODD(0, 0); qkt2(pA0, pA1, lds + DMA_K0, qr, r32, hi);
    int t = 1;
    for (; t + 3 < NT; t += 4) {
      IT_B(t, 1, pB0, pB1, pA0, pA1, mnA, alA);
      IT_B(t + 1, 2, pA0, pA1, pB0, pB1, mnB, alB);
      IT_B(t + 2, 3, pB0, pB1, pA0, pA1, mnA, alA);
      IT_B(t + 3, 0, pA0, pA1, pB0, pB1, mnB, alB);
    }
    IT_B(t, 1, pB0, pB1, pA0, pA1, mnA, alA);
    IT_B(t + 1, 2, pA0, pA1, pB0, pB1, mnB, alB);
    IT_B(t + 2, 3, pB0, pB1, pA0, pA1, mnA, alA);
    WAITV(0); BARX();
    SEG2(2, pB0, pB1, mnB, alB);
    finishSM(pB0, pB1, alB, l_reg, pa0, pa1, pa2, pa3); SBAR();
    pv_b<3>(o, vb0, pa0, pa1, pa2, pa3);
#undef IT_B
  }
#undef BAR_EVEN
#undef BAR_ODD
#undef SEG1
#undef SEG2
  if (hi == 0) li_l[r32] = l_reg; asm volatile("s_waitcnt lgkmcnt(0)" ::: "memory");
  float rli[16];
#pragma unroll
  for (int r = 0; r < 16; ++r) rli[r] = __builtin_amdgcn_rcpf(li_l[crow(r, hi)]);
  u16* Ow = Ob + (long)(wid * QBLK) * LDO;
#pragma unroll
  for (int r = 0; r < 16; ++r) { int orow = crow(r, hi);
#pragma unroll
    for (int d0 = 0; d0 < 4; ++d0) Ow[(long)orow * LDO + d0 * 32 + r32] = f2bf(o[d0][r] * rli[r]); }
  asm volatile("s_waitcnt vmcnt(0)" ::: "memory");
  __syncthreads();
#undef LASP
#undef ISSUE
#undef WAITV
#undef BARX
#undef RESC
#undef HALF_IT
}
}

DI int smap(int sigma, int dir) { return dir == 0 ? sigma : (sigma < TC ? (TC - 1 - sigma) : (SEQ + TC - 1 - sigma)); }

DI float fsig(float v) { return __builtin_amdgcn_rcpf(1.f + __builtin_amdgcn_exp2f(-1.4426950408889634f * v)); }
DI u16 bfr(float x) { return (u16)(cvtpk(x, x) & 0xffffu); }
#define WAVE_SYNC() do { __builtin_amdgcn_fence(__ATOMIC_RELEASE, "wavefront"); __builtin_amdgcn_wave_barrier(); __builtin_amdgcn_fence(__ATOMIC_ACQUIRE, "wavefront"); } while (0)

DI void lru_wg_item(const int tix, const Params& p, int l, int item, char* smem) {
  const int wid = __builtin_amdgcn_readfirstlane(tix >> 6), lane = tix & 63, r = lane & 31, h = lane >> 5;
  const int b = item >> 4, dir = (item >> 3) & 1, n = (item >> 1) & 3, half = item & 1;
  char* wlds = smem + wid * 9216;
  u16* xcb = (u16*)wlds;
  float* xcf = (float*)(wlds + 32 * 144);
  float* exch = (float*)(smem + 8 * 9216);
  const int ld = l * 2 + dir;
  bf16x8 wa[4], wx[4];
  { const u16* wt = p.lruWT + (size_t)(((ld * 4 + n) * 2) * 4096) + (half * 32 + r) * 64 + 8 * h;
#pragma unroll
    for (int s = 0; s < 4; ++s) { wa[s] = *reinterpret_cast<const bf16x8*>(wt + 16 * s); wx[s] = *reinterpret_cast<const bf16x8*>(wt + 4096 + 16 * s); } }
  const int ch = n * 64 + half * 32 + r;
  const float ba = p.lru_ba[ld * 256 + ch], bx = p.lru_bx[ld * 256 + ch];
  const float sp8l = 8.f * 1.4426950408889634f * log1pf(expf(-p.lru_lam[ld * 256 + ch]));
  const int cch = n * 64 + lane;
  const float cw0 = p.conv_w[(l * 4 + 0) * 256 + cch], cw1 = p.conv_w[(l * 4 + 1) * 256 + cch], cw2 = p.conv_w[(l * 4 + 2) * 256 + cch], cw3 = p.conv_w[(l * 4 + 3) * 256 + cch];
  const float cbias = p.conv_b[l * 256 + cch];
  const u16* ubase = p.pbuf + (size_t)b * SEQ * INW + C_UA + cch;
  u16* hout = p.hl + ((size_t)dir * ROWS + (size_t)b * SEQ) * 256 + ch;
  float sc = 0.f;
  u16 un[35];
  { const int sg = wid * 32; const int smin0 = dir == 0 ? sg : smap(sg + 31, 1);
#pragma unroll
    for (int k = 0; k < 35; ++k) { int s = smin0 - 2 + k; s = s < 0 ? 0 : (s > SEQ - 1 ? SEQ - 1 : s); un[k] = ubase[(size_t)s * INW]; } }
  for (int st = 0; st < SEQ / 256; ++st) {
    const int sg0 = st * 256 + wid * 32;
    const int smin = dir == 0 ? sg0 : smap(sg0 + 31, 1);
    const int seg_lo = smin < TC ? 0 : TC, seg_hi = smin < TC ? TC : SEQ;
    float uw[35];
#pragma unroll
    for (int k = 0; k < 35; ++k) { const int s = smin - 2 + k; uw[k] = (s >= seg_lo && s < seg_hi) ? bf2f(un[k]) : 0.f; }
    if (st + 1 < SEQ / 256) {
      const int smin1 = dir == 0 ? sg0 + 256 : smap(sg0 + 256 + 31, 1);
#pragma unroll
      for (int k = 0; k < 35; ++k) { int s = smin1 - 2 + k; s = s < 0 ? 0 : (s > SEQ - 1 ? SEQ - 1 : s); un[k] = ubase[(size_t)s * INW]; }
    }
#pragma unroll
    for (int i = 0; i < 32; ++i) {
      const float xc = cbias + cw0 * uw[i] + cw1 * uw[i + 1] + cw2 * uw[i + 2] + cw3 * uw[i + 3];
      const int m = dir ? 31 - i : i;
      xcb[m * 72 + lane] = bfr(xc);
      if ((lane >> 5) == half) xcf[m * 33 + (lane & 31)] = xc;
    }
    WAVE_SYNC();
    f32x16 ga = {}, gx = {};
#pragma unroll
    for (int s = 0; s < 4; ++s) {
      const bf16x8 a = *reinterpret_cast<const bf16x8*>(xcb + r * 72 + 16 * s + 8 * h);
      ga = MFMA32(a, wa[s], ga); gx = MFMA32(a, wx[s], gx);
    }
    float av[16], hv[16], cum[16];
#pragma unroll
    for (int i = 0; i < 16; ++i) {
      const int m = crow(i, h);
      const float xv = xcf[m * 33 + r];
      const float rr = fsig(ga[i] + ba), ii = fsig(gx[i] + bx);
      const float a = __builtin_amdgcn_exp2f(-sp8l * rr);
      av[i] = a;
      hv[i] = __builtin_amdgcn_sqrtf(fmaxf(1.f - a * a, 0.f)) * (ii * xv);
    }
    float Ag[4], Bg[4];
#pragma unroll
    for (int g = 0; g < 4; ++g) {
      cum[4 * g] = av[4 * g];
#pragma unroll
      for (int j = 1; j < 4; ++j) { hv[4 * g + j] = av[4 * g + j] * hv[4 * g + j - 1] + hv[4 * g + j]; cum[4 * g + j] = cum[4 * g + j - 1] * av[4 * g + j]; }
      Ag[g] = cum[4 * g + 3]; Bg[g] = hv[4 * g + 3];
    }
    float cin0[4], pre[4];
    float cc = 0.f, pp = 1.f;
#pragma unroll
    for (int g = 0; g < 4; ++g) {
      const float oA = __shfl_xor(Ag[g], 32), oB = __shfl_xor(Bg[g], 32);
      const float A0 = h ? oA : Ag[g], B0 = h ? oB : Bg[g], A1 = h ? Ag[g] : oA, B1 = h ? Bg[g] : oB;
      const float c0 = cc, p0 = pp; cc = A0 * cc + B0; pp = A0 * pp;
      const float c1 = cc, p1 = pp; cc = A1 * cc + B1; pp = A1 * pp;
      cin0[g] = h ? c1 : c0; pre[g] = h ? p1 : p0;
    }
    if (h == 0) { exch[(wid * 32 + r) * 2] = pp; exch[(wid * 32 + r) * 2 + 1] = cc; }
    __syncthreads();
    float tc = sc, mycin = sc;
#pragma unroll
    for (int j = 0; j < 8; ++j) { const float Aj = exch[(j * 32 + r) * 2], Bj = exch[(j * 32 + r) * 2 + 1]; if (j == wid) mycin = tc; tc = Aj * tc + Bj; }
    sc = tc;
#pragma unroll
    for (int i = 0; i < 16; ++i) {
      const float hf = hv[i] + cum[i] * (cin0[i >> 2] + pre[i >> 2] * mycin);
      const int s = smap(sg0 + crow(i, h), dir);
      hout[(size_t)s * 256] = bfr(hf);
    }
    __syncthreads();
  }
}

DI void s5_wg_item(const int tix, const Params& p, int l, int item, char* smem) {
  const int wid = __builtin_amdgcn_readfirstlane(tix >> 6), lane = tix & 63, r = lane & 31, h = lane >> 5;
  const int b = item >> 5, dir = (item >> 4) & 1, g = item & 15;
  const int ldg = (l * 2 + dir) * 16 + g;
  u16* Sl = (u16*)(smem + wid * 9216);
  float* exch = (float*)(smem + 8 * 9216);
  bf16x8 bb[4], cf[4];
  const int c16 = lane & 15, kq = lane >> 4;
#pragma unroll
  for (int nt = 0; nt < 4; ++nt) bb[nt] = *reinterpret_cast<const bf16x8*>(p.bbT + ((size_t)(ldg * 2 + (nt >> 1)) * 64 + (nt & 1) * 32 + r) * 16 + 8 * h);
#pragma unroll
  for (int s = 0; s < 4; ++s) cf[s] = *reinterpret_cast<const bf16x8*>(p.cc + ((size_t)ldg * 16 + c16) * 128 + 32 * s + 8 * kq);
  float ar[2][4], ai[2][4];
  float a8r_[2], a8i_[2];
  float a32r[2], a32i[2];
#pragma unroll
  for (int st = 0; st < 2; ++st) {
    const float a_r = p.sa[((size_t)ldg * 64 + st * 32 + r) * 2], a_i = p.sa[((size_t)ldg * 64 + st * 32 + r) * 2 + 1];
    ar[st][0] = a_r; ai[st][0] = a_i;
#pragma unroll
    for (int k = 1; k < 4; ++k) { ar[st][k] = ar[st][k - 1] * a_r - ai[st][k - 1] * a_i; ai[st][k] = ar[st][k - 1] * a_i + ai[st][k - 1] * a_r; }
    const float a4r = ar[st][3], a4i = ai[st][3];
    const float a8r = a4r * a4r - a4i * a4i, a8i = 2.f * a4r * a4i;
    a8r_[st] = a8r; a8i_[st] = a8i;
    const float a16r = a8r * a8r - a8i * a8i, a16i = 2.f * a8r * a8i;
    a32r[st] = a16r * a16r - a16i * a16i; a32i[st] = 2.f * a16r * a16i;
  }
  float scr[2] = {0.f, 0.f}, sci[2] = {0.f, 0.f};
  const u16* ubase = p.pbuf + (size_t)b * SEQ * INW + C_US + g * 16 + 8 * h;
  u16* yout = p.ys + ((size_t)dir * ROWS + (size_t)b * SEQ) * 256 + g * 16 + c16;
  bf16x8 uan = *reinterpret_cast<const bf16x8*>(ubase + (size_t)smap(wid * 32 + r, dir) * INW);
  for (int st_ = 0; st_ < SEQ / 256; ++st_) {
    const int sg0 = st_ * 256 + wid * 32;
    const bf16x8 ua = uan;
    { const int sgn = (st_ + 1 < SEQ / 256) ? sg0 + 256 : sg0; uan = *reinterpret_cast<const bf16x8*>(ubase + (size_t)smap(sgn + r, dir) * INW); }
    f32x16 z16 = {};
    f32x16 sre[2], sim[2];
    sre[0] = MFMA32(ua, bb[0], z16); sre[1] = MFMA32(ua, bb[1], z16); sim[0] = MFMA32(ua, bb[2], z16); sim[1] = MFMA32(ua, bb[3], z16);
    float cinr[2][4], cini[2][4];
#pragma unroll
    for (int st = 0; st < 2; ++st) {
      const float a_r = ar[st][0], a_i = ai[st][0];
      float Er[4], Ei[4];
#pragma unroll
      for (int g4 = 0; g4 < 4; ++g4) {
#pragma unroll
        for (int j = 1; j < 4; ++j) {
          const float pr = sre[st][4 * g4 + j - 1], pi = sim[st][4 * g4 + j - 1];
          sre[st][4 * g4 + j] += a_r * pr - a_i * pi;
          sim[st][4 * g4 + j] += a_r * pi + a_i * pr;
        }
        Er[g4] = sre[st][4 * g4 + 3]; Ei[g4] = sim[st][4 * g4 + 3];
      }
      float c_r = 0.f, c_i = 0.f;
      const float a4r = ar[st][3], a4i = ai[st][3];
#pragma unroll
      for (int g4 = 0; g4 < 4; ++g4) {
        const float oEr = __shfl_xor(Er[g4], 32), oEi = __shfl_xor(Ei[g4], 32);
        const float E0r = h ? oEr : Er[g4], E0i = h ? oEi : Ei[g4], E1r = h ? Er[g4] : oEr, E1i = h ? Ei[g4] : oEi;
        const float c0r = c_r, c0i = c_i;
        float nr = a4r * c_r - a4i * c_i + E0r, ni = a4r * c_i + a4i * c_r + E0i; c_r = nr; c_i = ni;
        const float c1r = c_r, c1i = c_i;
        nr = a4r * c_r - a4i * c_i + E1r; ni = a4r * c_i + a4i * c_r + E1i; c_r = nr; c_i = ni;
        cinr[st][g4] = h ? c1r : c0r; cini[st][g4] = h ? c1i : c0i;
      }
      if (h == 0) { exch[(wid * 32 + r) * 4 + st * 2] = c_r; exch[(wid * 32 + r) * 4 + st * 2 + 1] = c_i; }
    }
    __syncthreads();
#pragma unroll
    for (int st = 0; st < 2; ++st) {
      float tr = scr[st], ti = sci[st], mr = tr, mi = ti;
#pragma unroll
      for (int j = 0; j < 8; ++j) {
        const float er = exch[(j * 32 + r) * 4 + st * 2], ei = exch[(j * 32 + r) * 4 + st * 2 + 1];
        if (j == wid) { mr = tr; mi = ti; }
        const float nr = a32r[st] * tr - a32i[st] * ti + er, ni = a32r[st] * ti + a32i[st] * tr + ei; tr = nr; ti = ni;
      }
      scr[st] = tr; sci[st] = ti;
      float qr = h ? (ar[st][3] * mr - ai[st][3] * mi) : mr, qi = h ? (ar[st][3] * mi + ai[st][3] * mr) : mi;
#pragma unroll
      for (int g4 = 0; g4 < 4; ++g4) {
        const float cr_ = cinr[st][g4] + qr, ci_ = cini[st][g4] + qi;
        { const float nq = a8r_[st] * qr - a8i_[st] * qi; qi = a8r_[st] * qi + a8i_[st] * qr; qr = nq; }
#pragma unroll
        for (int j = 0; j < 4; ++j) {
          const int i = 4 * g4 + j;
          const float vr = sre[st][i] + ar[st][j] * cr_ - ai[st][j] * ci_;
          const float vi = sim[st][i] + ar[st][j] * ci_ + ai[st][j] * cr_;
          const int m = crow(i, h);
          const unsigned w = cvtpk(vr, vi);
          Sl[m * 136 + st * 32 + r] = (u16)(w & 0xffffu);
          Sl[m * 136 + 64 + st * 32 + r] = (u16)(w >> 16);
        }
      }
    }
    WAVE_SYNC();
#pragma unroll
    for (int mt = 0; mt < 2; ++mt) {
      f32x4 y = {};
#pragma unroll
      for (int s = 0; s < 4; ++s) {
        const bf16x8 a = *reinterpret_cast<const bf16x8*>(Sl + (mt * 16 + c16) * 136 + 32 * s + 8 * kq);
        y = __builtin_amdgcn_mfma_f32_16x16x32_bf16(a, cf[s], y, 0, 0, 0);
      }
#pragma unroll
      for (int j = 0; j < 4; ++j) { const int s = smap(sg0 + mt * 16 + kq * 4 + j, dir); yout[(size_t)s * 256] = f2bf(y[j]); }
    }
    __syncthreads();
  }
}

DI void phase_mix(const int tix, const Params& p, int l, char* smem, int* s_item, int cbase = 0) {
  const int tid = tix, wid = __builtin_amdgcn_readfirstlane(tid >> 6);
#define NEXT_ITEM(cidx) if (tid == 0) *s_item = atomicAdd(&p.counters[l * 16 + cbase + (cidx)], 1); __syncthreads(); const int item = *s_item; __syncthreads();
  const int n_att = 1024 + (l == 0 ? 64 : 0);
  for (int rep = 0; rep < ((PROBE_DUP & 4) ? 2 : 1); ++rep)
  for (;;) {
    NEXT_ITEM(2 + 3 * rep); if (item >= n_att) break;
    int b, hm, q0, seq;
    if (item < 1024) { const int qb = item & 15; hm = (item >> 4) & 7; b = item >> 7; q0 = TC + qb * 256; seq = SEQ; }
    else { const int a = item - 1024; hm = a & 7; b = a >> 3; q0 = 0; seq = TC; }
    const u16* base = p.pbuf + (size_t)b * SEQ * INW;
    at::attn_body_dma(tix, base + (size_t)q0 * INW + C_Q + hm * 64, base + C_K + hm * 64, base + C_V + (hm >> 1) * 128,
                  p.obuf + ((size_t)b * SEQ + q0) * 1024 + hm * 128, seq, smem);
  }
  for (int rep = 0; rep < ((PROBE_DUP & 1) ? 2 : 1); ++rep)
  for (;;) { NEXT_ITEM(0 + 3 * rep); if (item >= 128) break; lru_wg_item(tix, p, l, item, smem); }
  for (int rep = 0; rep < ((PROBE_DUP & 2) ? 2 : 1); ++rep)
  for (;;) { NEXT_ITEM(1 + 3 * rep); if (item >= 256) break; s5_wg_item(tix, p, l, item, smem); }
#undef NEXT_ITEM
}

DI void unpack8(const bf16x8 v, float* f) {
#pragma unroll
  for (int k = 0; k < 8; ++k) f[k] = bf2f((u16)v[k]);
}
DI bf16x8 pack8(const float* f) {
  u32x4 w = {cvtpk(f[0], f[1]), cvtpk(f[2], f[3]), cvtpk(f[4], f[5]), cvtpk(f[6], f[7])};
  return *reinterpret_cast<bf16x8*>(&w);
}
DI void phase_combine(const int tix, const Params& p, int l, char* smem, int* s_item) {
  const int tid = tix, wid = tid >> 6, lane = tid & 63, r = lane & 31, h = lane >> 5;
  const bool dyn = (l == 0);
  int* ctr = p.counters + l * 16 + 8;
  if (dyn && blockIdx.x < 32) {
    if (tid == 0) {
      unsigned sp = 0;
      while (__hip_atomic_load(&ctr[1], __ATOMIC_RELAXED, __HIP_MEMORY_SCOPE_AGENT) < 64) { __builtin_amdgcn_s_sleep(4); if (++sp > (1u << 22)) break; }
      __threadfence();
    }
    __syncthreads();
    pg::gemm_stream(tix, (PG_LAS unsigned char*)smem, p.nbuf, p.woutT, pg::Sched{3, 4, (int)gridDim.x, (int)blockIdx.x}, pg::EpiOut{p, 0});
    __syncthreads();
  }
  float* zf = (float*)smem;
  u16* zb = (u16*)(smem + 32 * 260 * 4);
  const float lam = p.lamv[l], onem = 1.f - p.lamv[2 + l];
  bf16x8 wg[16];
  { const u16* wt = p.wgluT + (size_t)l * 65536 + (size_t)(wid * 32 + r) * 256 + 8 * h;
#pragma unroll
    for (int s = 0; s < 16; ++s) wg[s] = *reinterpret_cast<const bf16x8*>(wt + 16 * s); }
  const float bglu = p.s5_b_glu[l * 256 + wid * 32 + r];
  const size_t DSTRIDE = (size_t)ROWS * 256;
  for (int it = 0;; ++it) {
    int item, q = 0;
    if (dyn) {
      if (tid == 0) *s_item = atomicAdd(&ctr[0], 1);
      __syncthreads(); q = *s_item; __syncthreads();
      if (q >= ROWS / 32) break;
      if (q < 64) item = (q >> 3) * 136 + (q & 7); else { const int e = q - 64; item = (e >> 7) * 136 + 8 + (e & 127); }
    } else { item = blockIdx.x + it * gridDim.x; if (item >= ROWS / 32) break; }
    const int row0 = item * 32;
    if (l == 1 && (row0 % SEQ) < TC) continue;
    bf16x8 lh0[2], lh1[2], ly0[2], ly1[2], lga[2], lus[2]; f32x4 ld0[2], ld1[2];
#pragma unroll
    for (int i = 0; i < 2; ++i) {
      const int id = tid + NTHR * i, rr = id >> 5, c8 = (id & 31) * 8; const size_t row = row0 + rr;
      const u16* pr = p.pbuf + row * INW;
      lh0[i] = *reinterpret_cast<const bf16x8*>(p.hl + row * 256 + c8); lh1[i] = *reinterpret_cast<const bf16x8*>(p.hl + DSTRIDE + row * 256 + c8);
      ly0[i] = *reinterpret_cast<const bf16x8*>(p.ys + row * 256 + c8); ly1[i] = *reinterpret_cast<const bf16x8*>(p.ys + DSTRIDE + row * 256 + c8);
      lga[i] = *reinterpret_cast<const bf16x8*>(pr + C_GA + c8); lus[i] = *reinterpret_cast<const bf16x8*>(pr + C_US + c8);
      ld0[i] = *reinterpret_cast<const f32x4*>(p.s5_d + l * 256 + c8); ld1[i] = *reinterpret_cast<const f32x4*>(p.s5_d + l * 256 + c8 + 4);
    }
    asm volatile("" ::: "memory");
#pragma unroll
    for (int i = 0; i < 2; ++i) {
      const int id = tid + NTHR * i, rr = id >> 5, c8 = (id & 31) * 8; const size_t row = row0 + rr;
      float h0[8], h1[8], y0[8], y1[8], ga[8], us[8], o[8], z[8];
      unpack8(lh0[i], h0); unpack8(lh1[i], h1); unpack8(ly0[i], y0); unpack8(ly1[i], y1); unpack8(lga[i], ga); unpack8(lus[i], us);
      const f32x4 d0 = ld0[i], d1 = ld1[i];
#pragma unroll
      for (int k = 0; k < 8; ++k) {
        o[k] = (h0[k] + h1[k]) * silu_f(ga[k]);
        z[k] = gelu_tanh((k < 4 ? d0[k] : d1[k - 4]) * us[k] + y0[k] + y1[k]);
      }
      *reinterpret_cast<bf16x8*>(p.nbuf + row * 1024 + c8) = pack8(o);
      *reinterpret_cast<f32x4*>(zf + rr * 260 + c8) = f32x4{z[0], z[1], z[2], z[3]};
      *reinterpret_cast<f32x4*>(zf + rr * 260 + c8 + 4) = f32x4{z[4], z[5], z[6], z[7]};
      *reinterpret_cast<bf16x8*>(zb + rr * 264 + c8) = pack8(z);
    }
    bf16x8 lgs[2], lo1[4], lo2[4], lgd[4];
#pragma unroll
    for (int i = 0; i < 2; ++i) { const int id = tid + NTHR * i, rr = id >> 5, c8 = (id & 31) * 8; lgs[i] = *reinterpret_cast<const bf16x8*>(p.pbuf + (size_t)(row0 + rr) * INW + C_GS + c8); }
#pragma unroll
    for (int it = 0; it < 4; ++it) {
      const int pair = (tid >> 4) + 32 * it, rr = pair >> 2, head = pair & 3, e8 = (tid & 15) * 8; const size_t row = row0 + rr;
      lo1[it] = *reinterpret_cast<const bf16x8*>(p.obuf + row * 1024 + head * 256 + e8);
      lo2[it] = *reinterpret_cast<const bf16x8*>(p.obuf + row * 1024 + head * 256 + 128 + e8);
      lgd[it] = *reinterpret_cast<const bf16x8*>(p.pbuf + row * INW + C_GD + head * 128 + e8);
    }
    const f32x4 nn0 = *reinterpret_cast<const f32x4*>(p.da_norm_g + l * 128 + (tid & 15) * 8), nn1 = *reinterpret_cast<const f32x4*>(p.da_norm_g + l * 128 + (tid & 15) * 8 + 4);
    asm volatile("" ::: "memory");
    __syncthreads();
    f32x16 acc = {};
#pragma unroll
    for (int s = 0; s < 16; ++s) {
      const bf16x8 a = *reinterpret_cast<const bf16x8*>(zb + r * 264 + 16 * s + 8 * h);
      acc = MFMA32(a, wg[s], acc);
    }
#pragma unroll
    for (int i = 0; i < 16; ++i) {
      const int m = crow(i, h), col = wid * 32 + r;
      const float zz = zf[m * 260 + col];
      zf[m * 260 + col] = zz * sigmoid_f(acc[i] + bglu);
    }
    __syncthreads();
#pragma unroll
    for (int i = 0; i < 2; ++i) {
      const int id = tid + NTHR * i, rr = id >> 5, c8 = (id & 31) * 8; const size_t row = row0 + rr;
      float gs[8], o[8];
      unpack8(lgs[i], gs);
      const f32x4 g0 = *reinterpret_cast<const f32x4*>(zf + rr * 260 + c8), g1 = *reinterpret_cast<const f32x4*>(zf + rr * 260 + c8 + 4);
#pragma unroll
      for (int k = 0; k < 8; ++k) o[k] = (k < 4 ? g0[k] : g1[k - 4]) * silu_f(gs[k]);
      *reinterpret_cast<bf16x8*>(p.nbuf + row * 1024 + 256 + c8) = pack8(o);
    }
#pragma unroll
    for (int it = 0; it < 4; ++it) {
      const int pair = (tid >> 4) + 32 * it, rr = pair >> 2, head = pair & 3, e8 = (tid & 15) * 8; const size_t row = row0 + rr;
      float o1[8], o2[8], gd[8], v[8], o[8];
      unpack8(lo1[it], o1); unpack8(lo2[it], o2); unpack8(lgd[it], gd);
      const f32x4 n0 = nn0, n1 = nn1;
      float ss = 0.f;
#pragma unroll
      for (int k = 0; k < 8; ++k) { v[k] = o1[k] - lam * o2[k]; ss += v[k] * v[k]; }
      ss += __shfl_xor(ss, 1); ss += __shfl_xor(ss, 2); ss += __shfl_xor(ss, 4); ss += __shfl_xor(ss, 8);
      const float rinv = rsqrtf(ss * (1.f / 128.f) + EPS) * onem;
#pragma unroll
      for (int k = 0; k < 8; ++k) o[k] = v[k] * rinv * (k < 4 ? n0[k] : n1[k - 4]) * silu_f(gd[k]);
      *reinterpret_cast<bf16x8*>(p.nbuf + row * 1024 + 512 + head * 128 + e8) = pack8(o);
    }
    if (dyn && q < 64) asm volatile("s_waitcnt vmcnt(0)" ::: "memory");
    __syncthreads();
    if (dyn && q < 64 && tid == 0) { __threadfence(); __hip_atomic_fetch_add(&ctr[1], 1, __ATOMIC_RELAXED, __HIP_MEMORY_SCOPE_AGENT); }
  }
}

DI void phase_final(const int tix, const Params& p) {
  const int wid = tix >> 6, lane = tix & 63;
  f32x4 gg[4];
#pragma unroll
  for (int i = 0; i < 4; ++i) gg[i] = *(const f32x4*)(p.final_g + i * 256 + lane * 4);
  for (int row = blockIdx.x * 8 + wid; row < NB * TL; row += gridDim.x * 8) {
    float* src = p.out + (size_t)row * 1024;
    f32x4 v[4]; float ss = 0.f;
#pragma unroll
    for (int i = 0; i < 4; ++i) v[i] = *(const f32x4*)(src + i * 256 + lane * 4);
#pragma unroll
    for (int i = 0; i < 4; ++i) ss += v[i][0] * v[i][0] + v[i][1] * v[i][1] + v[i][2] * v[i][2] + v[i][3] * v[i][3];
    ss = wave_sum(ss);
    const float r = rsqrtf(ss * (1.f / 1024.f) + EPS);
#pragma unroll
    for (int i = 0; i < 4; ++i) {
      f32x4 o = {v[i][0] * r * gg[i][0], v[i][1] * r * gg[i][1], v[i][2] * r * gg[i][2], v[i][3] * r * gg[i][3]};
      *(f32x4*)(src + i * 256 + lane * 4) = o;
    }
  }
}

#define XB_TMO      128
#define XB_XCNT(j)  (256  + 64 * (j))
#define XB_XSUB(j)  (1280 + 64 * (j))
#define XB_XGEN(j)  (2304 + 64 * (j))
#define XB_TOP      3328
#define XB_TOPGEN   3392
#define XCD_BAR_WORDS 3456
#define XB_SPIN_CAP (1u << 18)
#define LAS __attribute__((address_space(3)))
DI unsigned xb_ld(unsigned* p)              { return __hip_atomic_load(p, __ATOMIC_RELAXED, __HIP_MEMORY_SCOPE_AGENT); }
DI unsigned xb_add(unsigned* p, unsigned v) { return __hip_atomic_fetch_add(p, v, __ATOMIC_RELAXED, __HIP_MEMORY_SCOPE_AGENT); }
DI unsigned xb_xcc_id() { return (unsigned)__builtin_amdgcn_s_getreg((3 << 11) | 20) & 0xFu; }
#define XB_SPIN(cond, bar) do { unsigned _sp = 0; while (cond) { __builtin_amdgcn_s_sleep(1); \
    if ((++_sp & 255u) == 0u) { if (xb_ld(&(bar)[XB_TMO])) break; if (_sp > XB_SPIN_CAP) { atomicAdd(&(bar)[XB_TMO], 1u); break; } } } } while (0)
struct XcdBarrier { unsigned* bar; unsigned x; volatile LAS unsigned* st; };
DI XcdBarrier xcd_barrier_post(int tid, unsigned* bar, volatile LAS unsigned* st) {
  XcdBarrier b; b.bar = bar; b.x = xb_xcc_id(); b.st = st;
  if (tid == 0) (void)xb_add(&bar[XB_XCNT(b.x)], 1u);
  return b;
}
DI void xcd_barrier_complete(unsigned* bar, unsigned x, unsigned& nloc, unsigned& nx) {
  const unsigned G = gridDim.x;
  unsigned sum, cnt, mine, sp = 0u;
  for (;;) {
    sum = 0u; cnt = 0u; mine = 0u;
#pragma unroll
    for (unsigned j = 0; j < 16; ++j) { const unsigned c = xb_ld(&bar[XB_XCNT(j)]); sum += c; cnt += (c > 0u) ? 1u : 0u; mine = (j == x) ? c : mine; }
    if (sum == G) break;
    __builtin_amdgcn_s_sleep(1);
    if ((++sp & 255u) == 0u) { if (xb_ld(&bar[XB_TMO])) break; if (sp > XB_SPIN_CAP) { atomicAdd(&bar[XB_TMO], 1u); break; } }
  }
  nloc = mine > 0u ? mine : 1u; nx = cnt > 0u ? cnt : 1u;
}
DI void xcd_barrier(int tid, const XcdBarrier& b) {
  asm volatile("s_waitcnt vmcnt(0)" ::: "memory");
  __syncthreads();
  if (tid == 0) {
    unsigned* bar = b.bar;
    __builtin_amdgcn_s_waitcnt(0);
    unsigned nloc = b.st[0], nx = b.st[1];
    if (nloc == 0u) { xcd_barrier_complete(bar, b.x, nloc, nx); b.st[0] = nloc; b.st[1] = nx; }
    const unsigned old = xb_add(&bar[XB_XSUB(b.x)], 1u);
    const unsigned gen = old / nloc;
    if (old + 1u == (gen + 1u) * nloc) {
      __builtin_amdgcn_fence(__ATOMIC_RELEASE, "agent");
      asm volatile("s_waitcnt vmcnt(0)" ::: "memory");
      const unsigned og = xb_add(&bar[XB_TOP], 1u);
      const unsigned tg = og / nx;
      if (og + 1u == (tg + 1u) * nx) xb_add(&bar[XB_TOPGEN], 1u);
      else XB_SPIN(xb_ld(&bar[XB_TOPGEN]) == tg, bar);
      __builtin_amdgcn_fence(__ATOMIC_ACQUIRE, "agent");
      xb_add(&bar[XB_XGEN(b.x)], 1u);
      asm volatile("s_waitcnt vmcnt(0)" ::: "memory");
    } else {
      XB_SPIN(xb_ld(&bar[XB_XGEN(b.x)]) == gen, bar);
      __builtin_amdgcn_fence(__ATOMIC_ACQUIRE, "agent");
      asm volatile("s_waitcnt vmcnt(0)" ::: "memory");
    }
  }
  __syncthreads();
}

#if MULTI
template <int K> __global__ void __launch_bounds__(NTHR) phase_kernel(Params p, int ph) {
  extern __shared__ __attribute__((aligned(16))) char smem[];
  __shared__ int s_item;
  const int wid_s = __builtin_amdgcn_readfirstlane((int)__builtin_amdgcn_workitem_id_x() >> 6);
  const int l = (ph - 1) / 5;
  if (K == 0) { phase_prep(tid_opaque(wid_s), p, smem, 0); phase_prep(tid_opaque(wid_s), p, smem, 1); }
  else if (K == 6) phase_final(tid_opaque(wid_s), p);
  else if (K == 1) phase_norm(tid_opaque(wid_s), p, l);
  else if (K == 2) gm::gemm_phase<0>(tid_opaque(wid_s), p, l, p.nbuf, p.winT + (size_t)l * 3072 * 1024, 12, smem);
  else if (K == 3) phase_mix(tid_opaque(wid_s), p, l, smem, &s_item);
  else if (K == 4) phase_combine(tid_opaque(wid_s), p, l, smem, &s_item);
  else gm::gemm_phase<1>(tid_opaque(wid_s), p, l, p.nbuf, p.woutT + (size_t)l * 1024 * 1024, 4, smem);
}
template <int K> static void launch_phase(const Params& p, int ph, hipStream_t stream) {
  (void)hipFuncSetAttribute((const void*)phase_kernel<K>, hipFuncAttributeMaxDynamicSharedMemorySize, LDS_BYTES);
  hipLaunchKernelGGL(phase_kernel<K>, dim3(256), dim3(NTHR), LDS_BYTES, stream, p, ph);
}
#else
__global__ void __launch_bounds__(NTHR) mega_kernel(Params p) {
  extern __shared__ __attribute__((aligned(16))) char smem[];
  __shared__ uint4 sh_words;
  int* s_item = (int*)&sh_words;
  const int wid_s = __builtin_amdgcn_readfirstlane((int)__builtin_amdgcn_workitem_id_x() >> 6);
  cg::grid_group grid = cg::this_grid();
  if (tid_opaque(wid_s) == 0) sh_words = make_uint4(0u, 0u, 0u, 0u);
  __syncthreads();
  XcdBarrier xb = xcd_barrier_post(tid_opaque(wid_s), p.xbar, (volatile LAS unsigned*)((unsigned*)&sh_words + 2));
#define GSYNC() xcd_barrier(tid_opaque(wid_s), xb)
  for (int rep = 0; rep < ((PROBE_DUP & 64) ? 2 : 1); ++rep) { phase_prep(tid_opaque(wid_s), p, smem, 0); grid.sync(); phase_prep(tid_opaque(wid_s), p, smem, 1); }
  for (int l = 0; l < 2; ++l) {
    for (int rep = 0; rep < ((PROBE_DUP & 8) ? 2 : 1); ++rep) { phase_norm(tid_opaque(wid_s), p, l); GSYNC(); }
    for (int rep = 0; rep < ((PROBE_DUP & 16) ? 2 : 1); ++rep) { pg::gemm_stream(tid_opaque(wid_s), (PG_LAS unsigned char*)smem, p.nbuf, p.winT + (size_t)l * 3072 * 1024, pg::Sched{l == 0 ? 0 : 2, 12, (int)gridDim.x, (int)blockIdx.x}, pg::EpiIn{p, l}); GSYNC(); }
    for (int rep = 0; rep < ((PROBE_DUP & 128) ? 2 : 1); ++rep) { phase_mix(tid_opaque(wid_s), p, l, smem, s_item, rep * 3); GSYNC(); }
    for (int rep = 0; rep < ((PROBE_DUP & 32) ? 2 : 1); ++rep) { phase_combine(tid_opaque(wid_s), p, l, smem, s_item); GSYNC(); }
    for (int rep = 0; rep < (((PROBE_DUP & 256) && l == 0) ? 2 : 1); ++rep) { pg::gemm_stream(tid_opaque(wid_s), (PG_LAS unsigned char*)smem, p.nbuf, p.woutT + (size_t)l * 1024 * 1024, pg::Sched{1, 4, (int)gridDim.x, (int)blockIdx.x}, pg::EpiOut{p, l}); GSYNC(); }
  }
  phase_final(tid_opaque(wid_s), p);
#undef GSYNC
}
#endif

extern "C" void kernel_launch(void* const* d_in, const int* in_sizes, int n_in, void* d_out, int out_size, void* d_ws, size_t ws_size, hipStream_t stream) {
  Params p{};
  const float** pf = (const float**)&p;
  for (int i = 0; i < 29; ++i) pf[i] = (const float*)d_in[i];
  p.out = (float*)d_out;
  char* w = (char*)d_ws; size_t off = 0;
  auto take = [&](size_t bytes) { char* r = w + off; off += (bytes + 255) & ~(size_t)255; return r; };
  p.nbuf = (u16*)take((size_t)ROWS * 1024 * 2);
  p.pbuf = (u16*)take((size_t)ROWS * INW * 2);
  p.hl = (u16*)take((size_t)2 * ROWS * 256 * 2);
  p.ys = (u16*)take((size_t)2 * ROWS * 256 * 2);
  p.obuf = (u16*)take((size_t)ROWS * 1024 * 2);
  p.winT = (u16*)take((size_t)2 * 3072 * 1024 * 2);
  p.woutT = (u16*)take((size_t)2 * 1024 * 1024 * 2);
  p.wgluT = (u16*)take((size_t)2 * 65536 * 2);
  p.bbT = (u16*)take((size_t)64 * 2 * 64 * 16 * 2);
  p.cc = (u16*)take((size_t)131072 * 2);
  p.lruWT = (u16*)take((size_t)32 * 4096 * 2);
  p.hc = (float*)take((size_t)NB * TC * 1024 * 4);
  p.mod = (float*)take((size_t)2 * 9 * 3072 * 4);
  p.sa = (float*)take((size_t)4096 * 2 * 4);
  p.rope = (float*)take((size_t)2048 * 4);
  p.lamv = (float*)take(256);
  p.counters = (int*)take(256);
  p.xbar = (unsigned*)take((size_t)XCD_BAR_WORDS * 4);
  if (off > ws_size) { fprintf(stderr, "kernel_launch: workspace too small: need %zu have %zu\n", off, ws_size); return; }
#if MULTI
  launch_phase<0>(p, 0, stream);
  for (int l = 0; l < 2; ++l) {
    launch_phase<1>(p, 1 + 5 * l, stream); launch_phase<2>(p, 2 + 5 * l, stream); launch_phase<3>(p, 3 + 5 * l, stream);
    launch_phase<4>(p, 4 + 5 * l, stream); launch_phase<5>(p, 5 + 5 * l, stream);
  }
  launch_phase<6>(p, 11, stream);
#else
  static int grid_blocks = 0;
  if (!grid_blocks) {
    int dev = 0, cus = 0, per_cu = 0;
    hipGetDevice(&dev);
    hipDeviceGetAttribute(&cus, hipDeviceAttributeMultiprocessorCount, dev);
    hipFuncSetAttribute((const void*)mega_kernel, hipFuncAttributeMaxDynamicSharedMemorySize, LDS_BYTES);
    hipOccupancyMaxActiveBlocksPerMultiprocessor(&per_cu, (const void*)mega_kernel, NTHR, LDS_BYTES);
    if (per_cu < 1) per_cu = 1;
    grid_blocks = cus * per_cu;
  }
  (void)hipMemsetAsync(p.xbar, 0, (size_t)XCD_BAR_WORDS * 4, stream);
  void* args[] = {&p};
  hipError_t e = hipLaunchCooperativeKernel((const void*)mega_kernel, dim3(grid_blocks), dim3(NTHR), args, LDS_BYTES, stream);
  if (e != hipSuccess) fprintf(stderr, "cooperative launch failed: %s (grid %d)\n", hipGetErrorString(e), grid_blocks);
#endif
}
```
